# Optimizing an MI355X kernel written in HIP

```python
import math
import jax, jax.numpy as jnp
from jax import lax
import numpy as np

D_MODEL = 1024
BATCH = 16
SEQ = 2048
DEPTH = 2
DEC_BATCH = 16
DEC_SEQ = 16
PAST_LEN = 4096

CHUNK = 64
N_A_LAYERS = DEPTH // 2
N_B_LAYERS = DEPTH - N_A_LAYERS
RWKV_HEAD = 64
RWKV_HEADS = D_MODEL // RWKV_HEAD
DECAY_LORA = 64
AAA_LORA = 64
GATE_LORA = 128
GN_EPS = 64e-5
DIFF_HEADS = 8
DIFF_DH = D_MODEL // (2 * DIFF_HEADS)
ROT_DIM = DIFF_DH // 4
ROPE_THETA = 500000.0
Q_BLOCK = 128
SUBLN_EPS = 1e-5
PEER_HEADS = 8
PEER_KEYS = 128
PEER_EXPERTS = PEER_KEYS * PEER_KEYS
PEER_DKEY = 256
PEER_DHALF = PEER_DKEY // 2
PEER_TOPK = 16
PEER_ROWS = 64
DN_ALPHA = (2.0 * DEPTH) ** 0.25
DN_BETA = (8.0 * DEPTH) ** -0.25
LN_EPS = 1e-5

kernel_name = "yoco_rwkv7_diffattn_peer_stream_step"

F32 = jnp.float32


def layer_norm(x, g, b):
    xf = x.astype(F32)
    mu = jnp.mean(xf, -1, keepdims=True)
    var = jnp.mean(jnp.square(xf - mu), -1, keepdims=True)
    return ((xf - mu) * lax.rsqrt(var + LN_EPS) * g.astype(F32) + b.astype(F32)).astype(x.dtype)


def rwkv7_time_mix(x, shift_prev, wkv_prev, mu, w_rkv, w0, w1, w2, a0, a1, a2, g1, g2,
                   k_k, k_a, r_k, lnx_g, lnx_b, w_out):
    B, T, D = x.shape
    H, N = RWKV_HEADS, RWKV_HEAD
    x_prev = jnp.concatenate([shift_prev.astype(x.dtype), x[:, :-1]], axis=1)
    xx = x_prev - x
    xr, xk, xv, xw, xa, xg = (x + xx * mu[i] for i in range(6))
    r = xr @ w_rkv[0]
    k = xk @ w_rkv[1]
    v = xv @ w_rkv[2]
    logw = -jax.nn.softplus(-(w0 + jnp.tanh(xw @ w1) @ w2)) - 0.5
    a = jax.nn.sigmoid(a0 + (xa @ a1) @ a2)
    g = jax.nn.sigmoid(xg @ g1) @ g2
    hd = lambda t: t.reshape(B, T, H, N).astype(F32)
    kk = hd(k * k_k)
    kk = kk / jnp.maximum(jnp.sqrt(jnp.sum(kk * kk, -1, keepdims=True)), 1e-12)
    k = k * (1.0 + (a - 1.0) * k_a)
    rf, kf, vf, af = hd(r), hd(k), hd(v), hd(a)
    decay = jnp.exp(-jnp.exp(hd(logw)))

    def step(S, inp):
        r_t, d_t, k_t, v_t, kk_t, a_t = inp
        Skk = jnp.einsum('bhvk,bhk->bhv', S, kk_t)
        S = (S * d_t[:, :, None, :]
             - Skk[..., None] * (kk_t * a_t)[:, :, None, :]
             + v_t[..., None] * k_t[:, :, None, :])
        y_t = jnp.einsum('bhvk,bhk->bhv', S, r_t)
        return S, y_t

    seq = tuple(jnp.moveaxis(t, 1, 0) for t in (rf, decay, kf, vf, kk, af))
    S_final, y = lax.scan(step, wkv_prev.astype(F32), seq)
    y = jnp.moveaxis(y, 0, 1)
    ym = jnp.mean(y, -1, keepdims=True)
    yv = jnp.mean(jnp.square(y - ym), -1, keepdims=True)
    y = ((y - ym) * lax.rsqrt(yv + GN_EPS)).reshape(B, T, D) * lnx_g.astype(F32) + lnx_b.astype(F32)
    bonus = jnp.sum(rf * kf * r_k.astype(F32), -1, keepdims=True) * vf
    y = y + bonus.reshape(B, T, D)
    out = (y * g.astype(F32)).astype(x.dtype) @ w_out
    return out, x[:, -1:], S_final.astype(x.dtype)


def rope_partial(t, pos):
    half = ROT_DIM // 2
    inv = jnp.power(ROPE_THETA, -jnp.arange(half, dtype=F32) * 2.0 / ROT_DIM)
    ang = pos.astype(F32)[:, None] * inv[None, :]
    cos = jnp.cos(ang)[None, :, None, None, :]
    sin = jnp.sin(ang)[None, :, None, None, :]
    tr = t[..., :ROT_DIM].astype(F32)
    t1, t2 = tr[..., :half], tr[..., half:]
    rot = jnp.concatenate([t1 * cos - t2 * sin, t1 * sin + t2 * cos], -1)
    return jnp.concatenate([rot.astype(t.dtype), t[..., ROT_DIM:]], -1)


def shared_kv(x, w_kv, pos):
    B, T, _ = x.shape
    kv = x @ w_kv
    k = kv[..., :D_MODEL].reshape(B, T, DIFF_HEADS, 2, DIFF_DH)
    v = kv[..., D_MODEL:].reshape(B, T, DIFF_HEADS, 2 * DIFF_DH)
    return rope_partial(k, pos), v


def diff_core(q, kf, vf, lam, mask):
    s = jnp.einsum('bqhcd,bkhcd->bhcqk', q.astype(F32), kf) * (DIFF_DH ** -0.5)
    if mask is not None:
        s = jnp.where(mask[None, None, None], s, -jnp.inf)
    p = jax.nn.softmax(s, axis=-1)
    attn = p[:, :, 0] - lam * p[:, :, 1]
    return jnp.einsum('bhqk,bkhe->bqhe', attn, vf)


def diff_attention(x, k_all, v_all, pos, w_q, lam_params, subln_g, w_o, layer_idx, prompt_mode):
    B, T, _ = x.shape
    q = rope_partial((x @ w_q).reshape(B, T, DIFF_HEADS, 2, DIFF_DH), pos)
    lam_init = 0.8 - 0.6 * math.exp(-0.3 * layer_idx)
    lp = lam_params.astype(F32)
    lam = jnp.exp(jnp.sum(lp[0] * lp[1])) - jnp.exp(jnp.sum(lp[2] * lp[3])) + lam_init
    kf, vf = k_all.astype(F32), v_all.astype(F32)
    if prompt_mode:
        nb = T // Q_BLOCK
        qb = q.reshape(B, nb, Q_BLOCK, DIFF_HEADS, 2, DIFF_DH).transpose(1, 0, 2, 3, 4, 5)
        k_chunk = jnp.arange(kf.shape[1]) // CHUNK

        def block(args):
            qi, bi = args
            q_chunk = (bi * Q_BLOCK + jnp.arange(Q_BLOCK)) // CHUNK
            mask = k_chunk[None, :] <= q_chunk[:, None]
            return diff_core(qi, kf, vf, lam, mask)

        o = lax.map(block, (qb, jnp.arange(nb)))
        o = o.transpose(1, 0, 2, 3, 4).reshape(B, T, DIFF_HEADS, 2 * DIFF_DH)
    else:
        o = diff_core(q, kf, vf, lam, None)
    o = o * lax.rsqrt(jnp.mean(o * o, -1, keepdims=True) + SUBLN_EPS) * subln_g.astype(F32)
    o = o * (1.0 - lam_init)
    return o.reshape(B, T, D_MODEL).astype(x.dtype) @ w_o


def peer_rows(xr, w_query, sub_keys, expert_u, expert_v):
    n = xr.shape[0]
    q = (xr @ w_query).reshape(n, PEER_HEADS, 2, PEER_DHALF).astype(F32)
    s = jnp.einsum('nhcd,ckd->nhck', q, sub_keys.astype(F32))
    s1, i1 = lax.top_k(s[:, :, 0], PEER_TOPK)
    s2, i2 = lax.top_k(s[:, :, 1], PEER_TOPK)
    cand_s = (s1[..., :, None] + s2[..., None, :]).reshape(n, PEER_HEADS, PEER_TOPK * PEER_TOPK)
    cand_i = (i1[..., :, None] * PEER_KEYS + i2[..., None, :]).reshape(n, PEER_HEADS, PEER_TOPK * PEER_TOPK)
    top_s, top_pos = lax.top_k(cand_s, PEER_TOPK)
    eidx = jnp.take_along_axis(cand_i, top_pos, axis=-1)
    gate = jax.nn.softmax(top_s, axis=-1)
    u = expert_u[eidx].astype(F32)
    h = jax.nn.gelu(jnp.einsum('nhkd,nd->nhk', u, xr.astype(F32)), approximate=False)
    out = jnp.einsum('nhk,nhkd->nd', gate * h, expert_v[eidx].astype(F32))
    return out.astype(xr.dtype)


def peer_ffn(x, w_query, sub_keys, expert_u, expert_v):
    B, T, D = x.shape
    n = B * T
    nb = -(-n // PEER_ROWS)
    rows = jnp.pad(x.reshape(n, D), ((0, nb * PEER_ROWS - n), (0, 0)))
    out = lax.map(lambda r: peer_rows(r, w_query, sub_keys, expert_u, expert_v),
                  rows.reshape(nb, PEER_ROWS, D))
    return out.reshape(nb * PEER_ROWS, D)[:n].reshape(B, T, D)


def _trunk(x, pos, shift_prev, wkv_prev, past_k, past_v, W):
    new_shift, new_wkv = [], []
    k_all = v_all = k_new = v_new = None
    for l in range(DEPTH):
        if l < N_A_LAYERS:
            mix, sh, st = rwkv7_time_mix(
                x, shift_prev[l], wkv_prev[l], W['rwkv_mu'][l], W['rwkv_w_rkv'][l],
                W['rwkv_w0'][l], W['rwkv_w1'][l], W['rwkv_w2'][l],
                W['rwkv_a0'][l], W['rwkv_a1'][l], W['rwkv_a2'][l],
                W['rwkv_g1'][l], W['rwkv_g2'][l], W['rwkv_k_k'][l], W['rwkv_k_a'][l],
                W['rwkv_r_k'][l], W['rwkv_lnx_g'][l], W['rwkv_lnx_b'][l], W['rwkv_w_out'][l])
            new_shift.append(sh)
            new_wkv.append(st)
        else:
            if l == N_A_LAYERS:
                k_new, v_new = shared_kv(x, W['w_kv'], pos)
                if past_k is None:
                    k_all, v_all = k_new, v_new
                else:
                    k_all = jnp.concatenate([past_k.astype(k_new.dtype), k_new], axis=1)
                    v_all = jnp.concatenate([past_v.astype(v_new.dtype), v_new], axis=1)
            j = l - N_A_LAYERS
            mix = diff_attention(x, k_all, v_all, pos, W['diff_w_q'][j], W['diff_lambda'][j],
                                 W['diff_subln_g'][j], W['diff_w_o'][j], l, past_k is None)
        x = layer_norm(DN_ALPHA * x + mix, W['ln_mix_g'][l], W['ln_mix_b'][l])
        ffn = peer_ffn(x, W['peer_w_query'][l], W['peer_sub_keys'][l], W['peer_u'][l], W['peer_v'][l])
        x = layer_norm(DN_ALPHA * x + ffn, W['ln_ffn_g'][l], W['ln_ffn_b'][l])
    return x, jnp.stack(new_shift), jnp.stack(new_wkv), k_new, v_new


def setup_inputs(seed: int = 0) -> dict:
    key = jax.random.key(seed)
    ks = iter(jax.random.split(key, 64))
    D, H, N = D_MODEL, RWKV_HEADS, RWKV_HEAD
    A, Bn = N_A_LAYERS, N_B_LAYERS

    def nrm(shape, scale):
        return jax.random.normal(next(ks), shape, F32) * scale

    def uni(shape, lo, hi):
        return jax.random.uniform(next(ks), shape, F32, minval=lo, maxval=hi)

    return {
        'x_prompt': nrm((BATCH, SEQ, D), 1.0),
        'x_sample': nrm((DEC_BATCH, DEC_SEQ, D), 1.0),
        'state_wkv': nrm((A, DEC_BATCH, H, N, N), 0.1),
        'state_shift': nrm((A, DEC_BATCH, 1, D), 1.0),
        'cache_k': nrm((DEC_BATCH, PAST_LEN, DIFF_HEADS, 2, DIFF_DH), 1.0),
        'cache_v': nrm((DEC_BATCH, PAST_LEN, DIFF_HEADS, 2 * DIFF_DH), 1.0),
        'rwkv_mu': uni((A, 6, D), 0.0, 1.0),
        'rwkv_w_rkv': nrm((A, 3, D, D), D ** -0.5),
        'rwkv_w0': uni((A, D), -4.0, 1.0),
        'rwkv_w1': nrm((A, D, DECAY_LORA), D ** -0.5),
        'rwkv_w2': nrm((A, DECAY_LORA, D), 0.1 * DECAY_LORA ** -0.5),
        'rwkv_a0': nrm((A, D), 0.1),
        'rwkv_a1': nrm((A, D, AAA_LORA), D ** -0.5),
        'rwkv_a2': nrm((A, AAA_LORA, D), AAA_LORA ** -0.5),
        'rwkv_g1': nrm((A, D, GATE_LORA), D ** -0.5),
        'rwkv_g2': nrm((A, GATE_LORA, D), GATE_LORA ** -0.5),
        'rwkv_k_k': 0.85 + nrm((A, D), 0.05),
        'rwkv_k_a': 1.0 + nrm((A, D), 0.05),
        'rwkv_r_k': nrm((A, H, N), 0.1),
        'rwkv_lnx_g': 1.0 + nrm((A, D), 0.05),
        'rwkv_lnx_b': nrm((A, D), 0.02),
        'rwkv_w_out': nrm((A, D, D), D ** -0.5 * DN_BETA),
        'w_kv': nrm((D, 2 * D), D ** -0.5),
        'diff_w_q': nrm((Bn, D, D), D ** -0.5),
        'diff_lambda': nrm((Bn, 4, DIFF_DH), 0.1),
        'diff_subln_g': 1.0 + nrm((Bn, 2 * DIFF_DH), 0.05),
        'diff_w_o': nrm((Bn, D, D), D ** -0.5 * DN_BETA),
        'ln_mix_g': 1.0 + nrm((DEPTH, D), 0.05),
        'ln_mix_b': nrm((DEPTH, D), 0.02),
        'ln_ffn_g': 1.0 + nrm((DEPTH, D), 0.05),
        'ln_ffn_b': nrm((DEPTH, D), 0.02),
        'peer_w_query': nrm((DEPTH, D, PEER_HEADS * PEER_DKEY), D ** -0.5),
        'peer_sub_keys': nrm((DEPTH, 2, PEER_KEYS, PEER_DHALF), PEER_DHALF ** -0.5),
        'peer_u': nrm((DEPTH, PEER_EXPERTS, D), D ** -0.5),
        'peer_v': nrm((DEPTH, PEER_EXPERTS, D), DN_BETA * PEER_HEADS ** -0.5),
    }


def reference(x_prompt, x_sample, state_wkv, state_shift, cache_k, cache_v,
              rwkv_mu, rwkv_w_rkv, rwkv_w0, rwkv_w1, rwkv_w2, rwkv_a0, rwkv_a1, rwkv_a2,
              rwkv_g1, rwkv_g2, rwkv_k_k, rwkv_k_a, rwkv_r_k, rwkv_lnx_g, rwkv_lnx_b, rwkv_w_out,
              w_kv, diff_w_q, diff_lambda, diff_subln_g, diff_w_o,
              ln_mix_g, ln_mix_b, ln_ffn_g, ln_ffn_b,
              peer_w_query, peer_sub_keys, peer_u, peer_v):
    W = dict(rwkv_mu=rwkv_mu, rwkv_w_rkv=rwkv_w_rkv, rwkv_w0=rwkv_w0, rwkv_w1=rwkv_w1,
             rwkv_w2=rwkv_w2, rwkv_a0=rwkv_a0, rwkv_a1=rwkv_a1, rwkv_a2=rwkv_a2,
             rwkv_g1=rwkv_g1, rwkv_g2=rwkv_g2, rwkv_k_k=rwkv_k_k, rwkv_k_a=rwkv_k_a,
             rwkv_r_k=rwkv_r_k, rwkv_lnx_g=rwkv_lnx_g, rwkv_lnx_b=rwkv_lnx_b,
             rwkv_w_out=rwkv_w_out, w_kv=w_kv, diff_w_q=diff_w_q, diff_lambda=diff_lambda,
             diff_subln_g=diff_subln_g, diff_w_o=diff_w_o, ln_mix_g=ln_mix_g,
             ln_mix_b=ln_mix_b, ln_ffn_g=ln_ffn_g, ln_ffn_b=ln_ffn_b,
             peer_w_query=peer_w_query, peer_sub_keys=peer_sub_keys,
             peer_u=peer_u, peer_v=peer_v)
    Bp, Tp, D = x_prompt.shape
    _, Ts, _ = x_sample.shape
    pos_p = jnp.arange(Tp, dtype=jnp.int32)
    shift0 = jnp.zeros((N_A_LAYERS, Bp, 1, D), x_prompt.dtype)
    wkv0 = jnp.zeros((N_A_LAYERS, Bp, RWKV_HEADS, RWKV_HEAD, RWKV_HEAD), x_prompt.dtype)
    y_prompt, state_shift_prompt, state_wkv_prompt, cache_k_prompt, cache_v_prompt = _trunk(
        x_prompt, pos_p, shift0, wkv0, None, None, W)
    pos_s = PAST_LEN + jnp.arange(Ts, dtype=jnp.int32)
    y_sample, state_shift_sample, state_wkv_sample, cache_k_sample, cache_v_sample = _trunk(
        x_sample, pos_s, state_shift, state_wkv, cache_k, cache_v, W)
    return (y_prompt, y_sample, state_wkv_prompt, state_shift_prompt, cache_k_prompt, cache_v_prompt,
            state_wkv_sample, state_shift_sample, cache_k_sample, cache_v_sample)
```

```cpp
#include <hip/hip_runtime.h>
#include <hip/hip_cooperative_groups.h>
#include <stdio.h>
namespace cg = cooperative_groups;

typedef unsigned short bf16;
typedef __attribute__((ext_vector_type(8))) short s16x8;
typedef __attribute__((ext_vector_type(4))) float f32x4;

constexpr int NTP = 32768, NT = 33024;
constexpr int REP_GEMM = 1, REP_PE = 1, REP_SCAN = 1, REP_ATTN = 1, REP_P0 = 1;
constexpr size_t U = (size_t)NT * 1024 * 2;

constexpr size_t O_WRKV = 0;
constexpr size_t O_WL1  = O_WRKV + 3 * 2097152;
constexpr size_t O_W2T  = O_WL1 + 524288;
constexpr size_t O_A2T  = O_W2T + 131072;
constexpr size_t O_G2T  = O_A2T + 131072;
constexpr size_t O_WOUT = O_G2T + 262144;
constexpr size_t O_WKV  = O_WOUT + 2097152;
constexpr size_t O_WQ   = O_WKV + 4194304;
constexpr size_t O_WO   = O_WQ + 2097152;
constexpr size_t O_WPQ  = O_WO + 2097152;
constexpr size_t O_SK   = O_WPQ + 2 * 4194304;
constexpr size_t O_PU   = O_SK + 131072;
constexpr size_t O_PV   = O_PU + 16777216;
constexpr size_t O_SU   = O_PV + 16777216;
constexpr size_t O_SV   = O_SU + 131072;
constexpr size_t O_CNT  = O_SV + 131072;
constexpr size_t O_BAR  = O_CNT + 256;
constexpr size_t O_CUT  = O_BAR + 16384;
constexpr size_t O_SLOT = O_CUT + 16384;
constexpr size_t WS_NEED = O_SLOT + 10 * U;

constexpr size_t OFF_YP = 0, OFF_YS = 33554432, OFF_WKVP = 33816576, OFF_SHP = 34865152,
                 OFF_CKP = 34881536, OFF_CVP = 68435968, OFF_WKVS = 101990400, OFF_SHS = 103038976,
                 OFF_CKS = 103055360, OFF_CVS = 103317504;

struct Params {
  const float* in[35];
  float* out;
  char* ws;
};
typedef const Params __attribute__((address_space(4)))* KP;

__device__ const unsigned char CAND[64] = {0, 1, 2, 3, 4, 5, 6, 7, 8, 9, 10, 11, 12, 13, 14, 15, 16, 17, 18, 19, 20, 21, 22, 23, 32, 33, 34, 35, 36, 48, 49, 50, 51, 64, 65, 66, 80, 81, 96, 97, 112, 113, 128, 144, 160, 176, 192, 208, 224, 240, 255, 255, 255, 255, 255, 255, 255, 255, 255, 255, 255, 255, 255, 255};

__device__ __forceinline__ char* slot(KP p, int i) { return p->ws + O_SLOT + (size_t)i * U; }
__device__ __forceinline__ bf16 f2b(float f) { unsigned u = __float_as_uint(f); u += 0x7fffu + ((u >> 16) & 1u); return (bf16)(u >> 16); }
typedef float f32x2 __attribute__((ext_vector_type(2)));
typedef __bf16 bf16x2_t __attribute__((ext_vector_type(2)));
__device__ __forceinline__ unsigned pack2(float a, float b) {
  const f32x2 v = {a, b};
  return __builtin_bit_cast(unsigned, __builtin_convertvector(v, bf16x2_t));
}
__device__ __forceinline__ float blo(unsigned u) { return __uint_as_float(u << 16); }
__device__ __forceinline__ float bhi(unsigned u) { return __uint_as_float(u & 0xffff0000u); }
__device__ __forceinline__ uint2 pack4(f32x4 v) { return make_uint2(pack2(v[0], v[1]), pack2(v[2], v[3])); }
__device__ __forceinline__ f32x4 unpack4(uint2 u) { f32x4 r; r[0] = blo(u.x); r[1] = bhi(u.x); r[2] = blo(u.y); r[3] = bhi(u.y); return r; }
__device__ __forceinline__ f32x4 ld4(const float* p) { float4 t = *(const float4*)p; f32x4 r; r[0] = t.x; r[1] = t.y; r[2] = t.z; r[3] = t.w; return r; }
__device__ __forceinline__ void st4(float* p, f32x4 v) { *(float4*)p = make_float4(v[0], v[1], v[2], v[3]); }

template <int CTRL> __device__ __forceinline__ float dppf(float v) {
  return __builtin_bit_cast(float, __builtin_amdgcn_mov_dpp(__builtin_bit_cast(int, v), CTRL, 0xf, 0xf, true));
}
template <int CTRL> __device__ __forceinline__ unsigned dppu(unsigned v) {
  return (unsigned)__builtin_amdgcn_mov_dpp((int)v, CTRL, 0xf, 0xf, true);
}
__device__ __forceinline__ float oct_sum(float v) { v += dppf<0xB1>(v); v += dppf<0x4E>(v); v += dppf<0x141>(v); return v; }
__device__ __forceinline__ float row_sum(float v) { v = oct_sum(v); v += dppf<0x140>(v); return v; }
__device__ __forceinline__ float row_max(float v) {
  v = fmaxf(v, dppf<0xB1>(v)); v = fmaxf(v, dppf<0x4E>(v)); v = fmaxf(v, dppf<0x141>(v)); v = fmaxf(v, dppf<0x140>(v)); return v;
}
__device__ __forceinline__ unsigned umx(unsigned a, unsigned b) { return a > b ? a : b; }
__device__ __forceinline__ unsigned row_umax(unsigned v) {
  v = umx(v, dppu<0xB1>(v)); v = umx(v, dppu<0x4E>(v)); v = umx(v, dppu<0x141>(v)); v = umx(v, dppu<0x140>(v)); return v;
}
__device__ __forceinline__ float wave_sum(float v) { v = row_sum(v); v += __shfl_xor(v, 16); v += __shfl_xor(v, 32); return v; }
__device__ __forceinline__ unsigned f2ord(float f) { unsigned u = __float_as_uint(f); return (u & 0x80000000u) ? ~u : (u | 0x80000000u); }
__device__ __forceinline__ float ord2f(unsigned o) { unsigned u = (o & 0x80000000u) ? (o & 0x7fffffffu) : ~o; return __uint_as_float(u); }
__device__ __forceinline__ const float* xin(KP p, int m) {
  return m < NTP ? p->in[0] + (size_t)m * 1024 : p->in[1] + (size_t)(m - NTP) * 1024;
}

__device__ __forceinline__ int swz(int row, int slot) { const int q = (row >> 2) & 3; return row * 64 + ((slot ^ (q ^ ((q & 1) << 1))) << 4); }

__device__ __forceinline__ int otid() { int t = threadIdx.x; asm volatile("" : "+v"(t)); return t; }

#define XB_TMO      128
#define XB_XCNT(j)  (256  + 64 * (j))
#define XB_XSUB(j)  (1280 + 64 * (j))
#define XB_XGEN(j)  (2304 + 64 * (j))
#define XB_TOP      3328
#define XB_TOPGEN   3392
#define XCD_BAR_WORDS 3456
#define XB_SPIN_CAP (1u << 20)
__device__ __forceinline__ unsigned xb_ld(unsigned* p) { return __hip_atomic_load(p, __ATOMIC_RELAXED, __HIP_MEMORY_SCOPE_AGENT); }
__device__ __forceinline__ unsigned xb_add(unsigned* p, unsigned v) { return __hip_atomic_fetch_add(p, v, __ATOMIC_RELAXED, __HIP_MEMORY_SCOPE_AGENT); }
__device__ __forceinline__ unsigned xb_xcc_id() { return (unsigned)__builtin_amdgcn_s_getreg((3 << 11) | 20) & 0xFu; }
#define XB_SPIN(cond, bar) do { unsigned _sp = 0; while (cond) { __builtin_amdgcn_s_sleep(1); \
    if ((++_sp & 255u) == 0u) { if (xb_ld(&(bar)[XB_TMO])) break; if (_sp > XB_SPIN_CAP) { atomicAdd(&(bar)[XB_TMO], 1u); break; } } } } while (0)
struct XcdBar { unsigned* bar; unsigned x, nloc, nx; };
__device__ __forceinline__ void xcd_census(unsigned* bar, unsigned x, unsigned& nloc, unsigned& nx) {
  const unsigned G = gridDim.x;
  unsigned sum, cnt, mine, sp = 0u;
  for (;;) {
    sum = 0u; cnt = 0u; mine = 0u;
#pragma unroll
    for (unsigned j = 0; j < 16; ++j) { const unsigned c = xb_ld(&bar[XB_XCNT(j)]); sum += c; cnt += (c > 0u) ? 1u : 0u; mine = (j == x) ? c : mine; }
    if (sum == G) break;
    __builtin_amdgcn_s_sleep(1);
    if ((++sp & 255u) == 0u) { if (xb_ld(&bar[XB_TMO])) break; if (sp > XB_SPIN_CAP) { atomicAdd(&bar[XB_TMO], 1u); break; } }
  }
  nloc = mine > 0u ? mine : 1u; nx = cnt > 0u ? cnt : 1u;
}
__device__ __forceinline__ void xcd_barrier(XcdBar& b) {
  asm volatile("s_waitcnt vmcnt(0)" ::: "memory");
  __syncthreads();
  if (threadIdx.x == 0) {
    unsigned* bar = b.bar;
    __builtin_amdgcn_s_waitcnt(0);
    const unsigned nloc = b.nloc, nx = b.nx;
    const unsigned old = xb_add(&bar[XB_XSUB(b.x)], 1u);
    const unsigned gen = old / nloc;
    if (old + 1u == (gen + 1u) * nloc) {
      __builtin_amdgcn_fence(__ATOMIC_RELEASE, "agent");
      asm volatile("s_waitcnt vmcnt(0)" ::: "memory");
      const unsigned og = xb_add(&bar[XB_TOP], 1u);
      const unsigned tg = og / nx;
      if (og + 1u == (tg + 1u) * nx) xb_add(&bar[XB_TOPGEN], 1u);
      else XB_SPIN(xb_ld(&bar[XB_TOPGEN]) == tg, bar);
      __builtin_amdgcn_fence(__ATOMIC_ACQUIRE, "agent");
      xb_add(&bar[XB_XGEN(b.x)], 1u);
      asm volatile("s_waitcnt vmcnt(0)" ::: "memory");
    } else {
      XB_SPIN(xb_ld(&bar[XB_XGEN(b.x)]) == gen, bar);
      __builtin_amdgcn_fence(__ATOMIC_ACQUIRE, "agent");
      asm volatile("s_waitcnt vmcnt(0)" ::: "memory");
    }
  }
  __syncthreads();
}

__device__ __forceinline__ void transpose_cvt(const float* __restrict__ W, bf16* __restrict__ WT, int K, int N, int gtid, int gsz) {
  const int items = (K >> 3) * N;
  for (int it = gtid; it < items; it += gsz) {
    const int n = it % N, kb = it / N;
    const float* src = W + (size_t)(kb * 8) * N + n;
    uint4 o;
    o.x = pack2(src[0], src[(size_t)N]);
    o.y = pack2(src[(size_t)2 * N], src[(size_t)3 * N]);
    o.z = pack2(src[(size_t)4 * N], src[(size_t)5 * N]);
    o.w = pack2(src[(size_t)6 * N], src[(size_t)7 * N]);
    *(uint4*)(WT + (size_t)n * K + kb * 8) = o;
  }
}
__device__ __forceinline__ void plain_cvt(const float* __restrict__ S, bf16* __restrict__ D, size_t n8, int gtid, int gsz) {
  for (size_t it = gtid; it < n8; it += gsz) {
    const float4 a = *(const float4*)(S + it * 8), b = *(const float4*)(S + it * 8 + 4);
    uint4 o; o.x = pack2(a.x, a.y); o.y = pack2(a.z, a.w); o.z = pack2(b.x, b.y); o.w = pack2(b.z, b.w);
    *(uint4*)(D + it * 8) = o;
  }
}
__device__ __forceinline__ void quant_rows(KP p, int r0) {
  char* ws = p->ws;
  {
    const int l = threadIdx.x & 63;
    for (int r = r0 + (threadIdx.x >> 6); r < r0 + 64; r += 4) {
      const int tbl = r >> 15, rr = r & 32767;
      const float* src = (tbl ? p->in[34] : p->in[33]) + (size_t)rr * 1024 + l * 16;
      f32x4 x[4];
#pragma unroll
      for (int i = 0; i < 4; ++i) x[i] = ld4(src + i * 4);
      float am = 0.f;
#pragma unroll
      for (int i = 0; i < 4; ++i)
#pragma unroll
        for (int j = 0; j < 4; ++j) am = fmaxf(am, fabsf(x[i][j]));
      am = row_max(am); am = fmaxf(am, __shfl_xor(am, 16)); am = fmaxf(am, __shfl_xor(am, 32));
      if (tbl) {
        float ssq = 0.f;
#pragma unroll
        for (int i = 0; i < 4; ++i)
#pragma unroll
          for (int j = 0; j < 4; ++j) ssq = fmaf(x[i][j], x[i][j], ssq);
        const float clipv = fminf(am, 2.75f * sqrtf(wave_sum(ssq) * (1.0f / 1024.0f)));
        const float inv = clipv > 0.f ? 7.5f / clipv : 0.f;
        unsigned o[2] = {0u, 0u};
#pragma unroll
        for (int i = 0; i < 4; ++i)
#pragma unroll
          for (int j = 0; j < 4; ++j) {
            int q = (int)floorf(x[i][j] * inv + 8.0f); q = q < 0 ? 0 : (q > 15 ? 15 : q);
            const int e = i * 4 + j;
            o[e >> 3] |= (unsigned)q << (4 * (e & 7));
          }
        *(uint2*)((unsigned char*)(ws + O_PV) + (size_t)rr * 512 + l * 8) = make_uint2(o[0], o[1]);
        if (l == 0) ((float*)(ws + O_SV))[rr] = clipv > 0.f ? clipv / 7.5f : 1.0f;
      } else {
        float ssq = 0.f;
#pragma unroll
        for (int i = 0; i < 4; ++i)
#pragma unroll
          for (int j = 0; j < 4; ++j) ssq = fmaf(x[i][j], x[i][j], ssq);
        const float clipv = fminf(am, 2.75f * sqrtf(wave_sum(ssq) * (1.0f / 1024.0f)));
        const float inv = clipv > 0.f ? 7.5f / clipv : 0.f;
        unsigned o[2] = {0u, 0u};
#pragma unroll
        for (int i = 0; i < 4; ++i)
#pragma unroll
          for (int j = 0; j < 4; ++j) {
            int q = (int)floorf(x[i][j] * inv + 8.0f); q = q < 0 ? 0 : (q > 15 ? 15 : q);
            const int e = i * 4 + j;
            o[e >> 3] |= (unsigned)q << (4 * (e & 7));
          }
        *(uint2*)((unsigned char*)(ws + O_PU) + (size_t)rr * 512 + l * 8) = make_uint2(o[0], o[1]);
        if (l == 0) ((float*)(ws + O_SU))[rr] = clipv > 0.f ? clipv / 7.5f : 1.0f;
      }
    }
  }
}

__device__ __forceinline__ void phase0(KP p) {
  const int gtid = blockIdx.x * 256 + threadIdx.x, gsz = gridDim.x * 256;
  char* ws = p->ws;
  for (int rep0 = 0; rep0 < REP_P0; ++rep0) {
  if (gtid < 64) ((int*)(ws + O_CNT))[gtid] = 0;
  if (gtid < 4096) ((int*)(ws + O_CUT))[gtid] = 0;
  if (blockIdx.x == 0) for (int i = threadIdx.x; i < XCD_BAR_WORDS; i += 256) ((unsigned*)(ws + O_BAR))[i] = 0u;
  for (int g = 0; g < 3; ++g) transpose_cvt(p->in[7] + (size_t)g * 1048576, (bf16*)(ws + O_WRKV) + (size_t)g * 1048576, 1024, 1024, gtid, gsz);
  transpose_cvt(p->in[9],  (bf16*)(ws + O_WL1), 1024, 64, gtid, gsz);
  transpose_cvt(p->in[12], (bf16*)(ws + O_WL1) + 64 * 1024, 1024, 64, gtid, gsz);
  transpose_cvt(p->in[14], (bf16*)(ws + O_WL1) + 128 * 1024, 1024, 128, gtid, gsz);
  transpose_cvt(p->in[10], (bf16*)(ws + O_W2T), 64, 1024, gtid, gsz);
  transpose_cvt(p->in[13], (bf16*)(ws + O_A2T), 64, 1024, gtid, gsz);
  transpose_cvt(p->in[15], (bf16*)(ws + O_G2T), 128, 1024, gtid, gsz);
  transpose_cvt(p->in[21], (bf16*)(ws + O_WOUT), 1024, 1024, gtid, gsz);
  transpose_cvt(p->in[22], (bf16*)(ws + O_WKV), 1024, 2048, gtid, gsz);
  transpose_cvt(p->in[23], (bf16*)(ws + O_WQ), 1024, 1024, gtid, gsz);
  transpose_cvt(p->in[26], (bf16*)(ws + O_WO), 1024, 1024, gtid, gsz);
  for (int g = 0; g < 2; ++g) transpose_cvt(p->in[31] + (size_t)g * 2097152, (bf16*)(ws + O_WPQ) + (size_t)g * 2097152, 1024, 2048, gtid, gsz);
  plain_cvt(p->in[32], (bf16*)(ws + O_SK), 65536 / 8, gtid, gsz);
  const float* mu = p->in[6];
  for (int it = gtid; it < NT * 128; it += gsz) {
    const int m = it >> 7, c8 = (it & 127) * 8;
    const float* xr = xin(p, m) + c8;
    const float* pr = nullptr; bool last; float* sho;
    if (m < NTP) { const int t = m & 2047; if (t) pr = xr - 1024; last = (t == 2047); sho = p->out + OFF_SHP + (size_t)(m >> 11) * 1024 + c8; }
    else { const int ms = m - NTP, t = ms & 15; pr = t ? xr - 1024 : p->in[3] + (size_t)(ms >> 4) * 1024 + c8; last = (t == 15); sho = p->out + OFF_SHS + (size_t)(ms >> 4) * 1024 + c8; }
    const f32x4 x0 = ld4(xr), x1 = ld4(xr + 4);
    f32x4 d0, d1;
    if (pr) { d0 = ld4(pr) - x0; d1 = ld4(pr + 4) - x1; } else { d0 = -x0; d1 = -x1; }
    if (last) { st4(sho, x0); st4(sho + 4, x1); }
#pragma unroll
    for (int i = 0; i < 6; ++i) {
      const f32x4 m0 = ld4(mu + i * 1024 + c8), m1 = ld4(mu + i * 1024 + c8 + 4);
      const f32x4 a = x0 + d0 * m0, b = x1 + d1 * m1;
      const uint2 pa = pack4(a), pb = pack4(b);
      *(uint4*)((bf16*)slot(p, i) + (size_t)m * 1024 + c8) = make_uint4(pa.x, pa.y, pb.x, pb.y);
    }
  }
  }
}

struct Job { const bf16* A; const bf16* B; int lda, ldb, K, nmax, mode, m0, n0, aux; };

__device__ __forceinline__ void get_job(KP p, int ph, int id, Job& j) {
  char* ws = p->ws;
  j.lda = 1024; j.ldb = 1024; j.K = 1024; j.nmax = 1 << 30; j.aux = 0;
  if (ph == 1) {
    if (id < 6192) { const int g = id / 2064, r = id % 2064; j.A = (const bf16*)slot(p, g); j.B = (const bf16*)(ws + O_WRKV) + (size_t)g * 1048576; j.mode = 0; j.aux = g; j.m0 = (r >> 3) * 128; j.n0 = (r & 7) * 128; }
    else { const int q = id - 6192, g = q / 258; j.A = (const bf16*)slot(p, 3 + g); j.B = (const bf16*)(ws + O_WL1) + (size_t)g * 65536; j.nmax = (g == 2) ? 128 : 64; j.mode = 1; j.aux = g; j.m0 = (q % 258) * 128; j.n0 = 0; }
  } else if (ph == 2) {
    const int g = id / 2064, r = id % 2064; j.m0 = (r >> 3) * 128; j.n0 = (r & 7) * 128; j.lda = 256; j.mode = 2 + g;
    if (g == 0) { j.A = (const bf16*)slot(p, 9); j.B = (const bf16*)(ws + O_W2T); j.K = 64; j.ldb = 64; }
    else if (g == 1) { j.A = (const bf16*)slot(p, 9) + 64; j.B = (const bf16*)(ws + O_A2T); j.K = 64; j.ldb = 64; }
    else { j.A = (const bf16*)slot(p, 9) + 128; j.B = (const bf16*)(ws + O_G2T); j.K = 128; j.ldb = 128; }
  } else if (ph == 4) {
    j.A = (const bf16*)slot(p, 4); j.B = (const bf16*)(ws + O_WOUT); j.mode = 5; j.m0 = (id >> 3) * 128; j.n0 = (id & 7) * 128;
  } else if (ph == 6 || ph == 12) {
    const int layer = (ph == 12); j.aux = layer;
    j.A = (const bf16*)slot(p, layer ? 4 : 5); j.B = (const bf16*)(ws + O_WPQ) + (size_t)layer * 2097152; j.mode = 6; j.m0 = (id >> 4) * 128; j.n0 = (id & 15) * 128;
  } else if (ph == 8) {
    j.A = (const bf16*)slot(p, 4);
    if (id < 4128) { j.B = (const bf16*)(ws + O_WKV); j.mode = 7; j.m0 = (id >> 4) * 128; j.n0 = (id & 15) * 128; }
    else { const int q = id - 4128; j.B = (const bf16*)(ws + O_WQ); j.mode = 8; j.m0 = (q >> 3) * 128; j.n0 = (q & 7) * 128; }
  } else {
    j.A = (const bf16*)slot(p, 8); j.B = (const bf16*)(ws + O_WO); j.mode = 9; j.m0 = (id >> 3) * 128; j.n0 = (id & 7) * 128;
  }
}

__device__ __forceinline__ f32x4 rope4(f32x4 v, int m, int l) {
  const int pos = (m < NTP) ? (m & 2047) : (4096 + ((m - NTP) & 15));
  const int g = l >> 4; const bool t2 = g >= 2; const int fb = (g & 1) * 4;
  f32x4 o;
#pragma unroll
  for (int r = 0; r < 4; ++r) {
    const float inv = exp2f(-(float)(fb + r) * (18.931568569324174f * 0.125f));
    const float ang = (float)pos * inv;
    float rev = ang * 0.15915494309189535f; rev -= rintf(rev);
    const float s = __builtin_amdgcn_sinf(rev), c = __builtin_amdgcn_cosf(rev);
    const float pr = __shfl_xor(v[r], 32);
    o[r] = v[r] * c + (t2 ? pr * s : -pr * s);
  }
  return o;
}

template <int MODE>
__device__ __forceinline__ void epilogue(KP p, const Job& jb, int m, int n, f32x4 v, int l) {
  const size_t mi = (size_t)m * 1024 + n;
  switch (MODE) {
    case 0: *(uint2*)((bf16*)slot(p, 6 + jb.aux) + mi) = pack4(v); break;
    case 1: if (n < jb.nmax) {
        f32x4 o;
#pragma unroll
        for (int r = 0; r < 4; ++r) o[r] = jb.aux == 0 ? 1.0f - 2.0f / (1.0f + __expf(2.0f * v[r])) : (jb.aux == 1 ? v[r] : 1.0f / (1.0f + __expf(-v[r])));
        *(uint2*)((bf16*)slot(p, 9) + (size_t)m * 256 + jb.aux * 64 + n) = pack4(o);
      } break;
    case 2: {
        const f32x4 w0 = ld4(p->in[8] + n); f32x4 o;
#pragma unroll
        for (int r = 0; r < 4; ++r) { const float z = w0[r] + v[r]; const float sp = __logf(1.0f + __expf(-z)); o[r] = __expf(-__expf(-sp - 0.5f)); }
        st4((float*)slot(p, 0) + mi, o);
      } break;
    case 3: {
        const f32x4 a0 = ld4(p->in[11] + n); f32x4 o;
#pragma unroll
        for (int r = 0; r < 4; ++r) o[r] = 1.0f / (1.0f + __expf(-(a0[r] + v[r])));
        *(uint2*)((bf16*)slot(p, 2) + mi) = pack4(o);
      } break;
    case 4: *(uint2*)((bf16*)slot(p, 3) + mi) = pack4(v); break;
    case 5: { const f32x4 x = ld4(xin(p, m) + n); st4((float*)slot(p, 0) + mi, x * 1.4142135623730951f + v); } break;
    case 9: { const f32x4 x = ld4((const float*)slot(p, 0) + mi); st4((float*)slot(p, 2) + mi, x * 1.4142135623730951f + v); } break;
    case 7: {
        if (n < 1024) {
          if ((n & 63) < 16) v = rope4(v, m, l);
          float* o = (m < NTP) ? p->out + OFF_CKP + mi : p->out + OFF_CKS + (size_t)(m - NTP) * 1024 + n;
          st4(o, v);
          *(uint2*)((bf16*)slot(p, 5) + mi) = pack4(v);
        } else {
          const int n2 = n - 1024, h = n2 >> 7, e = n2 & 127;
          float* o = (m < NTP) ? p->out + OFF_CVP + (size_t)m * 1024 + n2 : p->out + OFF_CVS + (size_t)(m - NTP) * 1024 + n2;
          st4(o, v);
          bf16* vt = (bf16*)slot(p, 6);
          if (m < NTP) { const int s = m >> 11, t = m & 2047;
#pragma unroll
            for (int r = 0; r < 4; ++r) vt[((size_t)((s * 8 + h) * 128 + e + r)) * 2048 + t] = f2b(v[r]);
          } else { const int ms = m - NTP, b = ms >> 4, t = ms & 15;
#pragma unroll
            for (int r = 0; r < 4; ++r) vt[(size_t)33554432 + ((size_t)((b * 8 + h) * 128 + e + r)) * 16 + t] = f2b(v[r]);
          }
        }
      } break;
    case 8: {
        if ((n & 63) < 16) v = rope4(v, m, l);
        *(uint2*)((bf16*)slot(p, 7) + mi) = pack4(v * 0.18033688011112042f);
      } break;
    default: break;
  }
}

__device__ __forceinline__ void peer_tail(KP p, const Job& jb, f32x4 (&acc)[4][4], char* lds, int tid) {
  const int l = tid & 63, w = tid >> 6, wm = w & 1, wn = w >> 1, g = l >> 4, li = l & 15;
#pragma unroll
  for (int j = 0; j < 4; ++j)
#pragma unroll
    for (int i = 0; i < 4; ++i) {
      const int d0 = wn * 64 + j * 16 + g * 4, tok = wm * 64 + i * 16 + li;
      *(uint2*)(lds + (d0 >> 5) * 8192 + swz(tok, (d0 & 31) >> 3) + ((d0 & 7) * 2)) = pack4(acc[j][i]);
    }
  __syncthreads();
  f32x4 sc[4][4];
#pragma unroll
  for (int j = 0; j < 4; ++j)
#pragma unroll
    for (int i = 0; i < 4; ++i) sc[j][i] = f32x4{0.f, 0.f, 0.f, 0.f};
#pragma unroll
  for (int ks = 0; ks < 4; ++ks) {
    s16x8 kf[4], qf[4];
#pragma unroll
    for (int j = 0; j < 4; ++j) kf[j] = *(const s16x8*)(lds + 32768 + ks * 8192 + swz(wn * 64 + j * 16 + li, g));
#pragma unroll
    for (int i = 0; i < 4; ++i) qf[i] = *(const s16x8*)(lds + ks * 8192 + swz(wm * 64 + i * 16 + li, g));
#pragma unroll
    for (int j = 0; j < 4; ++j)
#pragma unroll
      for (int i = 0; i < 4; ++i) sc[j][i] = __builtin_amdgcn_mfma_f32_16x16x32_bf16(kf[j], qf[i], sc[j][i], 0, 0, 0);
    __builtin_amdgcn_sched_barrier(0);
  }
  __syncthreads();
  unsigned* tko = (unsigned*)slot(p, jb.aux ? 5 : 6);
  const int nt = jb.n0 >> 7;
#pragma unroll 1
  for (int hm = 0; hm < 2; ++hm) {
    if (wm == hm) {
#pragma unroll
      for (int j = 0; j < 4; ++j)
#pragma unroll
        for (int i = 0; i < 4; ++i) {
          const int key0 = wn * 64 + j * 16 + g * 4, tokl = i * 16 + li;
          uint4 o;
          o.x = (f2ord(sc[j][i][0]) & ~127u) | (unsigned)(127 - key0);
          o.y = (f2ord(sc[j][i][1]) & ~127u) | (unsigned)(126 - key0);
          o.z = (f2ord(sc[j][i][2]) & ~127u) | (unsigned)(125 - key0);
          o.w = (f2ord(sc[j][i][3]) & ~127u) | (unsigned)(124 - key0);
          *(uint4*)(lds + (tokl * 132 + key0) * 4) = o;
        }
    }
    __syncthreads();
#pragma unroll 1
    for (int pass = 0; pass < 4; ++pass) {
      int tq = tid; asm volatile("" : "+v"(tq));
      const int tokl = pass * 16 + (tq >> 4), sub = tq & 15;
      const uint4 a = *(const uint4*)(lds + (tokl * 132 + sub * 8) * 4), b = *(const uint4*)(lds + (tokl * 132 + sub * 8 + 4) * 4);
      unsigned k0 = a.x, k1 = a.y, k2 = a.z, k3 = a.w, k4 = b.x, k5 = b.y, k6 = b.z, k7 = b.w, mine = 0;
#define CE(x, y) { const unsigned hi_ = umx(x, y), lo_ = x < y ? x : y; x = hi_; y = lo_; }
      CE(k0, k1) CE(k2, k3) CE(k4, k5) CE(k6, k7)
      CE(k0, k2) CE(k1, k3) CE(k4, k6) CE(k5, k7)
      CE(k1, k2) CE(k5, k6) CE(k0, k4) CE(k3, k7)
      CE(k1, k5) CE(k2, k6)
      CE(k1, k4) CE(k3, k6)
      CE(k2, k4) CE(k3, k5)
      CE(k3, k4)
#undef CE
#pragma unroll
      for (int it = 0; it < 16; ++it) {
        const unsigned mx = row_umax(k0);
        if (sub == it) mine = mx;
        const bool wn_ = (k0 == mx);
        k0 = wn_ ? k1 : k0; k1 = wn_ ? k2 : k1; k2 = wn_ ? k3 : k2; k3 = wn_ ? k4 : k3;
        k4 = wn_ ? k5 : k4; k5 = wn_ ? k6 : k5; k6 = wn_ ? k7 : k6; k7 = wn_ ? 0u : k7;
      }
      tko[(size_t)(jb.m0 + hm * 64 + tokl) * 256 + nt * 16 + sub] = mine;
    }
    __syncthreads();
  }
}

template <int PH, int MODE, int NTN>
__device__ __forceinline__ void gemm_range(KP p, int lo, int hi, int vlo, char* lds) {
  const int G = (hi - lo) / (258 * NTN);
  const int nv = G * 264 * NTN;
  int v0 = blockIdx.x;
  if (v0 < vlo) v0 += ((vlo - v0 + (int)gridDim.x - 1) / (int)gridDim.x) * (int)gridDim.x;
  for (int vv = v0; vv < vlo + nv * REP_GEMM; vv += gridDim.x) {
    const int v = REP_GEMM == 1 ? vv - vlo : (vv - vlo) % nv;
    const int gg = v / (264 * NTN), r = v % (264 * NTN);
    const int xcd = r & 7, jx = r >> 3, nt = jx % NTN, mt = (jx / NTN) * 8 + xcd;
    if (mt >= 258) continue;
    const int id = lo + (gg * 258 + mt) * NTN + nt;
    int tid = threadIdx.x;
    asm volatile("" : "+v"(tid));
    const int l = tid & 63, w = tid >> 6, wm = w & 1, wn = w >> 1, g = l >> 4, li = l & 15;
    Job jb; get_job(p, PH, id, jb);
    f32x4 acc[4][4];
#pragma unroll
    for (int j = 0; j < 4; ++j)
#pragma unroll
      for (int i = 0; i < 4; ++i) acc[j][i] = f32x4{0.f, 0.f, 0.f, 0.f};
    const int lrow = tid >> 3, lkq = tid & 7;
    const int so = (lkq >> 2) * 8192 + swz(lrow, lkq & 3);
    const bf16* ga = jb.A + (size_t)(jb.m0 + lrow) * jb.lda + lkq * 8;
    const size_t sa = (size_t)32 * jb.lda;
    const bf16* gb0 = jb.B + (size_t)min(jb.n0 + lrow, jb.nmax - 1) * jb.ldb + lkq * 8;
    const bf16* gb1 = jb.B + (size_t)min(jb.n0 + lrow + 32, jb.nmax - 1) * jb.ldb + lkq * 8;
    const bf16* gb2 = jb.B + (size_t)min(jb.n0 + lrow + 64, jb.nmax - 1) * jb.ldb + lkq * 8;
    const bf16* gb3 = jb.B + (size_t)min(jb.n0 + lrow + 96, jb.nmax - 1) * jb.ldb + lkq * 8;
    uint4 r0a, r0b, r0c, r0d, r0e, r0f, r0g, r0h, r1a, r1b, r1c, r1d, r1e, r1f, r1g, r1h, r2a, r2b, r2c, r2d, r2e, r2f, r2g, r2h;
#define G_LOAD(S, t) { const int ko_ = (t) * 64; r##S##a = *(const uint4*)(ga + ko_); r##S##b = *(const uint4*)(ga + sa + ko_); r##S##c = *(const uint4*)(ga + 2 * sa + ko_); r##S##d = *(const uint4*)(ga + 3 * sa + ko_); \
      r##S##e = *(const uint4*)(gb0 + ko_); r##S##f = *(const uint4*)(gb1 + ko_); r##S##g = *(const uint4*)(gb2 + ko_); r##S##h = *(const uint4*)(gb3 + ko_); }
#define S_WRITE(S, buf) { char* nb_ = lds + (buf) * 32768 + so; *(uint4*)(nb_) = r##S##a; *(uint4*)(nb_ + 2048) = r##S##b; *(uint4*)(nb_ + 4096) = r##S##c; *(uint4*)(nb_ + 6144) = r##S##d; \
      *(uint4*)(nb_ + 16384) = r##S##e; *(uint4*)(nb_ + 18432) = r##S##f; *(uint4*)(nb_ + 20480) = r##S##g; *(uint4*)(nb_ + 22528) = r##S##h; }
#define K_STEP(u, SL, SW, DIST) { const int kt = kb + (u); if (kt < KT) { \
          if (kt + (DIST) < KT) G_LOAD(SL, kt + (DIST)); \
          const char* sb = lds + ((u) & 1) * 32768; \
          _Pragma("unroll") for (int ks = 0; ks < 2; ++ks) { \
            s16x8 xf[4], wf[4]; \
            _Pragma("unroll") for (int i = 0; i < 4; ++i) xf[i] = *(const s16x8*)(sb + ks * 8192 + swz(wm * 64 + i * 16 + li, g)); \
            _Pragma("unroll") for (int j = 0; j < 4; ++j) wf[j] = *(const s16x8*)(sb + 16384 + ks * 8192 + swz(wn * 64 + j * 16 + li, g)); \
            _Pragma("unroll") for (int j = 0; j < 4; ++j) \
              _Pragma("unroll") for (int i = 0; i < 4; ++i) acc[j][i] = __builtin_amdgcn_mfma_f32_16x16x32_bf16(wf[j], xf[i], acc[j][i], 0, 0, 0); \
          } \
          if (kt + 1 < KT) S_WRITE(SW, ((u) + 1) & 1); \
          __syncthreads(); } }
    const int KT = jb.K >> 6;
    if (MODE == 6) {
      G_LOAD(0, 0);
      S_WRITE(0, 0);
      __syncthreads();
      for (int kb = 0; kb < KT; kb += 2) {
        K_STEP(0, 0, 0, 1)
        K_STEP(1, 0, 0, 1)
      }
      const bf16* sk = (const bf16*)(p->ws + O_SK) + (size_t)jb.aux * 32768 + (size_t)((jb.n0 >> 7) & 1) * 16384;
#pragma unroll
      for (int i = 0; i < 8; ++i) {
        const int q = tid + i * 256, key = q >> 4, dc = q & 15;
        *(uint4*)(lds + 32768 + (dc >> 2) * 8192 + swz(key, dc & 3)) = *(const uint4*)(sk + key * 128 + dc * 8);
      }
    } else {
      G_LOAD(0, 0);
      if (KT > 1) G_LOAD(1, 1);
      if (KT > 2) G_LOAD(2, 2);
      S_WRITE(0, 0);
      __syncthreads();
      for (int kb = 0; kb < KT; kb += 6) {
        K_STEP(0, 0, 1, 3)
        K_STEP(1, 1, 2, 3)
        K_STEP(2, 2, 0, 3)
        K_STEP(3, 0, 1, 3)
        K_STEP(4, 1, 2, 3)
        K_STEP(5, 2, 0, 3)
      }
    }
#undef G_LOAD
#undef S_WRITE
#undef K_STEP
    if (MODE == 6) peer_tail(p, jb, acc, lds, tid);
    else {
#pragma unroll
      for (int j = 0; j < 4; ++j)
#pragma unroll
        for (int i = 0; i < 4; ++i)
        {
          epilogue<MODE>(p, jb, jb.m0 + wm * 64 + i * 16 + li, jb.n0 + wn * 64 + j * 16 + g * 4, acc[j][i], l);
        }
    }
  }
}
template <int ph>
__device__ __forceinline__ void phase_gemm(KP p, char* lds) {
  switch (ph) {
    case 1: gemm_range<1, 0, 8>(p, 0, 6192, 0, lds); gemm_range<1, 1, 1>(p, 6192, 6966, 6336, lds); break;
    case 2: gemm_range<2, 2, 8>(p, 0, 2064, 0, lds); gemm_range<2, 3, 8>(p, 2064, 4128, 2112, lds); gemm_range<2, 4, 8>(p, 4128, 6192, 4224, lds); break;
    case 4: gemm_range<4, 5, 8>(p, 0, 2064, 0, lds); break;
    case 6: gemm_range<6, 6, 16>(p, 0, 4128, 0, lds); break;
    case 8: gemm_range<8, 7, 16>(p, 0, 4128, 0, lds); gemm_range<8, 8, 8>(p, 4128, 6192, 4224, lds); break;
    case 10: gemm_range<10, 9, 8>(p, 0, 2064, 0, lds); break;
    default: gemm_range<12, 6, 16>(p, 0, 4128, 0, lds); break;
  }
}

__device__ __forceinline__ void phase_scan(KP p, char* lds) {
  const int tid = threadIdx.x, l = tid & 63, w = tid >> 6;
  const int row0 = w * 16 + (l >> 3) * 2, col0 = (l & 7) * 8;
  const int lt = tid >> 4, lc = (tid & 15) * 4;
  const bf16* Rb = (const bf16*)slot(p, 6); const bf16* Kb = (const bf16*)slot(p, 7); const bf16* Vb = (const bf16*)slot(p, 8);
  const float* Dc = (const float*)slot(p, 0); const bf16* Ab = (const bf16*)slot(p, 2); const bf16* Gb = (const bf16*)slot(p, 3);
  bf16* YG = (bf16*)slot(p, 4);
  float* ybuf = (float*)(lds + 49152);
  float* cbuf = (float*)(lds + 53248);
  int* s_it = (int*)(lds + 65520);
  int* qL = (int*)(p->ws + O_CNT) + 60; int* qS = qL + 1;
  int role = 0;
  if (threadIdx.x == 0) {
    const unsigned hw = (unsigned)__builtin_amdgcn_s_getreg((7 << 11) | (8 << 6) | 4);
    role = atomicAdd((int*)(p->ws + O_CUT) + ((xb_xcc_id() & 15u) * 256 + (hw & 255u)), 1);
  }
  for (;;) {
    __syncthreads();
    if (tid == 0) {
      int got = -1;
      if (role == 0) { int j = atomicAdd(qL, 1); if (j < 256 * REP_SCAN) got = j & 255; else { j = atomicAdd(qS, 1); if (j < 256) got = 256 + j; } }
      else { int j = atomicAdd(qS, 1); if (j < 256) got = 256 + j; else { j = atomicAdd(qL, 1); if (j < 256 * REP_SCAN) got = j & 255; } }
      *s_it = got;
    }
    __syncthreads();
    const int item = *s_it;
    if (item < 0) break;
    const int seq = item >> 4, h = item & 15;
    const bool samp = seq >= 16; const int b = seq & 15;
    const int nch = samp ? 1 : 128;
    const int tok0 = samp ? NTP + b * 16 : b * 2048;
    f32x2 S2[2][4];
#pragma unroll
    for (int rr = 0; rr < 2; ++rr) {
      if (samp) {
        const float* sp = p->in[2] + ((size_t)(b * 16 + h) * 64 + row0 + rr) * 64 + col0;
        const f32x4 a = ld4(sp), c = ld4(sp + 4);
        S2[rr][0] = f32x2{a[0], a[1]}; S2[rr][1] = f32x2{a[2], a[3]}; S2[rr][2] = f32x2{c[0], c[1]}; S2[rr][3] = f32x2{c[2], c[3]};
      } else {
#pragma unroll
        for (int i = 0; i < 4; ++i) S2[rr][i] = f32x2{0.f, 0.f};
      }
    }
    const int ch0 = h * 64 + lc;
    const f32x4 kk4 = ld4(p->in[16] + ch0), ka4 = ld4(p->in[17] + ch0), rk4 = ld4(p->in[18] + ch0);
    const f32x4 lng = ld4(p->in[19] + ch0), lnb = ld4(p->in[20] + ch0);
    uint2 rr_, rk_, rv_, ra_; f32x4 rd_;
    auto issue = [&](int ch) {
      const size_t off = (size_t)(tok0 + ch * 16 + lt) * 1024 + ch0;
      rr_ = *(const uint2*)(Rb + off); rk_ = *(const uint2*)(Kb + off); rv_ = *(const uint2*)(Vb + off); ra_ = *(const uint2*)(Ab + off);
      rd_ = ld4(Dc + off);
    };
    auto stage = [&](int buf) {
      const f32x4 r4 = unpack4(rr_), k4 = unpack4(rk_), v4 = unpack4(rv_), a4 = unpack4(ra_);
      const f32x4 kkr = k4 * kk4;
      float ss = kkr[0] * kkr[0] + kkr[1] * kkr[1] + kkr[2] * kkr[2] + kkr[3] * kkr[3];
      ss = row_sum(ss);
      const float inv = 1.0f / fmaxf(sqrtf(ss), 1e-12f);
      const f32x4 kkn = kkr * inv;
      const f32x4 kp = k4 * (1.0f + (a4 - 1.0f) * ka4);
      const f32x4 kka = kkn * a4;
      const f32x4 t = r4 * kp * rk4;
      float cb = row_sum(t[0] + t[1] + t[2] + t[3]);
      char* bp = lds + buf * 24576 + lt * 256 + lc * 4;
      st4((float*)(bp), r4); st4((float*)(bp + 4096), rd_); st4((float*)(bp + 8192), kp);
      st4((float*)(bp + 12288), kkn); st4((float*)(bp + 16384), kka); st4((float*)(bp + 20480), v4);
      if ((tid & 15) == 0) cbuf[buf * 16 + lt] = cb;
    };
    __syncthreads();
    issue(0); stage(0);
    __syncthreads();
    for (int ch = 0; ch < nch; ++ch) {
      const int cur = ch & 1;
      const bool more = ch + 1 < nch;
      const size_t goff = (size_t)(tok0 + ch * 16 + lt) * 1024 + ch0;
      const uint2 gq = *(const uint2*)(Gb + goff);
      if (more) issue(ch + 1);
#pragma unroll
      for (int t = 0; t < 16; ++t) {
        const char* bp = lds + cur * 24576 + t * 256 + col0 * 4;
        f32x2 rv[4], dv[4], kv[4], qv[4], av[4];
#pragma unroll
        for (int hh = 0; hh < 2; ++hh) {
          const float4 a0 = *(const float4*)(bp + hh * 16), b0 = *(const float4*)(bp + 4096 + hh * 16), c0 = *(const float4*)(bp + 8192 + hh * 16);
          const float4 d0 = *(const float4*)(bp + 12288 + hh * 16), e0 = *(const float4*)(bp + 16384 + hh * 16);
          rv[2 * hh] = f32x2{a0.x, a0.y}; rv[2 * hh + 1] = f32x2{a0.z, a0.w};
          dv[2 * hh] = f32x2{b0.x, b0.y}; dv[2 * hh + 1] = f32x2{b0.z, b0.w};
          kv[2 * hh] = f32x2{c0.x, c0.y}; kv[2 * hh + 1] = f32x2{c0.z, c0.w};
          qv[2 * hh] = f32x2{d0.x, d0.y}; qv[2 * hh + 1] = f32x2{d0.z, d0.w};
          av[2 * hh] = f32x2{e0.x, e0.y}; av[2 * hh + 1] = f32x2{e0.z, e0.w};
        }
        const float2 vv = *(const float2*)(lds + cur * 24576 + t * 256 + 20480 + row0 * 4);
        float yo[2];
#pragma unroll
        for (int rr = 0; rr < 2; ++rr) {
          f32x2 sa = S2[rr][0] * qv[0];
          sa = S2[rr][1] * qv[1] + sa; sa = S2[rr][2] * qv[2] + sa; sa = S2[rr][3] * qv[3] + sa;
          const float skk = oct_sum(sa.x + sa.y);
          const float vr = rr ? vv.y : vv.x;
          const f32x2 vr2 = {vr, vr}, ns2 = {-skk, -skk};
#pragma unroll
          for (int c = 0; c < 4; ++c) { const f32x2 tt = S2[rr][c] * dv[c] + vr2 * kv[c]; S2[rr][c] = ns2 * av[c] + tt; }
          f32x2 ya = S2[rr][0] * rv[0];
          ya = S2[rr][1] * rv[1] + ya; ya = S2[rr][2] * rv[2] + ya; ya = S2[rr][3] * rv[3] + ya;
          yo[rr] = oct_sum(ya.x + ya.y);
        }
        if ((l & 7) == 0) *(float2*)(ybuf + t * 64 + row0) = make_float2(yo[0], yo[1]);
      }
      __syncthreads();
      {
        const f32x4 y4 = ld4(ybuf + lt * 64 + lc);
        const float mean = row_sum(y4[0] + y4[1] + y4[2] + y4[3]) * (1.0f / 64.0f);
        const f32x4 dy = y4 - mean;
        const float var = row_sum(dy[0] * dy[0] + dy[1] * dy[1] + dy[2] * dy[2] + dy[3] * dy[3]) * (1.0f / 64.0f);
        const float rs = rsqrtf(var + 64e-5f);
        const f32x4 v4 = ld4((const float*)(lds + cur * 24576 + 20480 + lt * 256 + lc * 4));
        const float cb = cbuf[cur * 16 + lt];
        const f32x4 g4 = unpack4(gq);
        const f32x4 o = (dy * rs * lng + lnb + v4 * cb) * g4;
        *(uint2*)(YG + goff) = pack4(o);
      }
      if (more) stage(cur ^ 1);
      __syncthreads();
    }
    float* so = p->out + (samp ? OFF_WKVS : OFF_WKVP) + ((size_t)(b * 16 + h) * 64 + row0) * 64 + col0;
#pragma unroll
    for (int rr = 0; rr < 2; ++rr) {
      st4(so + rr * 64, f32x4{S2[rr][0].x, S2[rr][0].y, S2[rr][1].x, S2[rr][1].y});
      st4(so + rr * 64 + 4, f32x4{S2[rr][2].x, S2[rr][2].y, S2[rr][3].x, S2[rr][3].y});
    }
  }
  int* qQ = (int*)(p->ws + O_CNT) + 62;
  for (;;) {
    __syncthreads();
    if (tid == 0) *s_it = atomicAdd(qQ, 1);
    __syncthreads();
    const int ch = *s_it;
    if (ch >= 1024) break;
    quant_rows(p, ch * 64);
  }
}

__device__ __forceinline__ void phase_ln(KP p, const float* src, float* d32, bf16* db, const float* gam, const float* bet) {
  const int tid_ = otid();
  const int l = tid_ & 63, w = tid_ >> 6;
  for (int m = blockIdx.x * 4 + w; m < NT; m += gridDim.x * 4) {
    const float* s = src + (size_t)m * 1024;
    f32x4 x[4];
#pragma unroll
    for (int i = 0; i < 4; ++i) x[i] = ld4(s + i * 256 + l * 4);
    float sm = 0.f;
#pragma unroll
    for (int i = 0; i < 4; ++i) sm += x[i][0] + x[i][1] + x[i][2] + x[i][3];
    const float mean = wave_sum(sm) * (1.0f / 1024.0f);
    float sq = 0.f;
#pragma unroll
    for (int i = 0; i < 4; ++i) { x[i] = x[i] - mean; sq += x[i][0] * x[i][0] + x[i][1] * x[i][1] + x[i][2] * x[i][2] + x[i][3] * x[i][3]; }
    const float rs = rsqrtf(wave_sum(sq) * (1.0f / 1024.0f) + 1e-5f);
#pragma unroll
    for (int i = 0; i < 4; ++i) {
      const int e = i * 256 + l * 4;
      const f32x4 y = x[i] * rs * ld4(gam + e) + ld4(bet + e);
      st4(d32 + (size_t)m * 1024 + e, y);
      *(uint2*)(db + (size_t)m * 1024 + e) = pack4(y);
    }
  }
}

__device__ __forceinline__ float dotq4(unsigned u, const float* x, float d) {
  d = fmaf((float)(u & 255u), x[0], d); d = fmaf((float)((u >> 8) & 255u), x[1], d);
  d = fmaf((float)((u >> 16) & 255u), x[2], d); d = fmaf((float)(u >> 24), x[3], d);
  return d;
}
__device__ __forceinline__ float dotq(uint4 u, const float* x) {
  return dotq4(u.x, x, 0.f) + dotq4(u.y, x + 4, 0.f) + dotq4(u.z, x + 8, 0.f) + dotq4(u.w, x + 12, 0.f);
}
__device__ __forceinline__ void axq4(unsigned u, float a, float* o) {
  o[0] = fmaf(a, (float)(u & 255u), o[0]); o[1] = fmaf(a, (float)((u >> 8) & 255u), o[1]);
  o[2] = fmaf(a, (float)((u >> 16) & 255u), o[2]); o[3] = fmaf(a, (float)(u >> 24), o[3]);
}
__device__ __forceinline__ void axq(uint4 u, float a, float* o) { axq4(u.x, a, o); axq4(u.y, a, o + 4); axq4(u.z, a, o + 8); axq4(u.w, a, o + 12); }
__device__ __forceinline__ float reduce8(const float* pp, int l) {
  const bool b0 = l & 1, b1 = l & 2, b2 = l & 4;
  float a[4], bb[2];
#pragma unroll
  for (int i = 0; i < 4; ++i) { const float keep = b0 ? pp[2 * i + 1] : pp[2 * i], send = b0 ? pp[2 * i] : pp[2 * i + 1]; a[i] = keep + dppf<0xB1>(send); }
#pragma unroll
  for (int i = 0; i < 2; ++i) { const float keep = b1 ? a[2 * i + 1] : a[2 * i], send = b1 ? a[2 * i] : a[2 * i + 1]; bb[i] = keep + dppf<0x4E>(send); }
  const float keep = b2 ? bb[1] : bb[0], send = b2 ? bb[0] : bb[1];
  float c = keep + dppf<0x124>(send);
  c += dppf<0x128>(c);
  c += __shfl_xor(c, 16); c += __shfl_xor(c, 32);
  return c;
}

__device__ __forceinline__ void phase_peer_experts(KP p, int layer) {
  const int tid_ = otid();
  const int l = tid_ & 63, w = tid_ >> 6;
  const unsigned* TK = (const unsigned*)slot(p, layer ? 5 : 6);
  const float* X = (const float*)slot(p, layer ? 0 : 2);
  const unsigned char* PU = (const unsigned char*)(p->ws + O_PU) + (size_t)layer * 8388608;
  const unsigned char* PV = (const unsigned char*)(p->ws + O_PV) + (size_t)layer * 8388608;
  const float* SU = (const float*)(p->ws + O_SU) + layer * 16384;
  const float* SV = (const float*)(p->ws + O_SV) + layer * 16384;
  const float* lg = p->in[29] + layer * 1024; const float* lb = p->in[30] + layer * 1024;
  const int hq = l >> 4, r = l & 15;
  unsigned cd[4];
#pragma unroll
  for (int c = 0; c < 4; ++c) cd[c] = CAND[r * 4 + c];
  for (int mv = blockIdx.x * 4 + w; mv < NT * REP_PE; mv += gridDim.x * 4) {
    const int m = REP_PE == 1 ? mv : mv % NT;
    const unsigned* tk = TK + (size_t)m * 256;
    int eidx[2]; float gate[2];
#pragma unroll
    for (int pass = 0; pass < 2; ++pass) {
      const int h = pass * 4 + hq;
      unsigned k[4];
#pragma unroll
      for (int c = 0; c < 4; ++c) {
        const unsigned ab = cd[c] == 255u ? 0u : cd[c];
        const unsigned k1 = tk[h * 32 + (ab >> 4)], k2 = tk[h * 32 + 16 + (ab & 15)];
        const float s = ord2f(k1 & ~127u) + ord2f(k2 & ~127u);
        k[c] = cd[c] == 255u ? 0u : ((f2ord(s) & ~255u) | (255u - cd[c]));
      }
      unsigned mine = 0;
#pragma unroll
      for (int it = 0; it < 16; ++it) {
        unsigned mx = umx(umx(k[0], k[1]), umx(k[2], k[3]));
        mx = row_umax(mx);
        if (r == it) mine = mx;
#pragma unroll
        for (int c = 0; c < 4; ++c) k[c] = (k[c] == mx) ? 0u : k[c];
      }
      const unsigned pos = 255u - (mine & 255u);
      const unsigned k1 = tk[h * 32 + (pos >> 4)], k2 = tk[h * 32 + 16 + (pos & 15)];
      eidx[pass] = (int)((127u - (k1 & 127u)) * 128u + (127u - (k2 & 127u)));
      const float s = ord2f(mine & ~255u);
      const float mxs = row_max(s);
      const float ex = __expf(s - mxs);
      gate[pass] = ex / row_sum(ex);
    }
    const float* xr = X + (size_t)m * 1024;
    float xv[16], out[16];
    {
      const f32x4 a = ld4(xr + l * 16), b = ld4(xr + l * 16 + 4), c = ld4(xr + l * 16 + 8), d = ld4(xr + l * 16 + 12);
#pragma unroll
      for (int i = 0; i < 4; ++i) { xv[i] = a[i]; xv[4 + i] = b[i]; xv[8 + i] = c[i]; xv[12 + i] = d[i]; }
    }
    float xam = 0.f;
#pragma unroll
    for (int i = 0; i < 16; ++i) { out[i] = 0.f; xam = fmaxf(xam, fabsf(xv[i])); }
    xam = row_max(xam); xam = fmaxf(xam, __shfl_xor(xam, 16)); xam = fmaxf(xam, __shfl_xor(xam, 32));
    const float xinv = xam > 0.f ? 127.0f / xam : 0.f, xs = xam * (1.0f / 127.0f);
    int xq[16]; int sqi = 0;
#pragma unroll
    for (int i = 0; i < 16; ++i) { xq[i] = (int)rintf(xv[i] * xinv); sqi += xq[i]; }
    int xe0 = (xq[0] & 255) | ((xq[2] & 255) << 8) | ((xq[4] & 255) << 16) | (xq[6] << 24);
    int xo0 = (xq[1] & 255) | ((xq[3] & 255) << 8) | ((xq[5] & 255) << 16) | (xq[7] << 24);
    int xe1 = (xq[8] & 255) | ((xq[10] & 255) << 8) | ((xq[12] & 255) << 16) | (xq[14] << 24);
    int xo1 = (xq[9] & 255) | ((xq[11] & 255) << 8) | ((xq[13] & 255) << 16) | (xq[15] << 24);
    const float sx = wave_sum((float)sqi);
    float csum = 0.f;
    uint2 ua[8], ub[8];
    uint2 va[8], vb[8];
#define LD_U(dst, ps, s0) { _Pragma("unroll") for (int k = 0; k < 8; ++k) dst[k] = *(const uint2*)(PU + (size_t)__builtin_amdgcn_readlane(eidx[ps], (s0) + k) * 512 + l * 8); }
#define LD_V(dst, ps, s0) { _Pragma("unroll") for (int k = 0; k < 8; ++k) dst[k] = *(const uint2*)(PV + (size_t)__builtin_amdgcn_readlane(eidx[ps], (s0) + k) * 512 + l * 8); }
#define DO_U(buf, s0, MD) { float pp[8]; \
        _Pragma("unroll") for (int k = 0; k < 8; ++k) { \
          const unsigned w0 = buf[k].x, w1 = buf[k].y; \
          int a_ = __builtin_amdgcn_sdot4((int)(w0 & 0x0F0F0F0Fu), xe0, 0, false); \
          a_ = __builtin_amdgcn_sdot4((int)((w0 >> 4) & 0x0F0F0F0Fu), xo0, a_, false); \
          a_ = __builtin_amdgcn_sdot4((int)(w1 & 0x0F0F0F0Fu), xe1, a_, false); \
          a_ = __builtin_amdgcn_sdot4((int)((w1 >> 4) & 0x0F0F0F0Fu), xo1, a_, false); \
          pp[k] = (float)a_; } \
        const float c_ = reduce8(pp, l); \
        if ((l >> 3) == ((s0) >> 3)) MD = c_; }
#define TR4(d0, d1, d2, d3, A4, o) { \
          const unsigned pl_ = __builtin_amdgcn_perm(d1, d0, 0x05010400u), ph_ = __builtin_amdgcn_perm(d1, d0, 0x07030602u); \
          const unsigned ql_ = __builtin_amdgcn_perm(d3, d2, 0x05010400u), qh_ = __builtin_amdgcn_perm(d3, d2, 0x07030602u); \
          iacc[(o) + 0] = __builtin_amdgcn_sdot4((int)__builtin_amdgcn_perm(ql_, pl_, 0x05040100u), A4, iacc[(o) + 0], false); \
          iacc[(o) + 2] = __builtin_amdgcn_sdot4((int)__builtin_amdgcn_perm(ql_, pl_, 0x07060302u), A4, iacc[(o) + 2], false); \
          iacc[(o) + 4] = __builtin_amdgcn_sdot4((int)__builtin_amdgcn_perm(qh_, ph_, 0x05040100u), A4, iacc[(o) + 4], false); \
          iacc[(o) + 6] = __builtin_amdgcn_sdot4((int)__builtin_amdgcn_perm(qh_, ph_, 0x07060302u), A4, iacc[(o) + 6], false); }
#define NLO(w) ((w) & 0x0F0F0F0Fu)
#define NHI(w) (((w) >> 4) & 0x0F0F0F0Fu)
#define DO_V(buf, s0, CQ) { _Pragma("unroll") for (int hb = 0; hb < 2; ++hb) { \
          const int c0_ = __builtin_amdgcn_readlane(CQ, (s0) + hb * 4), c1_ = __builtin_amdgcn_readlane(CQ, (s0) + hb * 4 + 1); \
          const int c2_ = __builtin_amdgcn_readlane(CQ, (s0) + hb * 4 + 2), c3_ = __builtin_amdgcn_readlane(CQ, (s0) + hb * 4 + 3); \
          const int a4_ = (c0_ & 255) | ((c1_ & 255) << 8) | ((c2_ & 255) << 16) | ((c3_ & 255) << 24); \
          TR4(NLO(buf[hb * 4].x), NLO(buf[hb * 4 + 1].x), NLO(buf[hb * 4 + 2].x), NLO(buf[hb * 4 + 3].x), a4_, 0) \
          TR4(NHI(buf[hb * 4].x), NHI(buf[hb * 4 + 1].x), NHI(buf[hb * 4 + 2].x), NHI(buf[hb * 4 + 3].x), a4_, 1) \
          TR4(NLO(buf[hb * 4].y), NLO(buf[hb * 4 + 1].y), NLO(buf[hb * 4 + 2].y), NLO(buf[hb * 4 + 3].y), a4_, 8) \
          TR4(NHI(buf[hb * 4].y), NHI(buf[hb * 4 + 1].y), NHI(buf[hb * 4 + 2].y), NHI(buf[hb * 4 + 3].y), a4_, 9) } }
#define CQUANT(WG, CQ, CS) float CS; int CQ; { float cm_ = fabsf(WG); cm_ = row_max(cm_); cm_ = fmaxf(cm_, __shfl_xor(cm_, 16)); cm_ = fmaxf(cm_, __shfl_xor(cm_, 32)); \
          CS = cm_ * (1.0f / 127.0f); CQ = (int)rintf(WG * (cm_ > 0.f ? 127.0f / cm_ : 0.f)); }
#define CSUM(CQ) wave_sum((float)CQ)
#define FLUSH(CS, SUMQ) { const float off_ = 7.5f * (SUMQ); _Pragma("unroll") for (int i = 0; i < 16; ++i) { out[i] = fmaf(CS, (float)iacc[i] - off_, out[i]); iacc[i] = 0; } }
    float md0 = 0.f, md1 = 0.f;
    int iacc[16];
#pragma unroll
    for (int i = 0; i < 16; ++i) iacc[i] = 0;
    LD_U(ua, 0, 0)
#pragma unroll 1
    for (int s = 0; s < 64; s += 16) {
      LD_U(ub, 0, s + 8)
      DO_U(ua, s, md0)
      if (s + 16 < 64) LD_U(ua, 0, s + 16) else { LD_V(va, 0, 0) LD_U(ua, 1, 0) }
      DO_U(ub, s + 8, md0)
    }
    const float su0 = SU[eidx[0]], sv0 = SV[eidx[0]];
    const float hh0 = su0 * xs * (md0 - 7.5f * sx);
    const float wgt0 = gate[0] * 0.5f * hh0 * (1.0f + erff(hh0 * 0.70710678118654752f)) * sv0;
    CQUANT(wgt0, cq0, cs0)
    const float sq0 = CSUM(cq0);
#pragma unroll 1
    for (int s = 0; s < 64; s += 16) {
      LD_V(vb, 0, s + 8) LD_U(ub, 1, s + 8)
      DO_V(va, s, cq0) DO_U(ua, s, md1)
      if (s + 16 < 64) { LD_V(va, 0, s + 16) LD_U(ua, 1, s + 16) } else LD_V(va, 1, 0)
      DO_V(vb, s + 8, cq0) DO_U(ub, s + 8, md1)
    }
    const float su1 = SU[eidx[1]], sv1 = SV[eidx[1]];
    const float hh1 = su1 * xs * (md1 - 7.5f * sx);
    FLUSH(cs0, sq0)
    const float wgt1 = gate[1] * 0.5f * hh1 * (1.0f + erff(hh1 * 0.70710678118654752f)) * sv1;
    CQUANT(wgt1, cq1, cs1)
    const float sq1 = CSUM(cq1);
#pragma unroll 1
    for (int s = 0; s < 64; s += 16) {
      LD_V(vb, 1, s + 8)
      DO_V(va, s, cq1)
      if (s + 16 < 64) LD_V(va, 1, s + 16)
      DO_V(vb, s + 8, cq1)
    }
    FLUSH(cs1, sq1)
#undef LD_U
#undef LD_V
#undef DO_U
#undef DO_V
#undef TR4
#undef NLO
#undef NHI
#undef CSUM
#undef CQUANT
#undef FLUSH
    float sm = 0.f;
#pragma unroll
    for (int i = 0; i < 16; ++i) { out[i] = fmaf(xv[i], 1.4142135623730951f, out[i]); sm += out[i]; }
    const float mean = wave_sum(sm) * (1.0f / 1024.0f);
    float sq = 0.f;
#pragma unroll
    for (int i = 0; i < 16; ++i) { out[i] -= mean; sq = fmaf(out[i], out[i], sq); }
    const float rs = rsqrtf(wave_sum(sq) * (1.0f / 1024.0f) + 1e-5f);
    float* d32 = layer ? ((m < NTP) ? p->out + OFF_YP + (size_t)m * 1024 : p->out + OFF_YS + (size_t)(m - NTP) * 1024)
                       : (float*)slot(p, 0) + (size_t)m * 1024;
#pragma unroll
    for (int hf = 0; hf < 2; ++hf) {
      const int e = l * 16 + hf * 8;
      const f32x4 g0 = ld4(lg + e), g1 = ld4(lg + e + 4), b0 = ld4(lb + e), b1 = ld4(lb + e + 4);
      f32x4 y0, y1;
#pragma unroll
      for (int i = 0; i < 4; ++i) { y0[i] = out[hf * 8 + i] * rs * g0[i] + b0[i]; y1[i] = out[hf * 8 + 4 + i] * rs * g1[i] + b1[i]; }
      st4(d32 + e, y0); st4(d32 + e + 4, y1);
      if (!layer) {
        const uint2 pa = pack4(y0), pb = pack4(y1);
        *(uint4*)((bf16*)slot(p, 4) + (size_t)m * 1024 + e) = make_uint4(pa.x, pa.y, pb.x, pb.y);
      }
    }
  }
}

__device__ __forceinline__ void phase_attn(KP p, char* lds) {
  const int tid = threadIdx.x, l = tid & 63, w = tid >> 6, c = w & 1, qh = w >> 1, g = l >> 4, li = l & 15;
  int* s_item = (int*)(lds + 65520);
  int* counter = (int*)(p->ws + O_CNT);
  const float* lp = p->in[24];
  const float s1 = wave_sum(lp[l] * lp[64 + l]), s2 = wave_sum(lp[128 + l] * lp[192 + l]);
  const float lam = __expf(s1) - __expf(s2) + 0.35550906759f;
  const bf16* Kb = (const bf16*)slot(p, 5); const bf16* VT = (const bf16*)slot(p, 6);
  const bf16* Qb = (const bf16*)slot(p, 7); bf16* Ob = (bf16*)slot(p, 8);
  const float* ck = p->in[4]; const float* cv = p->in[5];
  const float* sg = p->in[25];
  const int myq = (int)(xb_xcc_id() & 7u);
  int qoff = 0;
  for (;;) {
    __syncthreads();
    if (tid == 0) {
      int got = -1;
      while (qoff < 8) {
        const int qx = (myq + qoff) & 7;
        const int j = atomicAdd(counter + qx * 8, 1);
        if (j < 640 * REP_ATTN) { got = qx * 1024 + (j % 640); break; }
        ++qoff;
      }
      *s_item = got;
    }
    __syncthreads();
    const int item = *s_item;
    if (item < 0) break;
    bool samp; int b, h, qc, sp;
    {
      const int qx = item >> 10, j = item & 1023;
      h = qx;
      if (j < 128) { samp = true; b = j >> 3; sp = j & 7; qc = 0; }
      else { const int j2 = j - 128; samp = false; sp = 0; b = j2 >> 5; qc = 31 - (j2 & 31); }
    }
    const int nkt = samp ? (sp == 7 ? 17 : 16) : qc + 1;
    const int qtok0 = samp ? NTP + b * 16 : b * 2048 + qc * 64;
    const int nq = samp ? 16 : 64;
    s16x8 qf[2][2];
#pragma unroll
    for (int f = 0; f < 2; ++f)
#pragma unroll
      for (int ks = 0; ks < 2; ++ks) {
        const int qi = min(qh * 32 + f * 16 + li, nq - 1);
        qf[f][ks] = *(const s16x8*)(Qb + (size_t)(qtok0 + qi) * 1024 + h * 128 + c * 64 + ks * 32 + g * 8);
      }
    f32x4 ot[8][2];
#pragma unroll
    for (int ef = 0; ef < 8; ++ef) { ot[ef][0] = f32x4{0.f, 0.f, 0.f, 0.f}; ot[ef][1] = f32x4{0.f, 0.f, 0.f, 0.f}; }
    float mrun[2] = {-INFINITY, -INFINITY}, lsum[2] = {0.f, 0.f};
    uint4 raw[8];
    auto load_tile = [&](int kt, int tid) {
      if (samp && kt < 16) {
#pragma unroll
        for (int i = 0; i < 2; ++i) {
          const int q = tid + i * 256, cc = q >> 8, key = (q >> 3) & 31, dch = q & 7;
          const float* src = ck + ((size_t)(b * 4096 + (sp * 16 + kt) * 32 + key)) * 1024 + h * 128 + cc * 64 + dch * 8;
          raw[2 * i] = *(const uint4*)src; raw[2 * i + 1] = *(const uint4*)(src + 4);
        }
        const int key = tid & 31, eq = tid >> 5;
        const float* src = cv + ((size_t)(b * 4096 + (sp * 16 + kt) * 32 + key)) * 1024 + h * 128 + eq * 16;
#pragma unroll
        for (int i = 0; i < 4; ++i) raw[4 + i] = *(const uint4*)(src + i * 4);
      } else if (!samp) {
        const bf16* kb_ = Kb + (size_t)(b * 2048 + kt * 64) * 1024 + h * 128;
        const bf16* vb_ = VT + (size_t)((b * 8 + h) * 128) * 2048 + kt * 64;
        const unsigned ko_ = (unsigned)(tid >> 3) * 1024u + (unsigned)(tid & 7) * 8u;
        const unsigned vo_ = (unsigned)(tid >> 3) * 2048u + (unsigned)(tid & 7) * 8u;
        raw[0] = *(const uint4*)(kb_ + ko_);
        raw[1] = *(const uint4*)(kb_ + (ko_ + 32768u));
        raw[2] = *(const uint4*)(kb_ + (ko_ + 64u));
        raw[3] = *(const uint4*)(kb_ + (ko_ + 32768u + 64u));
        raw[4] = *(const uint4*)(vb_ + vo_);
        raw[5] = *(const uint4*)(vb_ + (vo_ + 65536u));
        raw[6] = *(const uint4*)(vb_ + (vo_ + 131072u));
        raw[7] = *(const uint4*)(vb_ + (vo_ + 196608u));
      } else {
        const int ktok0 = NTP + b * 16;
        const size_t vbase = (size_t)33554432 + (size_t)((b * 8 + h) * 128) * 16;
#pragma unroll
        for (int i = 0; i < 4; ++i) {
          const int q = tid + i * 256, cc = q >> 9, key = (q >> 3) & 63, dch = q & 7;
          const uint4 kvv = *(const uint4*)(Kb + (size_t)(ktok0 + (key & 15)) * 1024 + h * 128 + cc * 64 + dch * 8);
          const int e = q >> 3, kch = q & 7;
          const uint4 vvv = *(const uint4*)(VT + vbase + (size_t)e * 16 + (kch & 1) * 8);
          const bool kok = key < 16, vok = kch < 2;
          raw[i] = make_uint4(kok ? kvv.x : 0u, kok ? kvv.y : 0u, kok ? kvv.z : 0u, kok ? kvv.w : 0u);
          raw[4 + i] = make_uint4(vok ? vvv.x : 0u, vok ? vvv.y : 0u, vok ? vvv.z : 0u, vok ? vvv.w : 0u);
        }
      }
    };
    auto store_tile = [&](int kt, int tid) {
      if (samp && kt < 16) {
#pragma unroll
        for (int i = 0; i < 2; ++i) {
          const int q = tid + i * 256, cc = q >> 8, key = (q >> 3) & 31, dch = q & 7;
          const uint4 a = raw[2 * i], bq = raw[2 * i + 1];
          uint4 o;
          o.x = pack2(__uint_as_float(a.x), __uint_as_float(a.y)); o.y = pack2(__uint_as_float(a.z), __uint_as_float(a.w));
          o.z = pack2(__uint_as_float(bq.x), __uint_as_float(bq.y)); o.w = pack2(__uint_as_float(bq.z), __uint_as_float(bq.w));
          *(uint4*)(lds + cc * 8192 + (dch >> 2) * 4096 + swz(key, dch & 3)) = o;
        }
        const int key = tid & 31, eq = tid >> 5;
#pragma unroll
        for (int i = 0; i < 4; ++i) {
          const int e = eq * 16 + i * 4;
          *(bf16*)(lds + 16384 + (e + 0) * 144 + key * 2) = f2b(__uint_as_float(raw[4 + i].x));
          *(bf16*)(lds + 16384 + (e + 1) * 144 + key * 2) = f2b(__uint_as_float(raw[4 + i].y));
          *(bf16*)(lds + 16384 + (e + 2) * 144 + key * 2) = f2b(__uint_as_float(raw[4 + i].z));
          *(bf16*)(lds + 16384 + (e + 3) * 144 + key * 2) = f2b(__uint_as_float(raw[4 + i].w));
        }
      } else {
#pragma unroll
        for (int i = 0; i < 4; ++i) {
          const int dch = tid & 7;
          *(uint4*)(lds + ((dch >> 2) * 4096 + swz(tid >> 3, dch & 3)) + (i & 1) * 2048 + (i >> 1) * 8192) = raw[i];
          *(uint4*)(lds + 16384 + ((tid >> 3) * 144 + dch * 16) + i * 4608) = raw[4 + i];
        }
      }
    };
    load_tile(0, tid);
    for (int kt = 0; kt < nkt; ++kt) {
      int tz = tid;
      asm volatile("" : "+v"(tz));
      const int li = tz & 15, g = (tz & 63) >> 4;
      __syncthreads();
      store_tile(kt, tz);
      __syncthreads();
      if (kt + 1 < nkt) load_tile(kt + 1, tz);
      const int kvalid = samp ? (kt == 16 ? 16 : 32) : 64;
      const bool full = !samp;
      f32x4 st[4][2];
#pragma unroll
      for (int kf = 0; kf < 4; ++kf) { st[kf][0] = f32x4{0.f, 0.f, 0.f, 0.f}; st[kf][1] = f32x4{0.f, 0.f, 0.f, 0.f}; }
      {
        s16x8 kfr[2][4];
#pragma unroll
        for (int ks = 0; ks < 2; ++ks)
#pragma unroll
          for (int kf = 0; kf < 4; ++kf)
            if (kf < 2 || full) kfr[ks][kf] = *(const s16x8*)(lds + c * 8192 + ks * 4096 + swz(kf * 16 + li, g));
        __builtin_amdgcn_s_setprio(1);
#pragma unroll
        for (int ks = 0; ks < 2; ++ks)
#pragma unroll
          for (int kf = 0; kf < 4; ++kf)
            if (kf < 2 || full) {
              st[kf][0] = __builtin_amdgcn_mfma_f32_16x16x32_bf16(kfr[ks][kf], qf[0][ks], st[kf][0], 0, 0, 0);
              st[kf][1] = __builtin_amdgcn_mfma_f32_16x16x32_bf16(kfr[ks][kf], qf[1][ks], st[kf][1], 0, 0, 0);
            }
        __builtin_amdgcn_s_setprio(0);
        __builtin_amdgcn_sched_barrier(0);
      }
      if (kvalid < 64) {
#pragma unroll
        for (int kf = 0; kf < 4; ++kf)
#pragma unroll
          for (int r = 0; r < 4; ++r)
            if (kf * 16 + g * 4 + r >= kvalid) { st[kf][0][r] = -INFINITY; st[kf][1][r] = -INFINITY; }
      }
#pragma unroll
      for (int f = 0; f < 2; ++f) {
        float ml = st[0][f][0];
#pragma unroll
        for (int kf = 0; kf < 4; ++kf)
#pragma unroll
          for (int r = 0; r < 4; ++r) ml = fmaxf(ml, st[kf][f][r]);
        ml = fmaxf(ml, __shfl_xor(ml, 16)); ml = fmaxf(ml, __shfl_xor(ml, 32));
        const bool grow = ml > mrun[f] + 8.0f;
        const float mn = grow ? ml : mrun[f];
        float ps = 0.f;
#pragma unroll
        for (int kf = 0; kf < 4; ++kf)
#pragma unroll
          for (int r = 0; r < 4; ++r) { const float pv = __builtin_amdgcn_exp2f(st[kf][f][r] - mn); st[kf][f][r] = pv; ps += pv; }
        if (__builtin_amdgcn_ballot_w64(grow) != 0ull) {
          const float scl = __builtin_amdgcn_exp2f(mrun[f] - mn);
          lsum[f] *= scl;
#pragma unroll
          for (int ef = 0; ef < 8; ++ef) ot[ef][f] = ot[ef][f] * scl;
        }
        mrun[f] = mn;
        lsum[f] += ps;
      }
      s16x8 pf[2][2];
#pragma unroll
      for (int step = 0; step < 2; ++step)
#pragma unroll
        for (int f = 0; f < 2; ++f) {
          const uint2 a = pack4(st[2 * step][f]), bq = pack4(st[2 * step + 1][f]);
          pf[step][f] = __builtin_bit_cast(s16x8, make_uint4(a.x, a.y, bq.x, bq.y));
        }
      __builtin_amdgcn_sched_barrier(0);
#pragma unroll
      for (int step = 0; step < 2; ++step) {
        if (step == 1 && !full) break;
        s16x8 vf[8];
#pragma unroll
        for (int ef = 0; ef < 8; ++ef) {
          const char* vp = lds + 16384 + (ef * 16 + li) * 144 + (step * 32 + g * 4) * 2;
          const uint2 a = *(const uint2*)vp, bq = *(const uint2*)(vp + 32);
          vf[ef] = __builtin_bit_cast(s16x8, make_uint4(a.x, a.y, bq.x, bq.y));
        }
        __builtin_amdgcn_s_setprio(1);
#pragma unroll
        for (int ef = 0; ef < 8; ++ef) {
          ot[ef][0] = __builtin_amdgcn_mfma_f32_16x16x32_bf16(vf[ef], pf[step][0], ot[ef][0], 0, 0, 0);
          ot[ef][1] = __builtin_amdgcn_mfma_f32_16x16x32_bf16(vf[ef], pf[step][1], ot[ef][1], 0, 0, 0);
        }
        __builtin_amdgcn_s_setprio(0);
        __builtin_amdgcn_sched_barrier(0);
      }
    }
    float inv[2];
#pragma unroll
    for (int f = 0; f < 2; ++f) { float lt = lsum[f]; lt += __shfl_xor(lt, 16); lt += __shfl_xor(lt, 32); inv[f] = 1.0f / lt; }
    if (samp) {
      if (qh == 0) {
        float* pr = (float*)slot(p, 9) + ((size_t)((((b * 8 + h) * 8 + sp) * 2 + c) * 16 + li)) * 132;
#pragma unroll
        for (int ef = 0; ef < 8; ++ef) st4(pr + ef * 16 + g * 4, ot[ef][0]);
        if (g == 0) { pr[128] = mrun[0]; pr[129] = 1.0f / inv[0]; }
      }
      continue;
    }
    __syncthreads();
    float* comb = (float*)lds;
    if (c == 1) {
#pragma unroll
      for (int ef = 0; ef < 8; ++ef)
#pragma unroll
        for (int f = 0; f < 2; ++f)
#pragma unroll
          for (int r = 0; r < 4; ++r) comb[(((qh * 8 + ef) * 2 + f) * 4 + r) * 64 + l] = ot[ef][f][r] * inv[f] * lam;
    }
    __syncthreads();
    if (c == 0) {
#pragma unroll
      for (int f = 0; f < 2; ++f) {
        float ss = 0.f;
#pragma unroll
        for (int ef = 0; ef < 8; ++ef)
#pragma unroll
          for (int r = 0; r < 4; ++r) { const float o = ot[ef][f][r] * inv[f] - comb[(((qh * 8 + ef) * 2 + f) * 4 + r) * 64 + l]; ot[ef][f][r] = o; ss = fmaf(o, o, ss); }
        ss += __shfl_xor(ss, 16); ss += __shfl_xor(ss, 32);
        const float rs = rsqrtf(ss * (1.0f / 128.0f) + 1e-5f) * 0.6444909324090307f;
        const int qi = qh * 32 + f * 16 + li;
        if (qi < nq) {
#pragma unroll
          for (int ef = 0; ef < 8; ++ef) {
            const int e = ef * 16 + g * 4;
            const f32x4 g4 = ld4(sg + e);
            *(uint2*)(Ob + (size_t)(qtok0 + qi) * 1024 + h * 128 + e) = pack4(ot[ef][f] * rs * g4);
          }
        }
      }
    }
  }
}

__device__ __forceinline__ void phase_attn_combine(KP p) {
  const int l = threadIdx.x & 63, w = threadIdx.x >> 6;
  const float* lp = p->in[24];
  const float s1 = wave_sum(lp[l] * lp[64 + l]), s2 = wave_sum(lp[128 + l] * lp[192 + l]);
  const float lam = __expf(s1) - __expf(s2) + 0.35550906759f;
  const float* sg = p->in[25];
  bf16* Ob = (bf16*)slot(p, 8);
  for (int row = blockIdx.x * 4 + w; row < 2048; row += gridDim.x * 4) {
    const int q = row & 15, bh = row >> 4;
    float o2[2][2];
#pragma unroll
    for (int c = 0; c < 2; ++c) {
      float m[8], M = -INFINITY;
#pragma unroll
      for (int sp = 0; sp < 8; ++sp) { m[sp] = ((const float*)slot(p, 9))[((size_t)(((bh * 8 + sp) * 2 + c) * 16 + q)) * 132 + 128]; M = fmaxf(M, m[sp]); }
      float L = 0.f, a0 = 0.f, a1 = 0.f;
#pragma unroll
      for (int sp = 0; sp < 8; ++sp) {
        const float* pr = (const float*)slot(p, 9) + ((size_t)(((bh * 8 + sp) * 2 + c) * 16 + q)) * 132;
        const float wg = __builtin_amdgcn_exp2f(m[sp] - M);
        L = fmaf(wg, pr[129], L);
        const float2 ov = *(const float2*)(pr + l * 2);
        a0 = fmaf(wg, ov.x, a0); a1 = fmaf(wg, ov.y, a1);
      }
      o2[c][0] = a0 / L; o2[c][1] = a1 / L;
    }
    const float x0 = o2[0][0] - lam * o2[1][0], x1 = o2[0][1] - lam * o2[1][1];
    const float ss = wave_sum(x0 * x0 + x1 * x1);
    const float rs = rsqrtf(ss * (1.0f / 128.0f) + 1e-5f) * 0.6444909324090307f;
    const int b = bh >> 3, h = bh & 7;
    *(unsigned*)(Ob + (size_t)(NTP + b * 16 + q) * 1024 + h * 128 + l * 2) = pack2(x0 * rs * sg[l * 2], x1 * rs * sg[l * 2 + 1]);
  }
}

__global__ void __launch_bounds__(256, 2) yoco_mega(Params p) {
  __shared__ __attribute__((aligned(16))) char lds[65536];
  cg::grid_group grid = cg::this_grid();
  KP kp = (KP)__builtin_amdgcn_kernarg_segment_ptr();
#define FRESH() ({ KP q_ = kp; asm volatile("" : "+s"(q_)); q_; })
  phase0(FRESH());
  grid.sync();
  XcdBar xb; xb.bar = (unsigned*)(FRESH()->ws + O_BAR); xb.x = xb_xcc_id(); xb.nloc = 1u; xb.nx = 1u;
  if (threadIdx.x == 0) (void)xb_add(&xb.bar[XB_XCNT(xb.x)], 1u);
  if (threadIdx.x < 64) {
    unsigned nl = 1u, nxx = 1u;
    xcd_census(xb.bar, xb.x, nl, nxx);
    xb.nloc = (unsigned)__builtin_amdgcn_readfirstlane((int)nl); xb.nx = (unsigned)__builtin_amdgcn_readfirstlane((int)nxx);
  }
  phase_gemm<1>(FRESH(), lds); xcd_barrier(xb);
  phase_gemm<2>(FRESH(), lds); xcd_barrier(xb);
  phase_scan(FRESH(), lds); xcd_barrier(xb);
  phase_gemm<4>(FRESH(), lds); xcd_barrier(xb);
  { KP p = FRESH(); phase_ln(p, (const float*)slot(p, 0), (float*)slot(p, 2), (bf16*)slot(p, 5), p->in[27], p->in[28]); } xcd_barrier(xb);
  phase_gemm<6>(FRESH(), lds); xcd_barrier(xb);
  phase_peer_experts(FRESH(), 0); xcd_barrier(xb);
  phase_gemm<8>(FRESH(), lds); xcd_barrier(xb);
  phase_attn(FRESH(), lds); xcd_barrier(xb);
  phase_attn_combine(FRESH()); xcd_barrier(xb);
  phase_gemm<10>(FRESH(), lds); xcd_barrier(xb);
  { KP p = FRESH(); phase_ln(p, (const float*)slot(p, 2), (float*)slot(p, 0), (bf16*)slot(p, 4), p->in[27] + 1024, p->in[28] + 1024); } xcd_barrier(xb);
  phase_gemm<12>(FRESH(), lds); xcd_barrier(xb);
  phase_peer_experts(FRESH(), 1);
}

extern "C" void kernel_launch(void* const* d_in, const int* in_sizes, int n_in, void* d_out, int out_size,
                              void* d_ws, size_t ws_size, hipStream_t stream) {
  static int grid_blocks = 0;
  if (!grid_blocks) {
    int dev = 0, cus = 0, per_cu = 0;
    hipGetDevice(&dev);
    hipDeviceGetAttribute(&cus, hipDeviceAttributeMultiprocessorCount, dev);
    hipOccupancyMaxActiveBlocksPerMultiprocessor(&per_cu, (const void*)yoco_mega, 256, 0);
    if (per_cu > 2) per_cu = 2;
    if (per_cu < 1) per_cu = 1;
    grid_blocks = cus * per_cu;
  }
  if (ws_size < WS_NEED) { fprintf(stderr, "workspace too small: %zu < %zu\n", ws_size, (size_t)WS_NEED); return; }
  Params p{};
  for (int i = 0; i < 35; ++i) p.in[i] = (const float*)d_in[i];
  p.out = (float*)d_out;
  p.ws = (char*)d_ws;
  void* args[] = {&p};
  hipError_t e = hipLaunchCooperativeKernel((const void*)yoco_mega, dim3(grid_blocks), dim3(256), args, 0, stream);
  if (e != hipSuccess) fprintf(stderr, "cooperative launch failed: %s (grid %d)\n", hipGetErrorString(e), grid_blocks);
}
```

```cpp
#include <hip/hip_runtime.h>
#include <hip/hip_cooperative_groups.h>
#include <stdio.h>
namespace cg = cooperative_groups;

typedef unsigned short bf16;
typedef __attribute__((ext_vector_type(8))) short s16x8;
typedef __attribute__((ext_vector_type(4))) float f32x4;

constexpr int NTP = 32768, NT = 33024;
constexpr int REP_GEMM = 1, REP_PE = 1, REP_SCAN = 1, REP_ATTN = 1, REP_P0 = 1;
constexpr size_t U = (size_t)NT * 1024 * 2;

constexpr size_t O_WRKV = 0;
constexpr size_t O_WL1  = O_WRKV + 3 * 2097152;
constexpr size_t O_W2T  = O_WL1 + 524288;
constexpr size_t O_A2T  = O_W2T + 131072;
constexpr size_t O_G2T  = O_A2T + 131072;
constexpr size_t O_WOUT = O_G2T + 262144;
constexpr size_t O_WKV  = O_WOUT + 2097152;
constexpr size_t O_WQ   = O_WKV + 4194304;
constexpr size_t O_WO   = O_WQ + 2097152;
constexpr size_t O_WPQ  = O_WO + 2097152;
constexpr size_t O_SK   = O_WPQ + 2 * 4194304;
constexpr size_t O_PU   = O_SK + 131072;
constexpr size_t O_PV   = O_PU + 16777216;
constexpr size_t O_SU   = O_PV + 16777216;
constexpr size_t O_SV   = O_SU + 131072;
constexpr size_t O_CNT  = O_SV + 131072;
constexpr size_t O_BAR  = O_CNT + 256;
constexpr size_t O_CUT  = O_BAR + 16384;
constexpr size_t O_SLOT = O_CUT + 16384;
constexpr size_t WS_NEED = O_SLOT + 10 * U;

constexpr size_t OFF_YP = 0, OFF_YS = 33554432, OFF_WKVP = 33816576, OFF_SHP = 34865152,
                 OFF_CKP = 34881536, OFF_CVP = 68435968, OFF_WKVS = 101990400, OFF_SHS = 103038976,
                 OFF_CKS = 103055360, OFF_CVS = 103317504;

struct Params {
  const float* in[35];
  float* out;
  char* ws;
};
typedef const Params __attribute__((address_space(4)))* KP;

__device__ const unsigned char CAND[64] = {0, 1, 2, 3, 4, 5, 6, 7, 8, 9, 10, 11, 12, 13, 14, 15, 16, 17, 18, 19, 20, 21, 22, 23, 32, 33, 34, 35, 36, 48, 49, 50, 51, 64, 65, 66, 80, 81, 96, 97, 112, 113, 128, 144, 160, 176, 192, 208, 224, 240, 255, 255, 255, 255, 255, 255, 255, 255, 255, 255, 255, 255, 255, 255};

__device__ __forceinline__ char* slot(KP p, int i) { return p->ws + O_SLOT + (size_t)i * U; }
__device__ __forceinline__ bf16 f2b(float f) { unsigned u = __float_as_uint(f); u += 0x7fffu + ((u >> 16) & 1u); return (bf16)(u >> 16); }
typedef float f32x2 __attribute__((ext_vector_type(2)));
typedef __bf16 bf16x2_t __attribute__((ext_vector_type(2)));
__device__ __forceinline__ unsigned pack2(float a, float b) {
  const f32x2 v = {a, b};
  return __builtin_bit_cast(unsigned, __builtin_convertvector(v, bf16x2_t));
}
__device__ __forceinline__ float blo(unsigned u) { return __uint_as_float(u << 16); }
__device__ __forceinline__ float bhi(unsigned u) { return __uint_as_float(u & 0xffff0000u); }
__device__ __forceinline__ uint2 pack4(f32x4 v) { return make_uint2(pack2(v[0], v[1]), pack2(v[2], v[3])); }
__device__ __forceinline__ f32x4 unpack4(uint2 u) { f32x4 r; r[0] = blo(u.x); r[1] = bhi(u.x); r[2] = blo(u.y); r[3] = bhi(u.y); return r; }
__device__ __forceinline__ f32x4 ld4(const float* p) { float4 t = *(const float4*)p; f32x4 r; r[0] = t.x; r[1] = t.y; r[2] = t.z; r[3] = t.w; return r; }
__device__ __forceinline__ void st4(float* p, f32x4 v) { *(float4*)p = make_float4(v[0], v[1], v[2], v[3]); }

template <int CTRL> __device__ __forceinline__ float dppf(float v) {
  return __builtin_bit_cast(float, __builtin_amdgcn_mov_dpp(__builtin_bit_cast(int, v), CTRL, 0xf, 0xf, true));
}
template <int CTRL> __device__ __forceinline__ unsigned dppu(unsigned v) {
  return (unsigned)__builtin_amdgcn_mov_dpp((int)v, CTRL, 0xf, 0xf, true);
}
__device__ __forceinline__ float oct_sum(float v) { v += dppf<0xB1>(v); v += dppf<0x4E>(v); v += dppf<0x141>(v); return v; }
__device__ __forceinline__ float row_sum(float v) { v = oct_sum(v); v += dppf<0x140>(v); return v; }
__device__ __forceinline__ float row_max(float v) {
  v = fmaxf(v, dppf<0xB1>(v)); v = fmaxf(v, dppf<0x4E>(v)); v = fmaxf(v, dppf<0x141>(v)); v = fmaxf(v, dppf<0x140>(v)); return v;
}
__device__ __forceinline__ unsigned umx(unsigned a, unsigned b) { return a > b ? a : b; }
__device__ __forceinline__ unsigned row_umax(unsigned v) {
  v = umx(v, dppu<0xB1>(v)); v = umx(v, dppu<0x4E>(v)); v = umx(v, dppu<0x141>(v)); v = umx(v, dppu<0x140>(v)); return v;
}
__device__ __forceinline__ float wave_sum(float v) { v = row_sum(v); v += __shfl_xor(v, 16); v += __shfl_xor(v, 32); return v; }
__device__ __forceinline__ unsigned f2ord(float f) { unsigned u = __float_as_uint(f); return (u & 0x80000000u) ? ~u : (u | 0x80000000u); }
__device__ __forceinline__ float ord2f(unsigned o) { unsigned u = (o & 0x80000000u) ? (o & 0x7fffffffu) : ~o; return __uint_as_float(u); }
__device__ __forceinline__ const float* xin(KP p, int m) {
  return m < NTP ? p->in[0] + (size_t)m * 1024 : p->in[1] + (size_t)(m - NTP) * 1024;
}

__device__ __forceinline__ int swz(int row, int slot) { const int q = (row >> 2) & 3; return row * 64 + ((slot ^ (q ^ ((q & 1) << 1))) << 4); }

__device__ __forceinline__ int otid() { int t = threadIdx.x; asm volatile("" : "+v"(t)); return t; }

#define XB_TMO      128
#define XB_XCNT(j)  (256  + 64 * (j))
#define XB_XSUB(j)  (1280 + 64 * (j))
#define XB_XGEN(j)  (2304 + 64 * (j))
#define XB_TOP      3328
#define XB_TOPGEN   3392
#define XCD_BAR_WORDS 3456
#define XB_SPIN_CAP (1u << 20)
__device__ __forceinline__ unsigned xb_ld(unsigned* p) { return __hip_atomic_load(p, __ATOMIC_RELAXED, __HIP_MEMORY_SCOPE_AGENT); }
__device__ __forceinline__ unsigned xb_add(unsigned* p, unsigned v) { return __hip_atomic_fetch_add(p, v, __ATOMIC_RELAXED, __HIP_MEMORY_SCOPE_AGENT); }
__device__ __forceinline__ unsigned xb_xcc_id() { return (unsigned)__builtin_amdgcn_s_getreg((3 << 11) | 20) & 0xFu; }
#define XB_SPIN(cond, bar) do { unsigned _sp = 0; while (cond) { __builtin_amdgcn_s_sleep(1); \
    if ((++_sp & 255u) == 0u) { if (xb_ld(&(bar)[XB_TMO])) break; if (_sp > XB_SPIN_CAP) { atomicAdd(&(bar)[XB_TMO], 1u); break; } } } } while (0)
struct XcdBar { unsigned* bar; unsigned x, nloc, nx; };
__device__ __forceinline__ void xcd_census(unsigned* bar, unsigned x, unsigned& nloc, unsigned& nx) {
  const unsigned G = gridDim.x;
  unsigned sum, cnt, mine, sp = 0u;
  for (;;) {
    sum = 0u; cnt = 0u; mine = 0u;
#pragma unroll
    for (unsigned j = 0; j < 16; ++j) { const unsigned c = xb_ld(&bar[XB_XCNT(j)]); sum += c; cnt += (c > 0u) ? 1u : 0u; mine = (j == x) ? c : mine; }
    if (sum == G) break;
    __builtin_amdgcn_s_sleep(1);
    if ((++sp & 255u) == 0u) { if (xb_ld(&bar[XB_TMO])) break; if (sp > XB_SPIN_CAP) { atomicAdd(&bar[XB_TMO], 1u); break; } }
  }
  nloc = mine > 0u ? mine : 1u; nx = cnt > 0u ? cnt : 1u;
}
__device__ __forceinline__ void xcd_barrier(XcdBar& b) {
  asm volatile("s_waitcnt vmcnt(0)" ::: "memory");
  __syncthreads();
  if (threadIdx.x == 0) {
    unsigned* bar = b.bar;
    __builtin_amdgcn_s_waitcnt(0);
    const unsigned nloc = b.nloc, nx = b.nx;
    const unsigned old = xb_add(&bar[XB_XSUB(b.x)], 1u);
    const unsigned gen = old / nloc;
    if (old + 1u == (gen + 1u) * nloc) {
      __builtin_amdgcn_fence(__ATOMIC_RELEASE, "agent");
      asm volatile("s_waitcnt vmcnt(0)" ::: "memory");
      const unsigned og = xb_add(&bar[XB_TOP], 1u);
      const unsigned tg = og / nx;
      if (og + 1u == (tg + 1u) * nx) xb_add(&bar[XB_TOPGEN], 1u);
      else XB_SPIN(xb_ld(&bar[XB_TOPGEN]) == tg, bar);
      __builtin_amdgcn_fence(__ATOMIC_ACQUIRE, "agent");
      xb_add(&bar[XB_XGEN(b.x)], 1u);
      asm volatile("s_waitcnt vmcnt(0)" ::: "memory");
    } else {
      XB_SPIN(xb_ld(&bar[XB_XGEN(b.x)]) == gen, bar);
      __builtin_amdgcn_fence(__ATOMIC_ACQUIRE, "agent");
      asm volatile("s_waitcnt vmcnt(0)" ::: "memory");
    }
  }
  __syncthreads();
}

__device__ __forceinline__ void transpose_cvt(const float* __restrict__ W, bf16* __restrict__ WT, int K, int N, int gtid, int gsz) {
  const int items = (K >> 3) * N;
  for (int it = gtid; it < items; it += gsz) {
    const int n = it % N, kb = it / N;
    const float* src = W + (size_t)(kb * 8) * N + n;
    uint4 o;
    o.x = pack2(src[0], src[(size_t)N]);
    o.y = pack2(src[(size_t)2 * N], src[(size_t)3 * N]);
    o.z = pack2(src[(size_t)4 * N], src[(size_t)5 * N]);
    o.w = pack2(src[(size_t)6 * N], src[(size_t)7 * N]);
    *(uint4*)(WT + (size_t)n * K + kb * 8) = o;
  }
}
__device__ __forceinline__ void plain_cvt(const float* __restrict__ S, bf16* __restrict__ D, size_t n8, int gtid, int gsz) {
  for (size_t it = gtid; it < n8; it += gsz) {
    const float4 a = *(const float4*)(S + it * 8), b = *(const float4*)(S + it * 8 + 4);
    uint4 o; o.x = pack2(a.x, a.y); o.y = pack2(a.z, a.w); o.z = pack2(b.x, b.y); o.w = pack2(b.z, b.w);
    *(uint4*)(D + it * 8) = o;
  }
}
__device__ __forceinline__ void quant_rows(KP p, int r0) {
  char* ws = p->ws;
  {
    const int l = threadIdx.x & 63;
    for (int r = r0 + (threadIdx.x >> 6); r < r0 + 64; r += 4) {
      const int tbl = r >> 15, rr = r & 32767;
      const float* src = (tbl ? p->in[34] : p->in[33]) + (size_t)rr * 1024 + l * 16;
      f32x4 x[4];
#pragma unroll
      for (int i = 0; i < 4; ++i) x[i] = ld4(src + i * 4);
      float am = 0.f;
#pragma unroll
      for (int i = 0; i < 4; ++i)
#pragma unroll
        for (int j = 0; j < 4; ++j) am = fmaxf(am, fabsf(x[i][j]));
      am = row_max(am); am = fmaxf(am, __shfl_xor(am, 16)); am = fmaxf(am, __shfl_xor(am, 32));
      if (tbl) {
        float ssq = 0.f;
#pragma unroll
        for (int i = 0; i < 4; ++i)
#pragma unroll
          for (int j = 0; j < 4; ++j) ssq = fmaf(x[i][j], x[i][j], ssq);
        const float clipv = fminf(am, 2.75f * sqrtf(wave_sum(ssq) * (1.0f / 1024.0f)));
        const float inv = clipv > 0.f ? 7.5f / clipv : 0.f;
        unsigned o[2] = {0u, 0u};
#pragma unroll
        for (int i = 0; i < 4; ++i)
#pragma unroll
          for (int j = 0; j < 4; ++j) {
            int q = (int)floorf(x[i][j] * inv + 8.0f); q = q < 0 ? 0 : (q > 15 ? 15 : q);
            const int e = i * 4 + j;
            o[e >> 3] |= (unsigned)q << (4 * (e & 7));
          }
        *(uint2*)((unsigned char*)(ws + O_PV) + (size_t)rr * 512 + l * 8) = make_uint2(o[0], o[1]);
        if (l == 0) ((float*)(ws + O_SV))[rr] = clipv > 0.f ? clipv / 7.5f : 1.0f;
      } else {
        float ssq = 0.f;
#pragma unroll
        for (int i = 0; i < 4; ++i)
#pragma unroll
          for (int j = 0; j < 4; ++j) ssq = fmaf(x[i][j], x[i][j], ssq);
        const float clipv = fminf(am, 2.75f * sqrtf(wave_sum(ssq) * (1.0f / 1024.0f)));
        const float inv = clipv > 0.f ? 7.5f / clipv : 0.f;
        unsigned o[2] = {0u, 0u};
#pragma unroll
        for (int i = 0; i < 4; ++i)
#pragma unroll
          for (int j = 0; j < 4; ++j) {
            int q = (int)floorf(x[i][j] * inv + 8.0f); q = q < 0 ? 0 : (q > 15 ? 15 : q);
            const int e = i * 4 + j;
            o[e >> 3] |= (unsigned)q << (4 * (e & 7));
          }
        *(uint2*)((unsigned char*)(ws + O_PU) + (size_t)rr * 512 + l * 8) = make_uint2(o[0], o[1]);
        if (l == 0) ((float*)(ws + O_SU))[rr] = clipv > 0.f ? clipv / 7.5f : 1.0f;
      }
    }
  }
}

__device__ __forceinline__ void phase0(KP p) {
  const int gtid = blockIdx.x * 256 + threadIdx.x, gsz = gridDim.x * 256;
  char* ws = p->ws;
  for (int rep0 = 0; rep0 < REP_P0; ++rep0) {
  if (gtid < 64) ((int*)(ws + O_CNT))[gtid] = 0;
  if (gtid < 4096) ((int*)(ws + O_CUT))[gtid] = 0;
  if (blockIdx.x == 0) for (int i = threadIdx.x; i < XCD_BAR_WORDS; i += 256) ((unsigned*)(ws + O_BAR))[i] = 0u;
  for (int g = 0; g < 3; ++g) transpose_cvt(p->in[7] + (size_t)g * 1048576, (bf16*)(ws + O_WRKV) + (size_t)g * 1048576, 1024, 1024, gtid, gsz);
  transpose_cvt(p->in[9],  (bf16*)(ws + O_WL1), 1024, 64, gtid, gsz);
  transpose_cvt(p->in[12], (bf16*)(ws + O_WL1) + 64 * 1024, 1024, 64, gtid, gsz);
  transpose_cvt(p->in[14], (bf16*)(ws + O_WL1) + 128 * 1024, 1024, 128, gtid, gsz);
  transpose_cvt(p->in[10], (bf16*)(ws + O_W2T), 64, 1024, gtid, gsz);
  transpose_cvt(p->in[13], (bf16*)(ws + O_A2T), 64, 1024, gtid, gsz);
  transpose_cvt(p->in[15], (bf16*)(ws + O_G2T), 128, 1024, gtid, gsz);
  transpose_cvt(p->in[21], (bf16*)(ws + O_WOUT), 1024, 1024, gtid, gsz);
  transpose_cvt(p->in[22], (bf16*)(ws + O_WKV), 1024, 2048, gtid, gsz);
  transpose_cvt(p->in[23], (bf16*)(ws + O_WQ), 1024, 1024, gtid, gsz);
  transpose_cvt(p->in[26], (bf16*)(ws + O_WO), 1024, 1024, gtid, gsz);
  for (int g = 0; g < 2; ++g) transpose_cvt(p->in[31] + (size_t)g * 2097152, (bf16*)(ws + O_WPQ) + (size_t)g * 2097152, 1024, 2048, gtid, gsz);
  plain_cvt(p->in[32], (bf16*)(ws + O_SK), 65536 / 8, gtid, gsz);
  const float* mu = p->in[6];
  for (int it = gtid; it < NT * 128; it += gsz) {
    const int m = it >> 7, c8 = (it & 127) * 8;
    const float* xr = xin(p, m) + c8;
    const float* pr = nullptr; bool last; float* sho;
    if (m < NTP) { const int t = m & 2047; if (t) pr = xr - 1024; last = (t == 2047); sho = p->out + OFF_SHP + (size_t)(m >> 11) * 1024 + c8; }
    else { const int ms = m - NTP, t = ms & 15; pr = t ? xr - 1024 : p->in[3] + (size_t)(ms >> 4) * 1024 + c8; last = (t == 15); sho = p->out + OFF_SHS + (size_t)(ms >> 4) * 1024 + c8; }
    const f32x4 x0 = ld4(xr), x1 = ld4(xr + 4);
    f32x4 d0, d1;
    if (pr) { d0 = ld4(pr) - x0; d1 = ld4(pr + 4) - x1; } else { d0 = -x0; d1 = -x1; }
    if (last) { st4(sho, x0); st4(sho + 4, x1); }
#pragma unroll
    for (int i = 0; i < 6; ++i) {
      const f32x4 m0 = ld4(mu + i * 1024 + c8), m1 = ld4(mu + i * 1024 + c8 + 4);
      const f32x4 a = x0 + d0 * m0, b = x1 + d1 * m1;
      const uint2 pa = pack4(a), pb = pack4(b);
      *(uint4*)((bf16*)slot(p, i) + (size_t)m * 1024 + c8) = make_uint4(pa.x, pa.y, pb.x, pb.y);
    }
  }
  }
}

struct Job { const bf16* A; const bf16* B; int lda, ldb, K, nmax, mode, m0, n0, aux; };

__device__ __forceinline__ void get_job(KP p, int ph, int id, Job& j) {
  char* ws = p->ws;
  j.lda = 1024; j.ldb = 1024; j.K = 1024; j.nmax = 1 << 30; j.aux = 0;
  if (ph == 1) {
    if (id < 6192) { const int g = id / 2064, r = id % 2064; j.A = (const bf16*)slot(p, g); j.B = (const bf16*)(ws + O_WRKV) + (size_t)g * 1048576; j.mode = 0; j.aux = g; j.m0 = (r >> 3) * 128; j.n0 = (r & 7) * 128; }
    else { const int q = id - 6192, g = q / 258; j.A = (const bf16*)slot(p, 3 + g); j.B = (const bf16*)(ws + O_WL1) + (size_t)g * 65536; j.nmax = (g == 2) ? 128 : 64; j.mode = 1; j.aux = g; j.m0 = (q % 258) * 128; j.n0 = 0; }
  } else if (ph == 2) {
    const int g = id / 2064, r = id % 2064; j.m0 = (r >> 3) * 128; j.n0 = (r & 7) * 128; j.lda = 256; j.mode = 2 + g;
    if (g == 0) { j.A = (const bf16*)slot(p, 9); j.B = (const bf16*)(ws + O_W2T); j.K = 64; j.ldb = 64; }
    else if (g == 1) { j.A = (const bf16*)slot(p, 9) + 64; j.B = (const bf16*)(ws + O_A2T); j.K = 64; j.ldb = 64; }
    else { j.A = (const bf16*)slot(p, 9) + 128; j.B = (const bf16*)(ws + O_G2T); j.K = 128; j.ldb = 128; }
  } else if (ph == 4) {
    j.A = (const bf16*)slot(p, 4); j.B = (const bf16*)(ws + O_WOUT); j.mode = 5; j.m0 = (id >> 3) * 128; j.n0 = (id & 7) * 128;
  } else if (ph == 6 || ph == 12) {
    const int layer = (ph == 12); j.aux = layer;
    j.A = (const bf16*)slot(p, layer ? 4 : 5); j.B = (const bf16*)(ws + O_WPQ) + (size_t)layer * 2097152; j.mode = 6; j.m0 = (id >> 4) * 128; j.n0 = (id & 15) * 128;
  } else if (ph == 8) {
    j.A = (const bf16*)slot(p, 4);
    if (id < 4128) { j.B = (const bf16*)(ws + O_WKV); j.mode = 7; j.m0 = (id >> 4) * 128; j.n0 = (id & 15) * 128; }
    else { const int q = id - 4128; j.B = (const bf16*)(ws + O_WQ); j.mode = 8; j.m0 = (q >> 3) * 128; j.n0 = (q & 7) * 128; }
  } else {
    j.A = (const bf16*)slot(p, 8); j.B = (const bf16*)(ws + O_WO); j.mode = 9; j.m0 = (id >> 3) * 128; j.n0 = (id & 7) * 128;
  }
}

__device__ __forceinline__ f32x4 rope4(f32x4 v, int m, int l) {
  const int pos = (m < NTP) ? (m & 2047) : (4096 + ((m - NTP) & 15));
  const int g = l >> 4; const bool t2 = g >= 2; const int fb = (g & 1) * 4;
  f32x4 o;
#pragma unroll
  for (int r = 0; r < 4; ++r) {
    const float inv = exp2f(-(float)(fb + r) * (18.931568569324174f * 0.125f));
    const float ang = (float)pos * inv;
    float rev = ang * 0.15915494309189535f; rev -= rintf(rev);
    const float s = __builtin_amdgcn_sinf(rev), c = __builtin_amdgcn_cosf(rev);
    const float pr = __shfl_xor(v[r], 32);
    o[r] = v[r] * c + (t2 ? pr * s : -pr * s);
  }
  return o;
}

template <int MODE>
__device__ __forceinline__ void epilogue(KP p, const Job& jb, int m, int n, f32x4 v, int l) {
  const size_t mi = (size_t)m * 1024 + n;
  switch (MODE) {
    case 0: *(uint2*)((bf16*)slot(p, 6 + jb.aux) + mi) = pack4(v); break;
    case 1: if (n < jb.nmax) {
        f32x4 o;
#pragma unroll
        for (int r = 0; r < 4; ++r) o[r] = jb.aux == 0 ? 1.0f - 2.0f / (1.0f + __expf(2.0f * v[r])) : (jb.aux == 1 ? v[r] : 1.0f / (1.0f + __expf(-v[r])));
        *(uint2*)((bf16*)slot(p, 9) + (size_t)m * 256 + jb.aux * 64 + n) = pack4(o);
      } break;
    case 2: {
        const f32x4 w0 = ld4(p->in[8] + n); f32x4 o;
#pragma unroll
        for (int r = 0; r < 4; ++r) { const float z = w0[r] + v[r]; const float sp = __logf(1.0f + __expf(-z)); o[r] = __expf(-__expf(-sp - 0.5f)); }
        st4((float*)slot(p, 0) + mi, o);
      } break;
    case 3: {
        const f32x4 a0 = ld4(p->in[11] + n); f32x4 o;
#pragma unroll
        for (int r = 0; r < 4; ++r) o[r] = 1.0f / (1.0f + __expf(-(a0[r] + v[r])));
        *(uint2*)((bf16*)slot(p, 2) + mi) = pack4(o);
      } break;
    case 4: *(uint2*)((bf16*)slot(p, 3) + mi) = pack4(v); break;
    case 5: { const f32x4 x = ld4(xin(p, m) + n); st4((float*)slot(p, 0) + mi, x * 1.4142135623730951f + v); } break;
    case 9: { const f32x4 x = ld4((const float*)slot(p, 0) + mi); st4((float*)slot(p, 2) + mi, x * 1.4142135623730951f + v); } break;
    case 7: {
        if (n < 1024) {
          if ((n & 63) < 16) v = rope4(v, m, l);
          float* o = (m < NTP) ? p->out + OFF_CKP + mi : p->out + OFF_CKS + (size_t)(m - NTP) * 1024 + n;
          st4(o, v);
          *(uint2*)((bf16*)slot(p, 5) + mi) = pack4(v);
        } else {
          const int n2 = n - 1024, h = n2 >> 7, e = n2 & 127;
          float* o = (m < NTP) ? p->out + OFF_CVP + (size_t)m * 1024 + n2 : p->out + OFF_CVS + (size_t)(m - NTP) * 1024 + n2;
          st4(o, v);
          bf16* vt = (bf16*)slot(p, 6);
          if (m < NTP) { const int s = m >> 11, t = m & 2047;
#pragma unroll
            for (int r = 0; r < 4; ++r) vt[((size_t)((s * 8 + h) * 128 + e + r)) * 2048 + t] = f2b(v[r]);
          } else { const int ms = m - NTP, b = ms >> 4, t = ms & 15;
#pragma unroll
            for (int r = 0; r < 4; ++r) vt[(size_t)33554432 + ((size_t)((b * 8 + h) * 128 + e + r)) * 16 + t] = f2b(v[r]);
          }
        }
      } break;
    case 8: {
        if ((n & 63) < 16) v = rope4(v, m, l);
        *(uint2*)((bf16*)slot(p, 7) + mi) = pack4(v * 0.18033688011112042f);
      } break;
    default: break;
  }
}

__device__ __forceinline__ void peer_tail(KP p, const Job& jb, f32x4 (&acc)[4][4], char* lds, int tid) {
  const int l = tid & 63, w = tid >> 6, wm = w & 1, wn = w >> 1, g = l >> 4, li = l & 15;
#pragma unroll
  for (int j = 0; j < 4; ++j)
#pragma unroll
    for (int i = 0; i < 4; ++i) {
      const int d0 = wn * 64 + j * 16 + g * 4, tok = wm * 64 + i * 16 + li;
      *(uint2*)(lds + (d0 >> 5) * 8192 + swz(tok, (d0 & 31) >> 3) + ((d0 & 7) * 2)) = pack4(acc[j][i]);
    }
  __syncthreads();
  f32x4 sc[4][4];
#pragma unroll
  for (int j = 0; j < 4; ++j)
#pragma unroll
    for (int i = 0; i < 4; ++i) sc[j][i] = f32x4{0.f, 0.f, 0.f, 0.f};
#pragma unroll
  for (int ks = 0; ks < 4; ++ks) {
    s16x8 kf[4], qf[4];
#pragma unroll
    for (int j = 0; j < 4; ++j) kf[j] = *(const s16x8*)(lds + 32768 + ks * 8192 + swz(wn * 64 + j * 16 + li, g));
#pragma unroll
    for (int i = 0; i < 4; ++i) qf[i] = *(const s16x8*)(lds + ks * 8192 + swz(wm * 64 + i * 16 + li, g));
#pragma unroll
    for (int j = 0; j < 4; ++j)
#pragma unroll
      for (int i = 0; i < 4; ++i) sc[j][i] = __builtin_amdgcn_mfma_f32_16x16x32_bf16(kf[j], qf[i], sc[j][i], 0, 0, 0);
    __builtin_amdgcn_sched_barrier(0);
  }
  __syncthreads();
  unsigned* tko = (unsigned*)slot(p, jb.aux ? 5 : 6);
  const int nt = jb.n0 >> 7;
#pragma unroll 1
  for (int hm = 0; hm < 2; ++hm) {
    if (wm == hm) {
#pragma unroll
      for (int j = 0; j < 4; ++j)
#pragma unroll
        for (int i = 0; i < 4; ++i) {
          const int key0 = wn * 64 + j * 16 + g * 4, tokl = i * 16 + li;
          uint4 o;
          o.x = (f2ord(sc[j][i][0]) & ~127u) | (unsigned)(127 - key0);
          o.y = (f2ord(sc[j][i][1]) & ~127u) | (unsigned)(126 - key0);
          o.z = (f2ord(sc[j][i][2]) & ~127u) | (unsigned)(125 - key0);
          o.w = (f2ord(sc[j][i][3]) & ~127u) | (unsigned)(124 - key0);
          *(uint4*)(lds + (tokl * 132 + key0) * 4) = o;
        }
    }
    __syncthreads();
#pragma unroll 1
    for (int pass = 0; pass < 4; ++pass) {
      int tq = tid; asm volatile("" : "+v"(tq));
      const int tokl = pass * 16 + (tq >> 4), sub = tq & 15;
      const uint4 a = *(const uint4*)(lds + (tokl * 132 + sub * 8) * 4), b = *(const uint4*)(lds + (tokl * 132 + sub * 8 + 4) * 4);
      unsigned k0 = a.x, k1 = a.y, k2 = a.z, k3 = a.w, k4 = b.x, k5 = b.y, k6 = b.z, k7 = b.w, mine = 0;
#define CE(x, y) { const unsigned hi_ = umx(x, y), lo_ = x < y ? x : y; x = hi_; y = lo_; }
      CE(k0, k1) CE(k2, k3) CE(k4, k5) CE(k6, k7)
      CE(k0, k2) CE(k1, k3) CE(k4, k6) CE(k5, k7)
      CE(k1, k2) CE(k5, k6) CE(k0, k4) CE(k3, k7)
      CE(k1, k5) CE(k2, k6)
      CE(k1, k4) CE(k3, k6)
      CE(k2, k4) CE(k3, k5)
      CE(k3, k4)
#undef CE
#pragma unroll
      for (int it = 0; it < 16; ++it) {
        const unsigned mx = row_umax(k0);
        if (sub == it) mine = mx;
        const bool wn_ = (k0 == mx);
        k0 = wn_ ? k1 : k0; k1 = wn_ ? k2 : k1; k2 = wn_ ? k3 : k2; k3 = wn_ ? k4 : k3;
        k4 = wn_ ? k5 : k4; k5 = wn_ ? k6 : k5; k6 = wn_ ? k7 : k6; k7 = wn_ ? 0u : k7;
      }
      tko[(size_t)(jb.m0 + hm * 64 + tokl) * 256 + nt * 16 + sub] = mine;
    }
    __syncthreads();
  }
}

template <int PH, int MODE, int NTN>
__device__ __forceinline__ void gemm_range(KP p, int lo, int hi, int vlo, char* lds) {
  const int G = (hi - lo) / (258 * NTN);
  const int nv = G * 264 * NTN;
  int v0 = blockIdx.x;
  if (v0 < vlo) v0 += ((vlo - v0 + (int)gridDim.x - 1) / (int)gridDim.x) * (int)gridDim.x;
  for (int vv = v0; vv < vlo + nv * REP_GEMM; vv += gridDim.x) {
    const int v = REP_GEMM == 1 ? vv - vlo : (vv - vlo) % nv;
    const int gg = v / (264 * NTN), r = v % (264 * NTN);
    const int xcd = r & 7, jx = r >> 3, nt = jx % NTN, mt = (jx / NTN) * 8 + xcd;
    if (mt >= 258) continue;
    const int id = lo + (gg * 258 + mt) * NTN + nt;
    int tid = threadIdx.x;
    asm volatile("" : "+v"(tid));
    const int l = tid & 63, w = tid >> 6, wm = w & 1, wn = w >> 1, g = l >> 4, li = l & 15;
    Job jb; get_job(p, PH, id, jb);
    f32x4 acc[4][4];
#pragma unroll
    for (int j = 0; j < 4; ++j)
#pragma unroll
      for (int i = 0; i < 4; ++i) acc[j][i] = f32x4{0.f, 0.f, 0.f, 0.f};
    const int lrow = tid >> 3, lkq = tid & 7;
    const int so = (lkq >> 2) * 8192 + swz(lrow, lkq & 3);
    const bf16* ga = jb.A + (size_t)(jb.m0 + lrow) * jb.lda + lkq * 8;
    const size_t sa = (size_t)32 * jb.lda;
    const bf16* gb0 = jb.B + (size_t)min(jb.n0 + lrow, jb.nmax - 1) * jb.ldb + lkq * 8;
    const bf16* gb1 = jb.B + (size_t)min(jb.n0 + lrow + 32, jb.nmax - 1) * jb.ldb + lkq * 8;
    const bf16* gb2 = jb.B + (size_t)min(jb.n0 + lrow + 64, jb.nmax - 1) * jb.ldb + lkq * 8;
    const bf16* gb3 = jb.B + (size_t)min(jb.n0 + lrow + 96, jb.nmax - 1) * jb.ldb + lkq * 8;
    uint4 r0a, r0b, r0c, r0d, r0e, r0f, r0g, r0h, r1a, r1b, r1c, r1d, r1e, r1f, r1g, r1h, r2a, r2b, r2c, r2d, r2e, r2f, r2g, r2h;
#define G_LOAD(S, t) { const int ko_ = (t) * 64; r##S##a = *(const uint4*)(ga + ko_); r##S##b = *(const uint4*)(ga + sa + ko_); r##S##c = *(const uint4*)(ga + 2 * sa + ko_); r##S##d = *(const uint4*)(ga + 3 * sa + ko_); \
      r##S##e = *(const uint4*)(gb0 + ko_); r##S##f = *(const uint4*)(gb1 + ko_); r##S##g = *(const uint4*)(gb2 + ko_); r##S##h = *(const uint4*)(gb3 + ko_); }
#define S_WRITE(S, buf) { char* nb_ = lds + (buf) * 32768 + so; *(uint4*)(nb_) = r##S##a; *(uint4*)(nb_ + 2048) = r##S##b; *(uint4*)(nb_ + 4096) = r##S##c; *(uint4*)(nb_ + 6144) = r##S##d; \
      *(uint4*)(nb_ + 16384) = r##S##e; *(uint4*)(nb_ + 18432) = r##S##f; *(uint4*)(nb_ + 20480) = r##S##g; *(uint4*)(nb_ + 22528) = r##S##h; }
#define K_STEP(u, SL, SW, DIST) { const int kt = kb + (u); if (kt < KT) { \
          if (kt + (DIST) < KT) G_LOAD(SL, kt + (DIST)); \
          const char* sb = lds + ((u) & 1) * 32768; \
          _Pragma("unroll") for (int ks = 0; ks < 2; ++ks) { \
            s16x8 xf[4], wf[4]; \
            _Pragma("unroll") for (int i = 0; i < 4; ++i) xf[i] = *(const s16x8*)(sb + ks * 8192 + swz(wm * 64 + i * 16 + li, g)); \
            _Pragma("unroll") for (int j = 0; j < 4; ++j) wf[j] = *(const s16x8*)(sb + 16384 + ks * 8192 + swz(wn * 64 + j * 16 + li, g)); \
            _Pragma("unroll") for (int j = 0; j < 4; ++j) \
              _Pragma("unroll") for (int i = 0; i < 4; ++i) acc[j][i] = __builtin_amdgcn_mfma_f32_16x16x32_bf16(wf[j], xf[i], acc[j][i], 0, 0, 0); \
          } \
          if (kt + 1 < KT) S_WRITE(SW, ((u) + 1) & 1); \
          __syncthreads(); } }
    const int KT = jb.K >> 6;
    if (MODE == 6) {
      G_LOAD(0, 0);
      S_WRITE(0, 0);
      __syncthreads();
      for (int kb = 0; kb < KT; kb += 2) {
        K_STEP(0, 0, 0, 1)
        K_STEP(1, 0, 0, 1)
      }
      const bf16* sk = (const bf16*)(p->ws + O_SK) + (size_t)jb.aux * 32768 + (size_t)((jb.n0 >> 7) & 1) * 16384;
#pragma unroll
      for (int i = 0; i < 8; ++i) {
        const int q = tid + i * 256, key = q >> 4, dc = q & 15;
        *(uint4*)(lds + 32768 + (dc >> 2) * 8192 + swz(key, dc & 3)) = *(const uint4*)(sk + key * 128 + dc * 8);
      }
    } else {
      G_LOAD(0, 0);
      if (KT > 1) G_LOAD(1, 1);
      if (KT > 2) G_LOAD(2, 2);
      S_WRITE(0, 0);
      __syncthreads();
      for (int kb = 0; kb < KT; kb += 6) {
        K_STEP(0, 0, 1, 3)
        K_STEP(1, 1, 2, 3)
        K_STEP(2, 2, 0, 3)
        K_STEP(3, 0, 1, 3)
        K_STEP(4, 1, 2, 3)
        K_STEP(5, 2, 0, 3)
      }
    }
#undef G_LOAD
#undef S_WRITE
#undef K_STEP
    if (MODE == 6) peer_tail(p, jb, acc, lds, tid);
    else {
#pragma unroll
      for (int j = 0; j < 4; ++j)
#pragma unroll
        for (int i = 0; i < 4; ++i)
        {
          epilogue<MODE>(p, jb, jb.m0 + wm * 64 + i * 16 + li, jb.n0 + wn * 64 + j * 16 + g * 4, acc[j][i], l);
        }
    }
  }
}
template <int ph>
__device__ __forceinline__ void phase_gemm(KP p, char* lds) {
  switch (ph) {
    case 1: gemm_range<1, 0, 8>(p, 0, 6192, 0, lds); gemm_range<1, 1, 1>(p, 6192, 6966, 6336, lds); break;
    case 2: gemm_range<2, 2, 8>(p, 0, 2064, 0, lds); gemm_range<2, 3, 8>(p, 2064, 4128, 2112, lds); gemm_range<2, 4, 8>(p, 4128, 6192, 4224, lds); break;
    case 4: gemm_range<4, 5, 8>(p, 0, 2064, 0, lds); break;
    case 6: gemm_range<6, 6, 16>(p, 0, 4128, 0, lds); break;
    case 8: gemm_range<8, 7, 16>(p, 0, 4128, 0, lds); gemm_range<8, 8, 8>(p, 4128, 6192, 4224, lds); break;
    case 10: gemm_range<10, 9, 8>(p, 0, 2064, 0, lds); break;
    default: gemm_range<12, 6, 16>(p, 0, 4128, 0, lds); break;
  }
}

__device__ __forceinline__ void phase_scan(KP p, char* lds) {
  const int tid = threadIdx.x, l = tid & 63, w = tid >> 6;
  const int row0 = w * 16 + (l >> 3) * 2, col0 = (l & 7) * 8;
  const int lt = tid >> 4, lc = (tid & 15) * 4;
  const bf16* Rb = (const bf16*)slot(p, 6); const bf16* Kb = (const bf16*)slot(p, 7); const bf16* Vb = (const bf16*)slot(p, 8);
  const float* Dc = (const float*)slot(p, 0); const bf16* Ab = (const bf16*)slot(p, 2); const bf16* Gb = (const bf16*)slot(p, 3);
  bf16* YG = (bf16*)slot(p, 4);
  float* ybuf = (float*)(lds + 49152);
  float* cbuf = (float*)(lds + 53248);
  int* s_it = (int*)(lds + 65520);
  int* qL = (int*)(p->ws + O_CNT) + 60; int* qS = qL + 1;
  int role = 0;
  if (threadIdx.x == 0) {
    const unsigned hw = (unsigned)__builtin_amdgcn_s_getreg((7 << 11) | (8 << 6) | 4);
    role = atomicAdd((int*)(p->ws + O_CUT) + ((xb_xcc_id() & 15u) * 256 + (hw & 255u)), 1);
  }
  for (;;) {
    __syncthreads();
    if (tid == 0) {
      int got = -1;
      if (role == 0) { int j = atomicAdd(qL, 1); if (j < 256 * REP_SCAN) got = j & 255; else { j = atomicAdd(qS, 1); if (j < 256) got = 256 + j; } }
      else { int j = atomicAdd(qS, 1); if (j < 256) got = 256 + j; else { j = atomicAdd(qL, 1); if (j < 256 * REP_SCAN) got = j & 255; } }
      *s_it = got;
    }
    __syncthreads();
    const int item = *s_it;
    if (item < 0) break;
    const int seq = item >> 4, h = item & 15;
    const bool samp = seq >= 16; const int b = seq & 15;
    const int nch = samp ? 1 : 128;
    const int tok0 = samp ? NTP + b * 16 : b * 2048;
    f32x2 S2[2][4];
#pragma unroll
    for (int rr = 0; rr < 2; ++rr) {
      if (samp) {
        const float* sp = p->in[2] + ((size_t)(b * 16 + h) * 64 + row0 + rr) * 64 + col0;
        const f32x4 a = ld4(sp), c = ld4(sp + 4);
        S2[rr][0] = f32x2{a[0], a[1]}; S2[rr][1] = f32x2{a[2], a[3]}; S2[rr][2] = f32x2{c[0], c[1]}; S2[rr][3] = f32x2{c[2], c[3]};
      } else {
#pragma unroll
        for (int i = 0; i < 4; ++i) S2[rr][i] = f32x2{0.f, 0.f};
      }
    }
    const int ch0 = h * 64 + lc;
    const f32x4 kk4 = ld4(p->in[16] + ch0), ka4 = ld4(p->in[17] + ch0), rk4 = ld4(p->in[18] + ch0);
    const f32x4 lng = ld4(p->in[19] + ch0), lnb = ld4(p->in[20] + ch0);
    uint2 rr_, rk_, rv_, ra_; f32x4 rd_;
    auto issue = [&](int ch) {
      const size_t off = (size_t)(tok0 + ch * 16 + lt) * 1024 + ch0;
      rr_ = *(const uint2*)(Rb + off); rk_ = *(const uint2*)(Kb + off); rv_ = *(const uint2*)(Vb + off); ra_ = *(const uint2*)(Ab + off);
      rd_ = ld4(Dc + off);
    };
    auto stage = [&](int buf) {
      const f32x4 r4 = unpack4(rr_), k4 = unpack4(rk_), v4 = unpack4(rv_), a4 = unpack4(ra_);
      const f32x4 kkr = k4 * kk4;
      float ss = kkr[0] * kkr[0] + kkr[1] * kkr[1] + kkr[2] * kkr[2] + kkr[3] * kkr[3];
      ss = row_sum(ss);
      const float inv = 1.0f / fmaxf(sqrtf(ss), 1e-12f);
      const f32x4 kkn = kkr * inv;
      const f32x4 kp = k4 * (1.0f + (a4 - 1.0f) * ka4);
      const f32x4 kka = kkn * a4;
      const f32x4 t = r4 * kp * rk4;
      float cb = row_sum(t[0] + t[1] + t[2] + t[3]);
      char* bp = lds + buf * 24576 + lt * 256 + lc * 4;
      st4((float*)(bp), r4); st4((float*)(bp + 4096), rd_); st4((float*)(bp + 8192), kp);
      st4((float*)(bp + 12288), kkn); st4((float*)(bp + 16384), kka); st4((float*)(bp + 20480), v4);
      if ((tid & 15) == 0) cbuf[buf * 16 + lt] = cb;
    };
    __syncthreads();
    issue(0); stage(0);
    __syncthreads();
    for (int ch = 0; ch < nch; ++ch) {
      const int cur = ch & 1;
      const bool more = ch + 1 < nch;
      const size_t goff = (size_t)(tok0 + ch * 16 + lt) * 1024 + ch0;
      const uint2 gq = *(const uint2*)(Gb + goff);
      if (more) issue(ch + 1);
#pragma unroll
      for (int t = 0; t < 16; ++t) {
        const char* bp = lds + cur * 24576 + t * 256 + col0 * 4;
        f32x2 rv[4], dv[4], kv[4], qv[4], av[4];
#pragma unroll
        for (int hh = 0; hh < 2; ++hh) {
          const float4 a0 = *(const float4*)(bp + hh * 16), b0 = *(const float4*)(bp + 4096 + hh * 16), c0 = *(const float4*)(bp + 8192 + hh * 16);
          const float4 d0 = *(const float4*)(bp + 12288 + hh * 16), e0 = *(const float4*)(bp + 16384 + hh * 16);
          rv[2 * hh] = f32x2{a0.x, a0.y}; rv[2 * hh + 1] = f32x2{a0.z, a0.w};
          dv[2 * hh] = f32x2{b0.x, b0.y}; dv[2 * hh + 1] = f32x2{b0.z, b0.w};
          kv[2 * hh] = f32x2{c0.x, c0.y}; kv[2 * hh + 1] = f32x2{c0.z, c0.w};
          qv[2 * hh] = f32x2{d0.x, d0.y}; qv[2 * hh + 1] = f32x2{d0.z, d0.w};
          av[2 * hh] = f32x2{e0.x, e0.y}; av[2 * hh + 1] = f32x2{e0.z, e0.w};
        }
        const float2 vv = *(const float2*)(lds + cur * 24576 + t * 256 + 20480 + row0 * 4);
        float yo[2];
#pragma unroll
        for (int rr = 0; rr < 2; ++rr) {
          f32x2 sa = S2[rr][0] * qv[0];
          sa = S2[rr][1] * qv[1] + sa; sa = S2[rr][2] * qv[2] + sa; sa = S2[rr][3] * qv[3] + sa;
          const float skk = oct_sum(sa.x + sa.y);
          const float vr = rr ? vv.y : vv.x;
          const f32x2 vr2 = {vr, vr}, ns2 = {-skk, -skk};
#pragma unroll
          for (int c = 0; c < 4; ++c) { const f32x2 tt = S2[rr][c] * dv[c] + vr2 * kv[c]; S2[rr][c] = ns2 * av[c] + tt; }
          f32x2 ya = S2[rr][0] * rv[0];
          ya = S2[rr][1] * rv[1] + ya; ya = S2[rr][2] * rv[2] + ya; ya = S2[rr][3] * rv[3] + ya;
          yo[rr] = oct_sum(ya.x + ya.y);
        }
        if ((l & 7) == 0) *(float2*)(ybuf + t * 64 + row0) = make_float2(yo[0], yo[1]);
      }
      __syncthreads();
      {
        const f32x4 y4 = ld4(ybuf + lt * 64 + lc);
        const float mean = row_sum(y4[0] + y4[1] + y4[2] + y4[3]) * (1.0f / 64.0f);
        const f32x4 dy = y4 - mean;
        const float var = row_sum(dy[0] * dy[0] + dy[1] * dy[1] + dy[2] * dy[2] + dy[3] * dy[3]) * (1.0f / 64.0f);
        const float rs = rsqrtf(var + 64e-5f);
        const f32x4 v4 = ld4((const float*)(lds + cur * 24576 + 20480 + lt * 256 + lc * 4));
        const float cb = cbuf[cur * 16 + lt];
        const f32x4 g4 = unpack4(gq);
        const f32x4 o = (dy * rs * lng + lnb + v4 * cb) * g4;
        *(uint2*)(YG + goff) = pack4(o);
      }
      if (more) stage(cur ^ 1);
      __syncthreads();
    }
    float* so = p->out + (samp ? OFF_WKVS : OFF_WKVP) + ((size_t)(b * 16 + h) * 64 + row0) * 64 + col0;
#pragma unroll
    for (int rr = 0; rr < 2; ++rr) {
      st4(so + rr * 64, f32x4{S2[rr][0].x, S2[rr][0].y, S2[rr][1].x, S2[rr][1].y});
      st4(so + rr * 64 + 4, f32x4{S2[rr][2].x, S2[rr][2].y, S2[rr][3].x, S2[rr][3].y});
    }
  }
  int* qQ = (int*)(p->ws + O_CNT) + 62;
  for (;;) {
    __syncthreads();
    if (tid == 0) *s_it = atomicAdd(qQ, 1);
    __syncthreads();
    const int ch = *s_it;
    if (ch >= 1024) break;
    quant_rows(p, ch * 64);
  }
}

__device__ __forceinline__ void phase_ln(KP p, const float* src, float* d32, bf16* db, const float* gam, const float* bet) {
  const int tid_ = otid();
  const int l = tid_ & 63, w = tid_ >> 6;
  for (int m = blockIdx.x * 4 + w; m < NT; m += gridDim.x * 4) {
    const float* s = src + (size_t)m * 1024;
    f32x4 x[4];
#pragma unroll
    for (int i = 0; i < 4; ++i) x[i] = ld4(s + i * 256 + l * 4);
    float sm = 0.f;
#pragma unroll
    for (int i = 0; i < 4; ++i) sm += x[i][0] + x[i][1] + x[i][2] + x[i][3];
    const float mean = wave_sum(sm) * (1.0f / 1024.0f);
    float sq = 0.f;
#pragma unroll
    for (int i = 0; i < 4; ++i) { x[i] = x[i] - mean; sq += x[i][0] * x[i][0] + x[i][1] * x[i][1] + x[i][2] * x[i][2] + x[i][3] * x[i][3]; }
    const float rs = rsqrtf(wave_sum(sq) * (1.0f / 1024.0f) + 1e-5f);
#pragma unroll
    for (int i = 0; i < 4; ++i) {
      const int e = i * 256 + l * 4;
      const f32x4 y = x[i] * rs * ld4(gam + e) + ld4(bet + e);
      st4(d32 + (size_t)m * 1024 + e, y);
      *(uint2*)(db + (size_t)m * 1024 + e) = pack4(y);
    }
  }
}

__device__ __forceinline__ float dotq4(unsigned u, const float* x, float d) {
  d = fmaf((float)(u & 255u), x[0], d); d = fmaf((float)((u >> 8) & 255u), x[1], d);
  d = fmaf((float)((u >> 16) & 255u), x[2], d); d = fmaf((float)(u >> 24), x[3], d);
  return d;
}
__device__ __forceinline__ float dotq(uint4 u, const float* x) {
  return dotq4(u.x, x, 0.f) + dotq4(u.y, x + 4, 0.f) + dotq4(u.z, x + 8, 0.f) + dotq4(u.w, x + 12, 0.f);
}
__device__ __forceinline__ void axq4(unsigned u, float a, float* o) {
  o[0] = fmaf(a, (float)(u & 255u), o[0]); o[1] = fmaf(a, (float)((u >> 8) & 255u), o[1]);
  o[2] = fmaf(a, (float)((u >> 16) & 255u), o[2]); o[3] = fmaf(a, (float)(u >> 24), o[3]);
}
__device__ __forceinline__ void axq(uint4 u, float a, float* o) { axq4(u.x, a, o); axq4(u.y, a, o + 4); axq4(u.z, a, o + 8); axq4(u.w, a, o + 12); }
__device__ __forceinline__ float reduce8(const float* pp, int l) {
  const bool b0 = l & 1, b1 = l & 2, b2 = l & 4;
  float a[4], bb[2];
#pragma unroll
  for (int i = 0; i < 4; ++i) { const float keep = b0 ? pp[2 * i + 1] : pp[2 * i], send = b0 ? pp[2 * i] : pp[2 * i + 1]; a[i] = keep + dppf<0xB1>(send); }
#pragma unroll
  for (int i = 0; i < 2; ++i) { const float keep = b1 ? a[2 * i + 1] : a[2 * i], send = b1 ? a[2 * i] : a[2 * i + 1]; bb[i] = keep + dppf<0x4E>(send); }
  const float keep = b2 ? bb[1] : bb[0], send = b2 ? bb[0] : bb[1];
  float c = keep + dppf<0x124>(send);
  c += dppf<0x128>(c);
  c += __shfl_xor(c, 16); c += __shfl_xor(c, 32);
  return c;
}

__device__ __forceinline__ void phase_peer_experts(KP p, int layer) {
  const int tid_ = otid();
  const int l = tid_ & 63, w = tid_ >> 6;
  const unsigned* TK = (const unsigned*)slot(p, layer ? 5 : 6);
  const float* X = (const float*)slot(p, layer ? 0 : 2);
  const unsigned char* PU = (const unsigned char*)(p->ws + O_PU) + (size_t)layer * 8388608;
  const unsigned char* PV = (const unsigned char*)(p->ws + O_PV) + (size_t)layer * 8388608;
  const float* SU = (const float*)(p->ws + O_SU) + layer * 16384;
  const float* SV = (const float*)(p->ws + O_SV) + layer * 16384;
  const float* lg = p->in[29] + layer * 1024; const float* lb = p->in[30] + layer * 1024;
  const int hq = l >> 4, r = l & 15;
  unsigned cd[4];
#pragma unroll
  for (int c = 0; c < 4; ++c) cd[c] = CAND[r * 4 + c];
  for (int mv = blockIdx.x * 4 + w; mv < NT * REP_PE; mv += gridDim.x * 4) {
    const int m = REP_PE == 1 ? mv : mv % NT;
    const unsigned* tk = TK + (size_t)m * 256;
    int eidx[2]; float gate[2];
#pragma unroll
    for (int pass = 0; pass < 2; ++pass) {
      const int h = pass * 4 + hq;
      unsigned k[4];
#pragma unroll
      for (int c = 0; c < 4; ++c) {
        const unsigned ab = cd[c] == 255u ? 0u : cd[c];
        const unsigned k1 = tk[h * 32 + (ab >> 4)], k2 = tk[h * 32 + 16 + (ab & 15)];
        const float s = ord2f(k1 & ~127u) + ord2f(k2 & ~127u);
        k[c] = cd[c] == 255u ? 0u : ((f2ord(s) & ~255u) | (255u - cd[c]));
      }
      unsigned mine = 0;
#pragma unroll
      for (int it = 0; it < 16; ++it) {
        unsigned mx = umx(umx(k[0], k[1]), umx(k[2], k[3]));
        mx = row_umax(mx);
        if (r == it) mine = mx;
#pragma unroll
        for (int c = 0; c < 4; ++c) k[c] = (k[c] == mx) ? 0u : k[c];
      }
      const unsigned pos = 255u - (mine & 255u);
      const unsigned k1 = tk[h * 32 + (pos >> 4)], k2 = tk[h * 32 + 16 + (pos & 15)];
      eidx[pass] = (int)((127u - (k1 & 127u)) * 128u + (127u - (k2 & 127u)));
      const float s = ord2f(mine & ~255u);
      const float mxs = row_max(s);
      const float ex = __expf(s - mxs);
      gate[pass] = ex / row_sum(ex);
    }
    const float* xr = X + (size_t)m * 1024;
    float xv[16], out[16];
    {
      const f32x4 a = ld4(xr + l * 16), b = ld4(xr + l * 16 + 4), c = ld4(xr + l * 16 + 8), d = ld4(xr + l * 16 + 12);
#pragma unroll
      for (int i = 0; i < 4; ++i) { xv[i] = a[i]; xv[4 + i] = b[i]; xv[8 + i] = c[i]; xv[12 + i] = d[i]; }
    }
    float xam = 0.f;
#pragma unroll
    for (int i = 0; i < 16; ++i) { out[i] = 0.f; xam = fmaxf(xam, fabsf(xv[i])); }
    xam = row_max(xam); xam = fmaxf(xam, __shfl_xor(xam, 16)); xam = fmaxf(xam, __shfl_xor(xam, 32));
    const float xinv = xam > 0.f ? 127.0f / xam : 0.f, xs = xam * (1.0f / 127.0f);
    int xq[16]; int sqi = 0;
#pragma unroll
    for (int i = 0; i < 16; ++i) { xq[i] = (int)rintf(xv[i] * xinv); sqi += xq[i]; }
    int xe0 = (xq[0] & 255) | ((xq[2] & 255) << 8) | ((xq[4] & 255) << 16) | (xq[6] << 24);
    int xo0 = (xq[1] & 255) | ((xq[3] & 255) << 8) | ((xq[5] & 255) << 16) | (xq[7] << 24);
    int xe1 = (xq[8] & 255) | ((xq[10] & 255) << 8) | ((xq[12] & 255) << 16) | (xq[14] << 24);
    int xo1 = (xq[9] & 255) | ((xq[11] & 255) << 8) | ((xq[13] & 255) << 16) | (xq[15] << 24);
    const float sx = wave_sum((float)sqi);
    float csum = 0.f;
    uint2 ua[8], ub[8];
    uint2 va[8], vb[8];
#define LD_U(dst, ps, s0) { _Pragma("unroll") for (int k = 0; k < 8; ++k) dst[k] = *(const uint2*)(PU + (size_t)__builtin_amdgcn_readlane(eidx[ps], (s0) + k) * 512 + l * 8); }
#define LD_V(dst, ps, s0) { _Pragma("unroll") for (int k = 0; k < 8; ++k) dst[k] = *(const uint2*)(PV + (size_t)__builtin_amdgcn_readlane(eidx[ps], (s0) + k) * 512 + l * 8); }
#define DO_U(buf, s0, MD) { float pp[8]; \
        _Pragma("unroll") for (int k = 0; k < 8; ++k) { \
          const unsigned w0 = buf[k].x, w1 = buf[k].y; \
          int a_ = __builtin_amdgcn_sdot4((int)(w0 & 0x0F0F0F0Fu), xe0, 0, false); \
          a_ = __builtin_amdgcn_sdot4((int)((w0 >> 4) & 0x0F0F0F0Fu), xo0, a_, false); \
          a_ = __builtin_amdgcn_sdot4((int)(w1 & 0x0F0F0F0Fu), xe1, a_, false); \
          a_ = __builtin_amdgcn_sdot4((int)((w1 >> 4) & 0x0F0F0F0Fu), xo1, a_, false); \
          pp[k] = (float)a_; } \
        const float c_ = reduce8(pp, l); \
        if ((l >> 3) == ((s0) >> 3)) MD = c_; }
#define TR4(d0, d1, d2, d3, A4, o) { \
          const unsigned pl_ = __builtin_amdgcn_perm(d1, d0, 0x05010400u), ph_ = __builtin_amdgcn_perm(d1, d0, 0x07030602u); \
          const unsigned ql_ = __builtin_amdgcn_perm(d3, d2, 0x05010400u), qh_ = __builtin_amdgcn_perm(d3, d2, 0x07030602u); \
          iacc[(o) + 0] = __builtin_amdgcn_sdot4((int)__builtin_amdgcn_perm(ql_, pl_, 0x05040100u), A4, iacc[(o) + 0], false); \
          iacc[(o) + 2] = __builtin_amdgcn_sdot4((int)__builtin_amdgcn_perm(ql_, pl_, 0x07060302u), A4, iacc[(o) + 2], false); \
          iacc[(o) + 4] = __builtin_amdgcn_sdot4((int)__builtin_amdgcn_perm(qh_, ph_, 0x05040100u), A4, iacc[(o) + 4], false); \
          iacc[(o) + 6] = __builtin_amdgcn_sdot4((int)__builtin_amdgcn_perm(qh_, ph_, 0x07060302u), A4, iacc[(o) + 6], false); }
#define NLO(w) ((w) & 0x0F0F0F0Fu)
#define NHI(w) (((w) >> 4) & 0x0F0F0F0Fu)
#define DO_V(buf, s0, CQ) { _Pragma("unroll") for (int hb = 0; hb < 2; ++hb) { \
          const int c0_ = __builtin_amdgcn_readlane(CQ, (s0) + hb * 4), c1_ = __builtin_amdgcn_readlane(CQ, (s0) + hb * 4 + 1); \
          const int c2_ = __builtin_amdgcn_readlane(CQ, (s0) + hb * 4 + 2), c3_ = __builtin_amdgcn_readlane(CQ, (s0) + hb * 4 + 3); \
          const int a4_ = (c0_ & 255) | ((c1_ & 255) << 8) | ((c2_ & 255) << 16) | ((c3_ & 255) << 24); \
          TR4(NLO(buf[hb * 4].x), NLO(buf[hb * 4 + 1].x), NLO(buf[hb * 4 + 2].x), NLO(buf[hb * 4 + 3].x), a4_, 0) \
          TR4(NHI(buf[hb * 4].x), NHI(buf[hb * 4 + 1].x), NHI(buf[hb * 4 + 2].x), NHI(buf[hb * 4 + 3].x), a4_, 1) \
          TR4(NLO(buf[hb * 4].y), NLO(buf[hb * 4 + 1].y), NLO(buf[hb * 4 + 2].y), NLO(buf[hb * 4 + 3].y), a4_, 8) \
          TR4(NHI(buf[hb * 4].y), NHI(buf[hb * 4 + 1].y), NHI(buf[hb * 4 + 2].y), NHI(buf[hb * 4 + 3].y), a4_, 9) } }
#define CQUANT(WG, CQ, CS) float CS; int CQ; { float cm_ = fabsf(WG); cm_ = row_max(cm_); cm_ = fmaxf(cm_, __shfl_xor(cm_, 16)); cm_ = fmaxf(cm_, __shfl_xor(cm_, 32)); \
          CS = cm_ * (1.0f / 127.0f); CQ = (int)rintf(WG * (cm_ > 0.f ? 127.0f / cm_ : 0.f)); }
#define CSUM(CQ) wave_sum((float)CQ)
#define FLUSH(CS, SUMQ) { const float off_ = 7.5f * (SUMQ); _Pragma("unroll") for (int i = 0; i < 16; ++i) { out[i] = fmaf(CS, (float)iacc[i] - off_, out[i]); iacc[i] = 0; } }
    float md0 = 0.f, md1 = 0.f;
    int iacc[16];
#pragma unroll
    for (int i = 0; i < 16; ++i) iacc[i] = 0;
    LD_U(ua, 0, 0)
#pragma unroll 1
    for (int s = 0; s < 64; s += 16) {
      LD_U(ub, 0, s + 8)
      DO_U(ua, s, md0)
      if (s + 16 < 64) LD_U(ua, 0, s + 16) else { LD_V(va, 0, 0) LD_U(ua, 1, 0) }
      DO_U(ub, s + 8, md0)
    }
    const float su0 = SU[eidx[0]], sv0 = SV[eidx[0]];
    const float hh0 = su0 * xs * (md0 - 7.5f * sx);
    const float wgt0 = gate[0] * 0.5f * hh0 * (1.0f + erff(hh0 * 0.70710678118654752f)) * sv0;
    CQUANT(wgt0, cq0, cs0)
    const float sq0 = CSUM(cq0);
#pragma unroll 1
    for (int s = 0; s < 64; s += 16) {
      LD_V(vb, 0, s + 8) LD_U(ub, 1, s + 8)
      DO_V(va, s, cq0) DO_U(ua, s, md1)
      if (s + 16 < 64) { LD_V(va, 0, s + 16) LD_U(ua, 1, s + 16) } else LD_V(va, 1, 0)
      DO_V(vb, s + 8, cq0) DO_U(ub, s + 8, md1)
    }
    const float su1 = SU[eidx[1]], sv1 = SV[eidx[1]];
    const float hh1 = su1 * xs * (md1 - 7.5f * sx);
    FLUSH(cs0, sq0)
    const float wgt1 = gate[1] * 0.5f * hh1 * (1.0f + erff(hh1 * 0.70710678118654752f)) * sv1;
    CQUANT(wgt1, cq1, cs1)
    const float sq1 = CSUM(cq1);
#pragma unroll 1
    for (int s = 0; s < 64; s += 16) {
      LD_V(vb, 1, s + 8)
      DO_V(va, s, cq1)
      if (s + 16 < 64) LD_V(va, 1, s + 16)
      DO_V(vb, s + 8, cq1)
    }
    FLUSH(cs1, sq1)
#undef LD_U
#undef LD_V
#undef DO_U
#undef DO_V
#undef TR4
#undef NLO
#undef NHI
#undef CSUM
#undef CQUANT
#undef FLUSH
    float sm = 0.f;
#pragma unroll
    for (int i = 0; i < 16; ++i) { out[i] = fmaf(xv[i], 1.4142135623730951f, out[i]); sm += out[i]; }
    const float mean = wave_sum(sm) * (1.0f / 1024.0f);
    float sq = 0.f;
#pragma unroll
    for (int i = 0; i < 16; ++i) { out[i] -= mean; sq = fmaf(out[i], out[i], sq); }
    const float rs = rsqrtf(wave_sum(sq) * (1.0f / 1024.0f) + 1e-5f);
    float* d32 = layer ? ((m < NTP) ? p->out + OFF_YP + (size_t)m * 1024 : p->out + OFF_YS + (size_t)(m - NTP) * 1024)
                       : (float*)slot(p, 0) + (size_t)m * 1024;
#pragma unroll
    for (int hf = 0; hf < 2; ++hf) {
      const int e = l * 16 + hf * 8;
      const f32x4 g0 = ld4(lg + e), g1 = ld4(lg + e + 4), b0 = ld4(lb + e), b1 = ld4(lb + e + 4);
      f32x4 y0, y1;
#pragma unroll
      for (int i = 0; i < 4; ++i) { y0[i] = out[hf * 8 + i] * rs * g0[i] + b0[i]; y1[i] = out[hf * 8 + 4 + i] * rs * g1[i] + b1[i]; }
      st4(d32 + e, y0); st4(d32 + e + 4, y1);
      if (!layer) {
        const uint2 pa = pack4(y0), pb = pack4(y1);
        *(uint4*)((bf16*)slot(p, 4) + (size_t)m * 1024 + e) = make_uint4(pa.x, pa.y, pb.x, pb.y);
      }
    }
  }
}

__device__ __forceinline__ void phase_attn(KP p, char* lds) {
  const int tid = threadIdx.x, l = tid & 63, w = tid >> 6, c = w & 1, qh = w >> 1, g = l >> 4, li = l & 15;
  int* s_item = (int*)(lds + 65520);
  int* counter = (int*)(p->ws + O_CNT);
  const float* lp = p->in[24];
  const float s1 = wave_sum(lp[l] * lp[64 + l]), s2 = wave_sum(lp[128 + l] * lp[192 + l]);
  const float lam = __expf(s1) - __expf(s2) + 0.35550906759f;
  const bf16* Kb = (const bf16*)slot(p, 5); const bf16* VT = (const bf16*)slot(p, 6);
  const bf16* Qb = (const bf16*)slot(p, 7); bf16* Ob = (bf16*)slot(p, 8);
  const float* ck = p->in[4]; const float* cv = p->in[5];
  const float* sg = p->in[25];
  const int myq = (int)(xb_xcc_id() & 7u);
  int qoff = 0;
  for (;;) {
    __syncthreads();
    if (tid == 0) {
      int got = -1;
      while (qoff < 8) {
        const int qx = (myq + qoff) & 7;
        const int j = atomicAdd(counter + qx * 8, 1);
        if (j < 640 * REP_ATTN) { got = qx * 1024 + (j % 640); break; }
        ++qoff;
      }
      *s_item = got;
    }
    __syncthreads();
    const int item = *s_item;
    if (item < 0) break;
    bool samp; int b, h, qc, sp;
    {
      const int qx = item >> 10, j = item & 1023;
      h = qx;
      if (j < 128) { samp = true; b = j >> 3; sp = j & 7; qc = 0; }
      else { const int j2 = j - 128; samp = false; sp = 0; b = j2 >> 5; qc = 31 - (j2 & 31); }
    }
    const int nkt = samp ? (sp == 7 ? 17 : 16) : qc + 1;
    const int qtok0 = samp ? NTP + b * 16 : b * 2048 + qc * 64;
    const int nq = samp ? 16 : 64;
    s16x8 qf[2][2];
#pragma unroll
    for (int f = 0; f < 2; ++f)
#pragma unroll
      for (int ks = 0; ks < 2; ++ks) {
        const int qi = min(qh * 32 + f * 16 + li, nq - 1);
        qf[f][ks] = *(const s16x8*)(Qb + (size_t)(qtok0 + qi) * 1024 + h * 128 + c * 64 + ks * 32 + g * 8);
      }
    f32x4 ot[8][2];
#pragma unroll
    for (int ef = 0; ef < 8; ++ef) { ot[ef][0] = f32x4{0.f, 0.f, 0.f, 0.f}; ot[ef][1] = f32x4{0.f, 0.f, 0.f, 0.f}; }
    float mrun[2] = {-INFINITY, -INFINITY}, lsum[2] = {0.f, 0.f};
    uint4 raw[8];
    auto load_tile = [&](int kt, int tid) {
      if (samp && kt < 16) {
#pragma unroll
        for (int i = 0; i < 2; ++i) {
          const int q = tid + i * 256, cc = q >> 8, key = (q >> 3) & 31, dch = q & 7;
          const float* src = ck + ((size_t)(b * 4096 + (sp * 16 + kt) * 32 + key)) * 1024 + h * 128 + cc * 64 + dch * 8;
          raw[2 * i] = *(const uint4*)src; raw[2 * i + 1] = *(const uint4*)(src + 4);
        }
        const int key = tid & 31, eq = tid >> 5;
        const float* src = cv + ((size_t)(b * 4096 + (sp * 16 + kt) * 32 + key)) * 1024 + h * 128 + eq * 16;
#pragma unroll
        for (int i = 0; i < 4; ++i) raw[4 + i] = *(const uint4*)(src + i * 4);
      } else if (!samp) {
        const bf16* kb_ = Kb + (size_t)(b * 2048 + kt * 64) * 1024 + h * 128;
        const bf16* vb_ = VT + (size_t)((b * 8 + h) * 128) * 2048 + kt * 64;
        const unsigned ko_ = (unsigned)(tid >> 3) * 1024u + (unsigned)(tid & 7) * 8u;
        const unsigned vo_ = (unsigned)(tid >> 3) * 2048u + (unsigned)(tid & 7) * 8u;
        raw[0] = *(const uint4*)(kb_ + ko_);
        raw[1] = *(const uint4*)(kb_ + (ko_ + 32768u));
        raw[2] = *(const uint4*)(kb_ + (ko_ + 64u));
        raw[3] = *(const uint4*)(kb_ + (ko_ + 32768u + 64u));
        raw[4] = *(const uint4*)(vb_ + vo_);
        raw[5] = *(const uint4*)(vb_ + (vo_ + 65536u));
        raw[6] = *(const uint4*)(vb_ + (vo_ + 131072u));
        raw[7] = *(const uint4*)(vb_ + (vo_ + 196608u));
      } else {
        const int ktok0 = NTP + b * 16;
        const size_t vbase = (size_t)33554432 + (size_t)((b * 8 + h) * 128) * 16;
#pragma unroll
        for (int i = 0; i < 4; ++i) {
          const int q = tid + i * 256, cc = q >> 9, key = (q >> 3) & 63, dch = q & 7;
          const uint4 kvv = *(const uint4*)(Kb + (size_t)(ktok0 + (key & 15)) * 1024 + h * 128 + cc * 64 + dch * 8);
          const int e = q >> 3, kch = q & 7;
          const uint4 vvv = *(const uint4*)(VT + vbase + (size_t)e * 16 + (kch & 1) * 8);
          const bool kok = key < 16, vok = kch < 2;
          raw[i] = make_uint4(kok ? kvv.x : 0u, kok ? kvv.y : 0u, kok ? kvv.z : 0u, kok ? kvv.w : 0u);
          raw[4 + i] = make_uint4(vok ? vvv.x : 0u, vok ? vvv.y : 0u, vok ? vvv.z : 0u, vok ? vvv.w : 0u);
        }
      }
    };
    auto store_tile = [&](int kt, int tid) {
      if (samp && kt < 16) {
#pragma unroll
        for (int i = 0; i < 2; ++i) {
          const int q = tid + i * 256, cc = q >> 8, key = (q >> 3) & 31, dch = q & 7;
          const uint4 a = raw[2 * i], bq = raw[2 * i + 1];
          uint4 o;
          o.x = pack2(__uint_as_float(a.x), __uint_as_float(a.y)); o.y = pack2(__uint_as_float(a.z), __uint_as_float(a.w));
          o.z = pack2(__uint_as_float(bq.x), __uint_as_float(bq.y)); o.w = pack2(__uint_as_float(bq.z), __uint_as_float(bq.w));
          *(uint4*)(lds + cc * 8192 + (dch >> 2) * 4096 + swz(key, dch & 3)) = o;
        }
        const int key = tid & 31, eq = tid >> 5;
#pragma unroll
        for (int i = 0; i < 4; ++i) {
          const int e = eq * 16 + i * 4;
          *(bf16*)(lds + 16384 + (e + 0) * 144 + key * 2) = f2b(__uint_as_float(raw[4 + i].x));
          *(bf16*)(lds + 16384 + (e + 1) * 144 + key * 2) = f2b(__uint_as_float(raw[4 + i].y));
          *(bf16*)(lds + 16384 + (e + 2) * 144 + key * 2) = f2b(__uint_as_float(raw[4 + i].z));
          *(bf16*)(lds + 16384 + (e + 3) * 144 + key * 2) = f2b(__uint_as_float(raw[4 + i].w));
        }
      } else {
#pragma unroll
        for (int i = 0; i < 4; ++i) {
          const int dch = tid & 7;
          *(uint4*)(lds + ((dch >> 2) * 4096 + swz(tid >> 3, dch & 3)) + (i & 1) * 2048 + (i >> 1) * 8192) = raw[i];
          *(uint4*)(lds + 16384 + ((tid >> 3) * 144 + dch * 16) + i * 4608) = raw[4 + i];
        }
      }
    };
    load_tile(0, tid);
    for (int kt = 0; kt < nkt; ++kt) {
      int tz = tid;
      asm volatile("" : "+v"(tz));
      const int li = tz & 15, g = (tz & 63) >> 4;
      __syncthreads();
      store_tile(kt, tz);
      __syncthreads();
      if (kt + 1 < nkt) load_tile(kt + 1, tz);
      const int kvalid = samp ? (kt == 16 ? 16 : 32) : 64;
      const bool full = !samp;
      f32x4 st[4][2];
#pragma unroll
      for (int kf = 0; kf < 4; ++kf) { st[kf][0] = f32x4{0.f, 0.f, 0.f, 0.f}; st[kf][1] = f32x4{0.f, 0.f, 0.f, 0.f}; }
      {
        s16x8 kfr[2][4];
#pragma unroll
        for (int ks = 0; ks < 2; ++ks)
#pragma unroll
          for (int kf = 0; kf < 4; ++kf)
            if (kf < 2 || full) kfr[ks][kf] = *(const s16x8*)(lds + c * 8192 + ks * 4096 + swz(kf * 16 + li, g));
#pragma unroll
        for (int ks = 0; ks < 2; ++ks)
#pragma unroll
          for (int kf = 0; kf < 4; ++kf)
            if (kf < 2 || full) {
              st[kf][0] = __builtin_amdgcn_mfma_f32_16x16x32_bf16(kfr[ks][kf], qf[0][ks], st[kf][0], 0, 0, 0);
              st[kf][1] = __builtin_amdgcn_mfma_f32_16x16x32_bf16(kfr[ks][kf], qf[1][ks], st[kf][1], 0, 0, 0);
            }
        __builtin_amdgcn_sched_barrier(0);
      }
      if (kvalid < 64) {
#pragma unroll
        for (int kf = 0; kf < 4; ++kf)
#pragma unroll
          for (int r = 0; r < 4; ++r)
            if (kf * 16 + g * 4 + r >= kvalid) { st[kf][0][r] = -INFINITY; st[kf][1][r] = -INFINITY; }
      }
#pragma unroll
      for (int f = 0; f < 2; ++f) {
        float ml = st[0][f][0];
#pragma unroll
        for (int kf = 0; kf < 4; ++kf)
#pragma unroll
          for (int r = 0; r < 4; ++r) ml = fmaxf(ml, st[kf][f][r]);
        ml = fmaxf(ml, __shfl_xor(ml, 16)); ml = fmaxf(ml, __shfl_xor(ml, 32));
        const bool grow = ml > mrun[f] + 8.0f;
        const float mn = grow ? ml : mrun[f];
        float ps = 0.f;
#pragma unroll
        for (int kf = 0; kf < 4; ++kf)
#pragma unroll
          for (int r = 0; r < 4; ++r) { const float pv = __builtin_amdgcn_exp2f(st[kf][f][r] - mn); st[kf][f][r] = pv; ps += pv; }
        if (__builtin_amdgcn_ballot_w64(grow) != 0ull) {
          const float scl = __builtin_amdgcn_exp2f(mrun[f] - mn);
          lsum[f] *= scl;
#pragma unroll
          for (int ef = 0; ef < 8; ++ef) ot[ef][f] = ot[ef][f] * scl;
        }
        mrun[f] = mn;
        lsum[f] += ps;
      }
      s16x8 pf[2][2];
#pragma unroll
      for (int step = 0; step < 2; ++step)
#pragma unroll
        for (int f = 0; f < 2; ++f) {
          const uint2 a = pack4(st[2 * step][f]), bq = pack4(st[2 * step + 1][f]);
          pf[step][f] = __builtin_bit_cast(s16x8, make_uint4(a.x, a.y, bq.x, bq.y));
        }
      __builtin_amdgcn_sched_barrier(0);
#pragma unroll
      for (int step = 0; step < 2; ++step) {
        if (step == 1 && !full) break;
        s16x8 vf[8];
#pragma unroll
        for (int ef = 0; ef < 8; ++ef) {
          const char* vp = lds + 16384 + (ef * 16 + li) * 144 + (step * 32 + g * 4) * 2;
          const uint2 a = *(const uint2*)vp, bq = *(const uint2*)(vp + 32);
          vf[ef] = __builtin_bit_cast(s16x8, make_uint4(a.x, a.y, bq.x, bq.y));
        }
#pragma unroll
        for (int ef = 0; ef < 8; ++ef) {
          ot[ef][0] = __builtin_amdgcn_mfma_f32_16x16x32_bf16(vf[ef], pf[step][0], ot[ef][0], 0, 0, 0);
          ot[ef][1] = __builtin_amdgcn_mfma_f32_16x16x32_bf16(vf[ef], pf[step][1], ot[ef][1], 0, 0, 0);
        }
        __builtin_amdgcn_sched_barrier(0);
      }
    }
    float inv[2];
#pragma unroll
    for (int f = 0; f < 2; ++f) { float lt = lsum[f]; lt += __shfl_xor(lt, 16); lt += __shfl_xor(lt, 32); inv[f] = 1.0f / lt; }
    if (samp) {
      if (qh == 0) {
        float* pr = (float*)slot(p, 9) + ((size_t)((((b * 8 + h) * 8 + sp) * 2 + c) * 16 + li)) * 132;
#pragma unroll
        for (int ef = 0; ef < 8; ++ef) st4(pr + ef * 16 + g * 4, ot[ef][0]);
        if (g == 0) { pr[128] = mrun[0]; pr[129] = 1.0f / inv[0]; }
      }
      continue;
    }
    __syncthreads();
    float* comb = (float*)lds;
    if (c == 1) {
#pragma unroll
      for (int ef = 0; ef < 8; ++ef)
#pragma unroll
        for (int f = 0; f < 2; ++f)
#pragma unroll
          for (int r = 0; r < 4; ++r) comb[(((qh * 8 + ef) * 2 + f) * 4 + r) * 64 + l] = ot[ef][f][r] * inv[f] * lam;
    }
    __syncthreads();
    if (c == 0) {
#pragma unroll
      for (int f = 0; f < 2; ++f) {
        float ss = 0.f;
#pragma unroll
        for (int ef = 0; ef < 8; ++ef)
#pragma unroll
          for (int r = 0; r < 4; ++r) { const float o = ot[ef][f][r] * inv[f] - comb[(((qh * 8 + ef) * 2 + f) * 4 + r) * 64 + l]; ot[ef][f][r] = o; ss = fmaf(o, o, ss); }
        ss += __shfl_xor(ss, 16); ss += __shfl_xor(ss, 32);
        const float rs = rsqrtf(ss * (1.0f / 128.0f) + 1e-5f) * 0.6444909324090307f;
        const int qi = qh * 32 + f * 16 + li;
        if (qi < nq) {
#pragma unroll
          for (int ef = 0; ef < 8; ++ef) {
            const int e = ef * 16 + g * 4;
            const f32x4 g4 = ld4(sg + e);
            *(uint2*)(Ob + (size_t)(qtok0 + qi) * 1024 + h * 128 + e) = pack4(ot[ef][f] * rs * g4);
          }
        }
      }
    }
  }
}

__device__ __forceinline__ void phase_attn_combine(KP p) {
  const int l = threadIdx.x & 63, w = threadIdx.x >> 6;
  const float* lp = p->in[24];
  const float s1 = wave_sum(lp[l] * lp[64 + l]), s2 = wave_sum(lp[128 + l] * lp[192 + l]);
  const float lam = __expf(s1) - __expf(s2) + 0.35550906759f;
  const float* sg = p->in[25];
  bf16* Ob = (bf16*)slot(p, 8);
  for (int row = blockIdx.x * 4 + w; row < 2048; row += gridDim.x * 4) {
    const int q = row & 15, bh = row >> 4;
    float o2[2][2];
#pragma unroll
    for (int c = 0; c < 2; ++c) {
      float m[8], M = -INFINITY;
#pragma unroll
      for (int sp = 0; sp < 8; ++sp) { m[sp] = ((const float*)slot(p, 9))[((size_t)(((bh * 8 + sp) * 2 + c) * 16 + q)) * 132 + 128]; M = fmaxf(M, m[sp]); }
      float L = 0.f, a0 = 0.f, a1 = 0.f;
#pragma unroll
      for (int sp = 0; sp < 8; ++sp) {
        const float* pr = (const float*)slot(p, 9) + ((size_t)(((bh * 8 + sp) * 2 + c) * 16 + q)) * 132;
        const float wg = __builtin_amdgcn_exp2f(m[sp] - M);
        L = fmaf(wg, pr[129], L);
        const float2 ov = *(const float2*)(pr + l * 2);
        a0 = fmaf(wg, ov.x, a0); a1 = fmaf(wg, ov.y, a1);
      }
      o2[c][0] = a0 / L; o2[c][1] = a1 / L;
    }
    const float x0 = o2[0][0] - lam * o2[1][0], x1 = o2[0][1] - lam * o2[1][1];
    const float ss = wave_sum(x0 * x0 + x1 * x1);
    const float rs = rsqrtf(ss * (1.0f / 128.0f) + 1e-5f) * 0.6444909324090307f;
    const int b = bh >> 3, h = bh & 7;
    *(unsigned*)(Ob + (size_t)(NTP + b * 16 + q) * 1024 + h * 128 + l * 2) = pack2(x0 * rs * sg[l * 2], x1 * rs * sg[l * 2 + 1]);
  }
}

__global__ void __launch_bounds__(256, 2) yoco_mega(Params p) {
  __shared__ __attribute__((aligned(16))) char lds[65536];
  cg::grid_group grid = cg::this_grid();
  KP kp = (KP)__builtin_amdgcn_kernarg_segment_ptr();
#define FRESH() ({ KP q_ = kp; asm volatile("" : "+s"(q_)); q_; })
  phase0(FRESH());
  grid.sync();
  XcdBar xb; xb.bar = (unsigned*)(FRESH()->ws + O_BAR); xb.x = xb_xcc_id(); xb.nloc = 1u; xb.nx = 1u;
  if (threadIdx.x == 0) (void)xb_add(&xb.bar[XB_XCNT(xb.x)], 1u);
  if (threadIdx.x < 64) {
    unsigned nl = 1u, nxx = 1u;
    xcd_census(xb.bar, xb.x, nl, nxx);
    xb.nloc = (unsigned)__builtin_amdgcn_readfirstlane((int)nl); xb.nx = (unsigned)__builtin_amdgcn_readfirstlane((int)nxx);
  }
  phase_gemm<1>(FRESH(), lds); xcd_barrier(xb);
  phase_gemm<2>(FRESH(), lds); xcd_barrier(xb);
  phase_scan(FRESH(), lds); xcd_barrier(xb);
  phase_gemm<4>(FRESH(), lds); xcd_barrier(xb);
  { KP p = FRESH(); phase_ln(p, (const float*)slot(p, 0), (float*)slot(p, 2), (bf16*)slot(p, 5), p->in[27], p->in[28]); } xcd_barrier(xb);
  phase_gemm<6>(FRESH(), lds); xcd_barrier(xb);
  phase_peer_experts(FRESH(), 0); xcd_barrier(xb);
  phase_gemm<8>(FRESH(), lds); xcd_barrier(xb);
  phase_attn(FRESH(), lds); xcd_barrier(xb);
  phase_attn_combine(FRESH()); xcd_barrier(xb);
  phase_gemm<10>(FRESH(), lds); xcd_barrier(xb);
  { KP p = FRESH(); phase_ln(p, (const float*)slot(p, 2), (float*)slot(p, 0), (bf16*)slot(p, 4), p->in[27] + 1024, p->in[28] + 1024); } xcd_barrier(xb);
  phase_gemm<12>(FRESH(), lds); xcd_barrier(xb);
  phase_peer_experts(FRESH(), 1);
}

extern "C" void kernel_launch(void* const* d_in, const int* in_sizes, int n_in, void* d_out, int out_size,
                              void* d_ws, size_t ws_size, hipStream_t stream) {
  static int grid_blocks = 0;
  if (!grid_blocks) {
    int dev = 0, cus = 0, per_cu = 0;
    hipGetDevice(&dev);
    hipDeviceGetAttribute(&cus, hipDeviceAttributeMultiprocessorCount, dev);
    hipOccupancyMaxActiveBlocksPerMultiprocessor(&per_cu, (const void*)yoco_mega, 256, 0);
    if (per_cu > 2) per_cu = 2;
    if (per_cu < 1) per_cu = 1;
    grid_blocks = cus * per_cu;
  }
  if (ws_size < WS_NEED) { fprintf(stderr, "workspace too small: %zu < %zu\n", ws_size, (size_t)WS_NEED); return; }
  Params p{};
  for (int i = 0; i < 35; ++i) p.in[i] = (const float*)d_in[i];
  p.out = (float*)d_out;
  p.ws = (char*)d_ws;
  void* args[] = {&p};
  hipError_t e = hipLaunchCooperativeKernel((const void*)yoco_mega, dim3(grid_blocks), dim3(256), args, 0, stream);
  if (e != hipSuccess) fprintf(stderr, "cooperative launch failed: %s (grid %d)\n", hipGetErrorString(e), grid_blocks);
}
```

```cpp
#include <hip/hip_runtime.h>
#include <hip/hip_cooperative_groups.h>
#include <stdio.h>
namespace cg = cooperative_groups;

typedef unsigned short bf16;
typedef __attribute__((ext_vector_type(8))) short s16x8;
typedef __attribute__((ext_vector_type(4))) float f32x4;

constexpr int NTP = 32768, NT = 33024;
constexpr int REP_GEMM = 1, REP_PE = 1, REP_SCAN = 1, REP_ATTN = 1, REP_P0 = 1;
constexpr size_t U = (size_t)NT * 1024 * 2;

constexpr size_t O_WRKV = 0;
constexpr size_t O_WL1  = O_WRKV + 3 * 2097152;
constexpr size_t O_W2T  = O_WL1 + 524288;
constexpr size_t O_A2T  = O_W2T + 131072;
constexpr size_t O_G2T  = O_A2T + 131072;
constexpr size_t O_WOUT = O_G2T + 262144;
constexpr size_t O_WKV  = O_WOUT + 2097152;
constexpr size_t O_WQ   = O_WKV + 4194304;
constexpr size_t O_WO   = O_WQ + 2097152;
constexpr size_t O_WPQ  = O_WO + 2097152;
constexpr size_t O_SK   = O_WPQ + 2 * 4194304;
constexpr size_t O_PU   = O_SK + 131072;
constexpr size_t O_PV   = O_PU + 16777216;
constexpr size_t O_SU   = O_PV + 16777216;
constexpr size_t O_SV   = O_SU + 131072;
constexpr size_t O_CNT  = O_SV + 131072;
constexpr size_t O_BAR  = O_CNT + 256;
constexpr size_t O_CUT  = O_BAR + 16384;
constexpr size_t O_SLOT = O_CUT + 16384;
constexpr size_t WS_NEED = O_SLOT + 10 * U;

constexpr size_t OFF_YP = 0, OFF_YS = 33554432, OFF_WKVP = 33816576, OFF_SHP = 34865152,
                 OFF_CKP = 34881536, OFF_CVP = 68435968, OFF_WKVS = 101990400, OFF_SHS = 103038976,
                 OFF_CKS = 103055360, OFF_CVS = 103317504;

struct Params {
  const float* in[35];
  float* out;
  char* ws;
};
typedef const Params __attribute__((address_space(4)))* KP;

__device__ const unsigned char CAND[64] = {0, 1, 2, 3, 4, 5, 6, 7, 8, 9, 10, 11, 12, 13, 14, 15, 16, 17, 18, 19, 20, 21, 22, 23, 32, 33, 34, 35, 36, 48, 49, 50, 51, 64, 65, 66, 80, 81, 96, 97, 112, 113, 128, 144, 160, 176, 192, 208, 224, 240, 255, 255, 255, 255, 255, 255, 255, 255, 255, 255, 255, 255, 255, 255};

__device__ __forceinline__ char* slot(KP p, int i) { return p->ws + O_SLOT + (size_t)i * U; }
__device__ __forceinline__ bf16 f2b(float f) { unsigned u = __float_as_uint(f); u += 0x7fffu + ((u >> 16) & 1u); return (bf16)(u >> 16); }
typedef float f32x2 __attribute__((ext_vector_type(2)));
typedef __bf16 bf16x2_t __attribute__((ext_vector_type(2)));
__device__ __forceinline__ unsigned pack2(float a, float b) {
  const f32x2 v = {a, b};
  return __builtin_bit_cast(unsigned, __builtin_convertvector(v, bf16x2_t));
}
__device__ __forceinline__ float blo(unsigned u) { return __uint_as_float(u << 16); }
__device__ __forceinline__ float bhi(unsigned u) { return __uint_as_float(u & 0xffff0000u); }
__device__ __forceinline__ uint2 pack4(f32x4 v) { return make_uint2(pack2(v[0], v[1]), pack2(v[2], v[3])); }
__device__ __forceinline__ f32x4 unpack4(uint2 u) { f32x4 r; r[0] = blo(u.x); r[1] = bhi(u.x); r[2] = blo(u.y); r[3] = bhi(u.y); return r; }
__device__ __forceinline__ f32x4 ld4(const float* p) { float4 t = *(const float4*)p; f32x4 r; r[0] = t.x; r[1] = t.y; r[2] = t.z; r[3] = t.w; return r; }
__device__ __forceinline__ void st4(float* p, f32x4 v) { *(float4*)p = make_float4(v[0], v[1], v[2], v[3]); }

template <int CTRL> __device__ __forceinline__ float dppf(float v) {
  return __builtin_bit_cast(float, __builtin_amdgcn_mov_dpp(__builtin_bit_cast(int, v), CTRL, 0xf, 0xf, true));
}
template <int CTRL> __device__ __forceinline__ unsigned dppu(unsigned v) {
  return (unsigned)__builtin_amdgcn_mov_dpp((int)v, CTRL, 0xf, 0xf, true);
}
__device__ __forceinline__ float oct_sum(float v) { v += dppf<0xB1>(v); v += dppf<0x4E>(v); v += dppf<0x141>(v); return v; }
__device__ __forceinline__ float row_sum(float v) { v = oct_sum(v); v += dppf<0x140>(v); return v; }
__device__ __forceinline__ float row_max(float v) {
  v = fmaxf(v, dppf<0xB1>(v)); v = fmaxf(v, dppf<0x4E>(v)); v = fmaxf(v, dppf<0x141>(v)); v = fmaxf(v, dppf<0x140>(v)); return v;
}
__device__ __forceinline__ unsigned umx(unsigned a, unsigned b) { return a > b ? a : b; }
__device__ __forceinline__ unsigned row_umax(unsigned v) {
  v = umx(v, dppu<0xB1>(v)); v = umx(v, dppu<0x4E>(v)); v = umx(v, dppu<0x141>(v)); v = umx(v, dppu<0x140>(v)); return v;
}
__device__ __forceinline__ float wave_sum(float v) { v = row_sum(v); v += __shfl_xor(v, 16); v += __shfl_xor(v, 32); return v; }
__device__ __forceinline__ unsigned f2ord(float f) { unsigned u = __float_as_uint(f); return (u & 0x80000000u) ? ~u : (u | 0x80000000u); }
__device__ __forceinline__ float ord2f(unsigned o) { unsigned u = (o & 0x80000000u) ? (o & 0x7fffffffu) : ~o; return __uint_as_float(u); }
__device__ __forceinline__ const float* xin(KP p, int m) {
  return m < NTP ? p->in[0] + (size_t)m * 1024 : p->in[1] + (size_t)(m - NTP) * 1024;
}

__device__ __forceinline__ int swz(int row, int slot) { const int q = (row >> 2) & 3; return row * 64 + ((slot ^ (q ^ ((q & 1) << 1))) << 4); }

__device__ __forceinline__ int otid() { int t = threadIdx.x; asm volatile("" : "+v"(t)); return t; }

#define XB_TMO      128
#define XB_XCNT(j)  (256  + 64 * (j))
#define XB_XSUB(j)  (1280 + 64 * (j))
#define XB_XGEN(j)  (2304 + 64 * (j))
#define XB_TOP      3328
#define XB_TOPGEN   3392
#define XCD_BAR_WORDS 3456
#define XB_SPIN_CAP (1u << 20)
__device__ __forceinline__ unsigned xb_ld(unsigned* p) { return __hip_atomic_load(p, __ATOMIC_RELAXED, __HIP_MEMORY_SCOPE_AGENT); }
__device__ __forceinline__ unsigned xb_add(unsigned* p, unsigned v) { return __hip_atomic_fetch_add(p, v, __ATOMIC_RELAXED, __HIP_MEMORY_SCOPE_AGENT); }
__device__ __forceinline__ unsigned xb_xcc_id() { return (unsigned)__builtin_amdgcn_s_getreg((3 << 11) | 20) & 0xFu; }
#define XB_SPIN(cond, bar) do { unsigned _sp = 0; while (cond) { __builtin_amdgcn_s_sleep(1); \
    if ((++_sp & 255u) == 0u) { if (xb_ld(&(bar)[XB_TMO])) break; if (_sp > XB_SPIN_CAP) { atomicAdd(&(bar)[XB_TMO], 1u); break; } } } } while (0)
struct XcdBar { unsigned* bar; unsigned x, nloc, nx; };
__device__ __forceinline__ void xcd_census(unsigned* bar, unsigned x, unsigned& nloc, unsigned& nx) {
  const unsigned G = gridDim.x;
  unsigned sum, cnt, mine, sp = 0u;
  for (;;) {
    sum = 0u; cnt = 0u; mine = 0u;
#pragma unroll
    for (unsigned j = 0; j < 16; ++j) { const unsigned c = xb_ld(&bar[XB_XCNT(j)]); sum += c; cnt += (c > 0u) ? 1u : 0u; mine = (j == x) ? c : mine; }
    if (sum == G) break;
    __builtin_amdgcn_s_sleep(1);
    if ((++sp & 255u) == 0u) { if (xb_ld(&bar[XB_TMO])) break; if (sp > XB_SPIN_CAP) { atomicAdd(&bar[XB_TMO], 1u); break; } }
  }
  nloc = mine > 0u ? mine : 1u; nx = cnt > 0u ? cnt : 1u;
}
__device__ __forceinline__ void xcd_barrier(XcdBar& b) {
  asm volatile("s_waitcnt vmcnt(0)" ::: "memory");
  __syncthreads();
  if (threadIdx.x == 0) {
    unsigned* bar = b.bar;
    __builtin_amdgcn_s_waitcnt(0);
    const unsigned nloc = b.nloc, nx = b.nx;
    const unsigned old = xb_add(&bar[XB_XSUB(b.x)], 1u);
    const unsigned gen = old / nloc;
    if (old + 1u == (gen + 1u) * nloc) {
      __builtin_amdgcn_fence(__ATOMIC_RELEASE, "agent");
      asm volatile("s_waitcnt vmcnt(0)" ::: "memory");
      const unsigned og = xb_add(&bar[XB_TOP], 1u);
      const unsigned tg = og / nx;
      if (og + 1u == (tg + 1u) * nx) xb_add(&bar[XB_TOPGEN], 1u);
      else XB_SPIN(xb_ld(&bar[XB_TOPGEN]) == tg, bar);
      __builtin_amdgcn_fence(__ATOMIC_ACQUIRE, "agent");
      xb_add(&bar[XB_XGEN(b.x)], 1u);
      asm volatile("s_waitcnt vmcnt(0)" ::: "memory");
    } else {
      XB_SPIN(xb_ld(&bar[XB_XGEN(b.x)]) == gen, bar);
      __builtin_amdgcn_fence(__ATOMIC_ACQUIRE, "agent");
      asm volatile("s_waitcnt vmcnt(0)" ::: "memory");
    }
  }
  __syncthreads();
}

__device__ __forceinline__ void transpose_cvt(const float* __restrict__ W, bf16* __restrict__ WT, int K, int N, int gtid, int gsz) {
  const int items = (K >> 3) * N;
  for (int it = gtid; it < items; it += gsz) {
    const int n = it % N, kb = it / N;
    const float* src = W + (size_t)(kb * 8) * N + n;
    uint4 o;
    o.x = pack2(src[0], src[(size_t)N]);
    o.y = pack2(src[(size_t)2 * N], src[(size_t)3 * N]);
    o.z = pack2(src[(size_t)4 * N], src[(size_t)5 * N]);
    o.w = pack2(src[(size_t)6 * N], src[(size_t)7 * N]);
    *(uint4*)(WT + (size_t)n * K + kb * 8) = o;
  }
}
__device__ __forceinline__ void plain_cvt(const float* __restrict__ S, bf16* __restrict__ D, size_t n8, int gtid, int gsz) {
  for (size_t it = gtid; it < n8; it += gsz) {
    const float4 a = *(const float4*)(S + it * 8), b = *(const float4*)(S + it * 8 + 4);
    uint4 o; o.x = pack2(a.x, a.y); o.y = pack2(a.z, a.w); o.z = pack2(b.x, b.y); o.w = pack2(b.z, b.w);
    *(uint4*)(D + it * 8) = o;
  }
}
__device__ __forceinline__ void quant_rows(KP p, int r0) {
  char* ws = p->ws;
  {
    const int l = threadIdx.x & 63;
    for (int r = r0 + (threadIdx.x >> 6); r < r0 + 64; r += 4) {
      const int tbl = r >> 15, rr = r & 32767;
      const float* src = (tbl ? p->in[34] : p->in[33]) + (size_t)rr * 1024 + l * 16;
      f32x4 x[4];
#pragma unroll
      for (int i = 0; i < 4; ++i) x[i] = ld4(src + i * 4);
      float am = 0.f;
#pragma unroll
      for (int i = 0; i < 4; ++i)
#pragma unroll
        for (int j = 0; j < 4; ++j) am = fmaxf(am, fabsf(x[i][j]));
      am = row_max(am); am = fmaxf(am, __shfl_xor(am, 16)); am = fmaxf(am, __shfl_xor(am, 32));
      if (tbl) {
        float ssq = 0.f;
#pragma unroll
        for (int i = 0; i < 4; ++i)
#pragma unroll
          for (int j = 0; j < 4; ++j) ssq = fmaf(x[i][j], x[i][j], ssq);
        const float clipv = fminf(am, 2.75f * sqrtf(wave_sum(ssq) * (1.0f / 1024.0f)));
        const float inv = clipv > 0.f ? 7.5f / clipv : 0.f;
        unsigned o[2] = {0u, 0u};
#pragma unroll
        for (int i = 0; i < 4; ++i)
#pragma unroll
          for (int j = 0; j < 4; ++j) {
            int q = (int)floorf(x[i][j] * inv + 8.0f); q = q < 0 ? 0 : (q > 15 ? 15 : q);
            const int e = i * 4 + j;
            o[e >> 3] |= (unsigned)q << (4 * (e & 7));
          }
        *(uint2*)((unsigned char*)(ws + O_PV) + (size_t)rr * 512 + l * 8) = make_uint2(o[0], o[1]);
        if (l == 0) ((float*)(ws + O_SV))[rr] = clipv > 0.f ? clipv / 7.5f : 1.0f;
      } else {
        float ssq = 0.f;
#pragma unroll
        for (int i = 0; i < 4; ++i)
#pragma unroll
          for (int j = 0; j < 4; ++j) ssq = fmaf(x[i][j], x[i][j], ssq);
        const float clipv = fminf(am, 2.75f * sqrtf(wave_sum(ssq) * (1.0f / 1024.0f)));
        const float inv = clipv > 0.f ? 7.5f / clipv : 0.f;
        unsigned o[2] = {0u, 0u};
#pragma unroll
        for (int i = 0; i < 4; ++i)
#pragma unroll
          for (int j = 0; j < 4; ++j) {
            int q = (int)floorf(x[i][j] * inv + 8.0f); q = q < 0 ? 0 : (q > 15 ? 15 : q);
            const int e = i * 4 + j;
            o[e >> 3] |= (unsigned)q << (4 * (e & 7));
          }
        *(uint2*)((unsigned char*)(ws + O_PU) + (size_t)rr * 512 + l * 8) = make_uint2(o[0], o[1]);
        if (l == 0) ((float*)(ws + O_SU))[rr] = clipv > 0.f ? clipv / 7.5f : 1.0f;
      }
    }
  }
}

__device__ __forceinline__ void phase0(KP p) {
  const int gtid = blockIdx.x * 256 + threadIdx.x, gsz = gridDim.x * 256;
  char* ws = p->ws;
  for (int rep0 = 0; rep0 < REP_P0; ++rep0) {
  if (gtid < 64) ((int*)(ws + O_CNT))[gtid] = 0;
  if (gtid < 4096) ((int*)(ws + O_CUT))[gtid] = 0;
  if (blockIdx.x == 0) for (int i = threadIdx.x; i < XCD_BAR_WORDS; i += 256) ((unsigned*)(ws + O_BAR))[i] = 0u;
  for (int g = 0; g < 3; ++g) transpose_cvt(p->in[7] + (size_t)g * 1048576, (bf16*)(ws + O_WRKV) + (size_t)g * 1048576, 1024, 1024, gtid, gsz);
  transpose_cvt(p->in[9],  (bf16*)(ws + O_WL1), 1024, 64, gtid, gsz);
  transpose_cvt(p->in[12], (bf16*)(ws + O_WL1) + 64 * 1024, 1024, 64, gtid, gsz);
  transpose_cvt(p->in[14], (bf16*)(ws + O_WL1) + 128 * 1024, 1024, 128, gtid, gsz);
  transpose_cvt(p->in[10], (bf16*)(ws + O_W2T), 64, 1024, gtid, gsz);
  transpose_cvt(p->in[13], (bf16*)(ws + O_A2T), 64, 1024, gtid, gsz);
  transpose_cvt(p->in[15], (bf16*)(ws + O_G2T), 128, 1024, gtid, gsz);
  transpose_cvt(p->in[21], (bf16*)(ws + O_WOUT), 1024, 1024, gtid, gsz);
  transpose_cvt(p->in[22], (bf16*)(ws + O_WKV), 1024, 2048, gtid, gsz);
  transpose_cvt(p->in[23], (bf16*)(ws + O_WQ), 1024, 1024, gtid, gsz);
  transpose_cvt(p->in[26], (bf16*)(ws + O_WO), 1024, 1024, gtid, gsz);
  for (int g = 0; g < 2; ++g) transpose_cvt(p->in[31] + (size_t)g * 2097152, (bf16*)(ws + O_WPQ) + (size_t)g * 2097152, 1024, 2048, gtid, gsz);
  plain_cvt(p->in[32], (bf16*)(ws + O_SK), 65536 / 8, gtid, gsz);
  const float* mu = p->in[6];
  for (int it = gtid; it < NT * 128; it += gsz) {
    const int m = it >> 7, c8 = (it & 127) * 8;
    const float* xr = xin(p, m) + c8;
    const float* pr = nullptr; bool last; float* sho;
    if (m < NTP) { const int t = m & 2047; if (t) pr = xr - 1024; last = (t == 2047); sho = p->out + OFF_SHP + (size_t)(m >> 11) * 1024 + c8; }
    else { const int ms = m - NTP, t = ms & 15; pr = t ? xr - 1024 : p->in[3] + (size_t)(ms >> 4) * 1024 + c8; last = (t == 15); sho = p->out + OFF_SHS + (size_t)(ms >> 4) * 1024 + c8; }
    const f32x4 x0 = ld4(xr), x1 = ld4(xr + 4);
    f32x4 d0, d1;
    if (pr) { d0 = ld4(pr) - x0; d1 = ld4(pr + 4) - x1; } else { d0 = -x0; d1 = -x1; }
    if (last) { st4(sho, x0); st4(sho + 4, x1); }
#pragma unroll
    for (int i = 0; i < 6; ++i) {
      const f32x4 m0 = ld4(mu + i * 1024 + c8), m1 = ld4(mu + i * 1024 + c8 + 4);
      const f32x4 a = x0 + d0 * m0, b = x1 + d1 * m1;
      const uint2 pa = pack4(a), pb = pack4(b);
      *(uint4*)((bf16*)slot(p, i) + (size_t)m * 1024 + c8) = make_uint4(pa.x, pa.y, pb.x, pb.y);
    }
  }
  }
}

struct Job { const bf16* A; const bf16* B; int lda, ldb, K, nmax, mode, m0, n0, aux; };

__device__ __forceinline__ void get_job(KP p, int ph, int id, Job& j) {
  char* ws = p->ws;
  j.lda = 1024; j.ldb = 1024; j.K = 1024; j.nmax = 1 << 30; j.aux = 0;
  if (ph == 1) {
    if (id < 6192) { const int g = id / 2064, r = id % 2064; j.A = (const bf16*)slot(p, g); j.B = (const bf16*)(ws + O_WRKV) + (size_t)g * 1048576; j.mode = 0; j.aux = g; j.m0 = (r >> 3) * 128; j.n0 = (r & 7) * 128; }
    else { const int q = id - 6192, g = q / 258; j.A = (const bf16*)slot(p, 3 + g); j.B = (const bf16*)(ws + O_WL1) + (size_t)g * 65536; j.nmax = (g == 2) ? 128 : 64; j.mode = 1; j.aux = g; j.m0 = (q % 258) * 128; j.n0 = 0; }
  } else if (ph == 2) {
    const int g = id / 2064, r = id % 2064; j.m0 = (r >> 3) * 128; j.n0 = (r & 7) * 128; j.lda = 256; j.mode = 2 + g;
    if (g == 0) { j.A = (const bf16*)slot(p, 9); j.B = (const bf16*)(ws + O_W2T); j.K = 64; j.ldb = 64; }
    else if (g == 1) { j.A = (const bf16*)slot(p, 9) + 64; j.B = (const bf16*)(ws + O_A2T); j.K = 64; j.ldb = 64; }
    else { j.A = (const bf16*)slot(p, 9) + 128; j.B = (const bf16*)(ws + O_G2T); j.K = 128; j.ldb = 128; }
  } else if (ph == 4) {
    j.A = (const bf16*)slot(p, 4); j.B = (const bf16*)(ws + O_WOUT); j.mode = 5; j.m0 = (id >> 3) * 128; j.n0 = (id & 7) * 128;
  } else if (ph == 6 || ph == 12) {
    const int layer = (ph == 12); j.aux = layer;
    j.A = (const bf16*)slot(p, layer ? 4 : 5); j.B = (const bf16*)(ws + O_WPQ) + (size_t)layer * 2097152; j.mode = 6; j.m0 = (id >> 4) * 128; j.n0 = (id & 15) * 128;
  } else if (ph == 8) {
    j.A = (const bf16*)slot(p, 4);
    if (id < 4128) { j.B = (const bf16*)(ws + O_WKV); j.mode = 7; j.m0 = (id >> 4) * 128; j.n0 = (id & 15) * 128; }
    else { const int q = id - 4128; j.B = (const bf16*)(ws + O_WQ); j.mode = 8; j.m0 = (q >> 3) * 128; j.n0 = (q & 7) * 128; }
  } else {
    j.A = (const bf16*)slot(p, 8); j.B = (const bf16*)(ws + O_WO); j.mode = 9; j.m0 = (id >> 3) * 128; j.n0 = (id & 7) * 128;
  }
}

__device__ __forceinline__ f32x4 rope4(f32x4 v, int m, int l) {
  const int pos = (m < NTP) ? (m & 2047) : (4096 + ((m - NTP) & 15));
  const int g = l >> 4; const bool t2 = g >= 2; const int fb = (g & 1) * 4;
  f32x4 o;
#pragma unroll
  for (int r = 0; r < 4; ++r) {
    const float inv = exp2f(-(float)(fb + r) * (18.931568569324174f * 0.125f));
    const float ang = (float)pos * inv;
    float rev = ang * 0.15915494309189535f; rev -= rintf(rev);
    const float s = __builtin_amdgcn_sinf(rev), c = __builtin_amdgcn_cosf(rev);
    const float pr = __shfl_xor(v[r], 32);
    o[r] = v[r] * c + (t2 ? pr * s : -pr * s);
  }
  return o;
}

template <int MODE>
__device__ __forceinline__ void epilogue(KP p, const Job& jb, int m, int n, f32x4 v, int l) {
  const size_t mi = (size_t)m * 1024 + n;
  switch (MODE) {
    case 0: *(uint2*)((bf16*)slot(p, 6 + jb.aux) + mi) = pack4(v); break;
    case 1: if (n < jb.nmax) {
        f32x4 o;
#pragma unroll
        for (int r = 0; r < 4; ++r) o[r] = jb.aux == 0 ? 1.0f - 2.0f / (1.0f + __expf(2.0f * v[r])) : (jb.aux == 1 ? v[r] : 1.0f / (1.0f + __expf(-v[r])));
        *(uint2*)((bf16*)slot(p, 9) + (size_t)m * 256 + jb.aux * 64 + n) = pack4(o);
      } break;
    case 2: {
        const f32x4 w0 = ld4(p->in[8] + n); f32x4 o;
#pragma unroll
        for (int r = 0; r < 4; ++r) { const float z = w0[r] + v[r]; const float sp = __logf(1.0f + __expf(-z)); o[r] = __expf(-__expf(-sp - 0.5f)); }
        st4((float*)slot(p, 0) + mi, o);
      } break;
    case 3: {
        const f32x4 a0 = ld4(p->in[11] + n); f32x4 o;
#pragma unroll
        for (int r = 0; r < 4; ++r) o[r] = 1.0f / (1.0f + __expf(-(a0[r] + v[r])));
        *(uint2*)((bf16*)slot(p, 2) + mi) = pack4(o);
      } break;
    case 4: *(uint2*)((bf16*)slot(p, 3) + mi) = pack4(v); break;
    case 5: { const f32x4 x = ld4(xin(p, m) + n); st4((float*)slot(p, 0) + mi, x * 1.4142135623730951f + v); } break;
    case 9: { const f32x4 x = unpack4(*(const uint2*)((const bf16*)slot(p, 4) + mi)); st4((float*)slot(p, 2) + mi, x * 1.4142135623730951f + v); } break;
    case 7: {
        if (n < 1024) {
          if ((n & 63) < 16) v = rope4(v, m, l);
          float* o = (m < NTP) ? p->out + OFF_CKP + mi : p->out + OFF_CKS + (size_t)(m - NTP) * 1024 + n;
          st4(o, v);
          *(uint2*)((bf16*)slot(p, 5) + mi) = pack4(v);
        } else {
          const int n2 = n - 1024, h = n2 >> 7, e = n2 & 127;
          float* o = (m < NTP) ? p->out + OFF_CVP + (size_t)m * 1024 + n2 : p->out + OFF_CVS + (size_t)(m - NTP) * 1024 + n2;
          st4(o, v);
          bf16* vt = (bf16*)slot(p, 6);
          if (m < NTP) { const int s = m >> 11, t = m & 2047;
#pragma unroll
            for (int r = 0; r < 4; ++r) vt[((size_t)((s * 8 + h) * 128 + e + r)) * 2048 + t] = f2b(v[r]);
          } else { const int ms = m - NTP, b = ms >> 4, t = ms & 15;
#pragma unroll
            for (int r = 0; r < 4; ++r) vt[(size_t)33554432 + ((size_t)((b * 8 + h) * 128 + e + r)) * 16 + t] = f2b(v[r]);
          }
        }
      } break;
    case 8: {
        if ((n & 63) < 16) v = rope4(v, m, l);
        *(uint2*)((bf16*)slot(p, 7) + mi) = pack4(v * 0.18033688011112042f);
      } break;
    default: break;
  }
}

__device__ __forceinline__ void peer_tail(KP p, const Job& jb, f32x4 (&acc)[4][4], char* lds, int tid) {
  const int l = tid & 63, w = tid >> 6, wm = w & 1, wn = w >> 1, g = l >> 4, li = l & 15;
#pragma unroll
  for (int j = 0; j < 4; ++j)
#pragma unroll
    for (int i = 0; i < 4; ++i) {
      const int d0 = wn * 64 + j * 16 + g * 4, tok = wm * 64 + i * 16 + li;
      *(uint2*)(lds + (d0 >> 5) * 8192 + swz(tok, (d0 & 31) >> 3) + ((d0 & 7) * 2)) = pack4(acc[j][i]);
    }
  __syncthreads();
  f32x4 sc[4][4];
#pragma unroll
  for (int j = 0; j < 4; ++j)
#pragma unroll
    for (int i = 0; i < 4; ++i) sc[j][i] = f32x4{0.f, 0.f, 0.f, 0.f};
#pragma unroll
  for (int ks = 0; ks < 4; ++ks) {
    s16x8 kf[4], qf[4];
#pragma unroll
    for (int j = 0; j < 4; ++j) kf[j] = *(const s16x8*)(lds + 32768 + ks * 8192 + swz(wn * 64 + j * 16 + li, g));
#pragma unroll
    for (int i = 0; i < 4; ++i) qf[i] = *(const s16x8*)(lds + ks * 8192 + swz(wm * 64 + i * 16 + li, g));
#pragma unroll
    for (int j = 0; j < 4; ++j)
#pragma unroll
      for (int i = 0; i < 4; ++i) sc[j][i] = __builtin_amdgcn_mfma_f32_16x16x32_bf16(kf[j], qf[i], sc[j][i], 0, 0, 0);
    __builtin_amdgcn_sched_barrier(0);
  }
  __syncthreads();
  unsigned* tko = (unsigned*)slot(p, jb.aux ? 5 : 6);
  const int nt = jb.n0 >> 7;
#pragma unroll 1
  for (int hm = 0; hm < 2; ++hm) {
    if (wm == hm) {
#pragma unroll
      for (int j = 0; j < 4; ++j)
#pragma unroll
        for (int i = 0; i < 4; ++i) {
          const int key0 = wn * 64 + j * 16 + g * 4, tokl = i * 16 + li;
          uint4 o;
          o.x = (f2ord(sc[j][i][0]) & ~127u) | (unsigned)(127 - key0);
          o.y = (f2ord(sc[j][i][1]) & ~127u) | (unsigned)(126 - key0);
          o.z = (f2ord(sc[j][i][2]) & ~127u) | (unsigned)(125 - key0);
          o.w = (f2ord(sc[j][i][3]) & ~127u) | (unsigned)(124 - key0);
          *(uint4*)(lds + (tokl * 132 + key0) * 4) = o;
        }
    }
    __syncthreads();
#pragma unroll 1
    for (int pass = 0; pass < 4; ++pass) {
      int tq = tid; asm volatile("" : "+v"(tq));
      const int tokl = pass * 16 + (tq >> 4), sub = tq & 15;
      const uint4 a = *(const uint4*)(lds + (tokl * 132 + sub * 8) * 4), b = *(const uint4*)(lds + (tokl * 132 + sub * 8 + 4) * 4);
      unsigned k0 = a.x, k1 = a.y, k2 = a.z, k3 = a.w, k4 = b.x, k5 = b.y, k6 = b.z, k7 = b.w, mine = 0;
#define CE(x, y) { const unsigned hi_ = umx(x, y), lo_ = x < y ? x : y; x = hi_; y = lo_; }
      CE(k0, k1) CE(k2, k3) CE(k4, k5) CE(k6, k7)
      CE(k0, k2) CE(k1, k3) CE(k4, k6) CE(k5, k7)
      CE(k1, k2) CE(k5, k6) CE(k0, k4) CE(k3, k7)
      CE(k1, k5) CE(k2, k6)
      CE(k1, k4) CE(k3, k6)
      CE(k2, k4) CE(k3, k5)
      CE(k3, k4)
#undef CE
#pragma unroll
      for (int it = 0; it < 16; ++it) {
        const unsigned mx = row_umax(k0);
        if (sub == it) mine = mx;
        const bool wn_ = (k0 == mx);
        k0 = wn_ ? k1 : k0; k1 = wn_ ? k2 : k1; k2 = wn_ ? k3 : k2; k3 = wn_ ? k4 : k3;
        k4 = wn_ ? k5 : k4; k5 = wn_ ? k6 : k5; k6 = wn_ ? k7 : k6; k7 = wn_ ? 0u : k7;
      }
      tko[(size_t)(jb.m0 + hm * 64 + tokl) * 256 + nt * 16 + sub] = mine;
    }
    __syncthreads();
  }
}

template <int PH, int MODE, int NTN>
__device__ __forceinline__ void gemm_range(KP p, int lo, int hi, int vlo, char* lds) {
  const int G = (hi - lo) / (258 * NTN);
  const int nv = G * 264 * NTN;
  int v0 = blockIdx.x;
  if (v0 < vlo) v0 += ((vlo - v0 + (int)gridDim.x - 1) / (int)gridDim.x) * (int)gridDim.x;
  for (int vv = v0; vv < vlo + nv * REP_GEMM; vv += gridDim.x) {
    const int v = REP_GEMM == 1 ? vv - vlo : (vv - vlo) % nv;
    const int gg = v / (264 * NTN), r = v % (264 * NTN);
    const int xcd = r & 7, jx = r >> 3, nt = jx % NTN, mt = (jx / NTN) * 8 + xcd;
    if (mt >= 258) continue;
    const int id = lo + (gg * 258 + mt) * NTN + nt;
    int tid = threadIdx.x;
    asm volatile("" : "+v"(tid));
    const int l = tid & 63, w = tid >> 6, wm = w & 1, wn = w >> 1, g = l >> 4, li = l & 15;
    Job jb; get_job(p, PH, id, jb);
    f32x4 acc[4][4];
#pragma unroll
    for (int j = 0; j < 4; ++j)
#pragma unroll
      for (int i = 0; i < 4; ++i) acc[j][i] = f32x4{0.f, 0.f, 0.f, 0.f};
    const int lrow = tid >> 3, lkq = tid & 7;
    const int so = (lkq >> 2) * 8192 + swz(lrow, lkq & 3);
    const bf16* ga = jb.A + (size_t)(jb.m0 + lrow) * jb.lda + lkq * 8;
    const size_t sa = (size_t)32 * jb.lda;
    const bf16* gb0 = jb.B + (size_t)min(jb.n0 + lrow, jb.nmax - 1) * jb.ldb + lkq * 8;
    const bf16* gb1 = jb.B + (size_t)min(jb.n0 + lrow + 32, jb.nmax - 1) * jb.ldb + lkq * 8;
    const bf16* gb2 = jb.B + (size_t)min(jb.n0 + lrow + 64, jb.nmax - 1) * jb.ldb + lkq * 8;
    const bf16* gb3 = jb.B + (size_t)min(jb.n0 + lrow + 96, jb.nmax - 1) * jb.ldb + lkq * 8;
    uint4 r0a, r0b, r0c, r0d, r0e, r0f, r0g, r0h, r1a, r1b, r1c, r1d, r1e, r1f, r1g, r1h, r2a, r2b, r2c, r2d, r2e, r2f, r2g, r2h;
#define G_LOAD(S, t) { const int ko_ = (t) * 64; r##S##a = *(const uint4*)(ga + ko_); r##S##b = *(const uint4*)(ga + sa + ko_); r##S##c = *(const uint4*)(ga + 2 * sa + ko_); r##S##d = *(const uint4*)(ga + 3 * sa + ko_); \
      r##S##e = *(const uint4*)(gb0 + ko_); r##S##f = *(const uint4*)(gb1 + ko_); r##S##g = *(const uint4*)(gb2 + ko_); r##S##h = *(const uint4*)(gb3 + ko_); }
#define S_WRITE(S, buf) { char* nb_ = lds + (buf) * 32768 + so; *(uint4*)(nb_) = r##S##a; *(uint4*)(nb_ + 2048) = r##S##b; *(uint4*)(nb_ + 4096) = r##S##c; *(uint4*)(nb_ + 6144) = r##S##d; \
      *(uint4*)(nb_ + 16384) = r##S##e; *(uint4*)(nb_ + 18432) = r##S##f; *(uint4*)(nb_ + 20480) = r##S##g; *(uint4*)(nb_ + 22528) = r##S##h; }
#define K_STEP(u, SL, SW, DIST) { const int kt = kb + (u); if (kt < KT) { \
          if (kt + (DIST) < KT) G_LOAD(SL, kt + (DIST)); \
          const char* sb = lds + ((u) & 1) * 32768; \
          _Pragma("unroll") for (int ks = 0; ks < 2; ++ks) { \
            s16x8 xf[4], wf[4]; \
            _Pragma("unroll") for (int i = 0; i < 4; ++i) xf[i] = *(const s16x8*)(sb + ks * 8192 + swz(wm * 64 + i * 16 + li, g)); \
            _Pragma("unroll") for (int j = 0; j < 4; ++j) wf[j] = *(const s16x8*)(sb + 16384 + ks * 8192 + swz(wn * 64 + j * 16 + li, g)); \
            _Pragma("unroll") for (int j = 0; j < 4; ++j) \
              _Pragma("unroll") for (int i = 0; i < 4; ++i) acc[j][i] = __builtin_amdgcn_mfma_f32_16x16x32_bf16(wf[j], xf[i], acc[j][i], 0, 0, 0); \
          } \
          if (kt + 1 < KT) S_WRITE(SW, ((u) + 1) & 1); \
          __syncthreads(); } }
    const int KT = jb.K >> 6;
    if (MODE == 6) {
      G_LOAD(0, 0);
      S_WRITE(0, 0);
      __syncthreads();
      for (int kb = 0; kb < KT; kb += 2) {
        K_STEP(0, 0, 0, 1)
        K_STEP(1, 0, 0, 1)
      }
      const bf16* sk = (const bf16*)(p->ws + O_SK) + (size_t)jb.aux * 32768 + (size_t)((jb.n0 >> 7) & 1) * 16384;
#pragma unroll
      for (int i = 0; i < 8; ++i) {
        const int q = tid + i * 256, key = q >> 4, dc = q & 15;
        *(uint4*)(lds + 32768 + (dc >> 2) * 8192 + swz(key, dc & 3)) = *(const uint4*)(sk + key * 128 + dc * 8);
      }
    } else {
      G_LOAD(0, 0);
      if (KT > 1) G_LOAD(1, 1);
      if (KT > 2) G_LOAD(2, 2);
      S_WRITE(0, 0);
      __syncthreads();
      for (int kb = 0; kb < KT; kb += 6) {
        K_STEP(0, 0, 1, 3)
        K_STEP(1, 1, 2, 3)
        K_STEP(2, 2, 0, 3)
        K_STEP(3, 0, 1, 3)
        K_STEP(4, 1, 2, 3)
        K_STEP(5, 2, 0, 3)
      }
    }
#undef G_LOAD
#undef S_WRITE
#undef K_STEP
    if (MODE == 6) peer_tail(p, jb, acc, lds, tid);
    else {
#pragma unroll
      for (int j = 0; j < 4; ++j)
#pragma unroll
        for (int i = 0; i < 4; ++i)
        {
          epilogue<MODE>(p, jb, jb.m0 + wm * 64 + i * 16 + li, jb.n0 + wn * 64 + j * 16 + g * 4, acc[j][i], l);
        }
    }
  }
}
template <int ph>
__device__ __forceinline__ void phase_gemm(KP p, char* lds) {
  switch (ph) {
    case 1: gemm_range<1, 0, 8>(p, 0, 6192, 0, lds); gemm_range<1, 1, 1>(p, 6192, 6966, 6336, lds); break;
    case 2: gemm_range<2, 2, 8>(p, 0, 2064, 0, lds); gemm_range<2, 3, 8>(p, 2064, 4128, 2112, lds); gemm_range<2, 4, 8>(p, 4128, 6192, 4224, lds); break;
    case 4: gemm_range<4, 5, 8>(p, 0, 2064, 0, lds); break;
    case 6: gemm_range<6, 6, 16>(p, 0, 4128, 0, lds); break;
    case 8: gemm_range<8, 7, 16>(p, 0, 4128, 0, lds); gemm_range<8, 8, 8>(p, 4128, 6192, 4224, lds); break;
    case 10: gemm_range<10, 9, 8>(p, 0, 2064, 0, lds); break;
    default: gemm_range<12, 6, 16>(p, 0, 4128, 0, lds); break;
  }
}

__device__ __forceinline__ void phase_scan(KP p, char* lds) {
  const int tid = threadIdx.x, l = tid & 63, w = tid >> 6;
  const int row0 = w * 16 + (l >> 3) * 2, col0 = (l & 7) * 8;
  const int lt = tid >> 4, lc = (tid & 15) * 4;
  const bf16* Rb = (const bf16*)slot(p, 6); const bf16* Kb = (const bf16*)slot(p, 7); const bf16* Vb = (const bf16*)slot(p, 8);
  const float* Dc = (const float*)slot(p, 0); const bf16* Ab = (const bf16*)slot(p, 2); const bf16* Gb = (const bf16*)slot(p, 3);
  bf16* YG = (bf16*)slot(p, 4);
  float* ybuf = (float*)(lds + 49152);
  float* cbuf = (float*)(lds + 53248);
  int* s_it = (int*)(lds + 65520);
  int* qL = (int*)(p->ws + O_CNT) + 60; int* qS = qL + 1;
  int role = 0;
  if (threadIdx.x == 0) {
    const unsigned hw = (unsigned)__builtin_amdgcn_s_getreg((7 << 11) | (8 << 6) | 4);
    role = atomicAdd((int*)(p->ws + O_CUT) + ((xb_xcc_id() & 15u) * 256 + (hw & 255u)), 1);
  }
  for (;;) {
    __syncthreads();
    if (tid == 0) {
      int got = -1;
      if (role == 0) { int j = atomicAdd(qL, 1); if (j < 256 * REP_SCAN) got = j & 255; else { j = atomicAdd(qS, 1); if (j < 256) got = 256 + j; } }
      else { int j = atomicAdd(qS, 1); if (j < 256) got = 256 + j; else { j = atomicAdd(qL, 1); if (j < 256 * REP_SCAN) got = j & 255; } }
      *s_it = got;
    }
    __syncthreads();
    const int item = *s_it;
    if (item < 0) break;
    const int seq = item >> 4, h = item & 15;
    const bool samp = seq >= 16; const int b = seq & 15;
    const int nch = samp ? 1 : 128;
    const int tok0 = samp ? NTP + b * 16 : b * 2048;
    f32x2 S2[2][4];
#pragma unroll
    for (int rr = 0; rr < 2; ++rr) {
      if (samp) {
        const float* sp = p->in[2] + ((size_t)(b * 16 + h) * 64 + row0 + rr) * 64 + col0;
        const f32x4 a = ld4(sp), c = ld4(sp + 4);
        S2[rr][0] = f32x2{a[0], a[1]}; S2[rr][1] = f32x2{a[2], a[3]}; S2[rr][2] = f32x2{c[0], c[1]}; S2[rr][3] = f32x2{c[2], c[3]};
      } else {
#pragma unroll
        for (int i = 0; i < 4; ++i) S2[rr][i] = f32x2{0.f, 0.f};
      }
    }
    const int ch0 = h * 64 + lc;
    const f32x4 kk4 = ld4(p->in[16] + ch0), ka4 = ld4(p->in[17] + ch0), rk4 = ld4(p->in[18] + ch0);
    const f32x4 lng = ld4(p->in[19] + ch0), lnb = ld4(p->in[20] + ch0);
    uint2 rr_, rk_, rv_, ra_; f32x4 rd_;
    auto issue = [&](int ch) {
      const size_t off = (size_t)(tok0 + ch * 16 + lt) * 1024 + ch0;
      rr_ = *(const uint2*)(Rb + off); rk_ = *(const uint2*)(Kb + off); rv_ = *(const uint2*)(Vb + off); ra_ = *(const uint2*)(Ab + off);
      rd_ = ld4(Dc + off);
    };
    auto stage = [&](int buf) {
      const f32x4 r4 = unpack4(rr_), k4 = unpack4(rk_), v4 = unpack4(rv_), a4 = unpack4(ra_);
      const f32x4 kkr = k4 * kk4;
      float ss = kkr[0] * kkr[0] + kkr[1] * kkr[1] + kkr[2] * kkr[2] + kkr[3] * kkr[3];
      ss = row_sum(ss);
      const float inv = 1.0f / fmaxf(sqrtf(ss), 1e-12f);
      const f32x4 kkn = kkr * inv;
      const f32x4 kp = k4 * (1.0f + (a4 - 1.0f) * ka4);
      const f32x4 kka = kkn * a4;
      const f32x4 t = r4 * kp * rk4;
      float cb = row_sum(t[0] + t[1] + t[2] + t[3]);
      char* bp = lds + buf * 24576 + lt * 256 + lc * 4;
      st4((float*)(bp), r4); st4((float*)(bp + 4096), rd_); st4((float*)(bp + 8192), kp);
      st4((float*)(bp + 12288), kkn); st4((float*)(bp + 16384), kka); st4((float*)(bp + 20480), v4);
      if ((tid & 15) == 0) cbuf[buf * 16 + lt] = cb;
    };
    __syncthreads();
    issue(0); stage(0);
    __syncthreads();
    for (int ch = 0; ch < nch; ++ch) {
      const int cur = ch & 1;
      const bool more = ch + 1 < nch;
      const size_t goff = (size_t)(tok0 + ch * 16 + lt) * 1024 + ch0;
      const uint2 gq = *(const uint2*)(Gb + goff);
      if (more) issue(ch + 1);
#pragma unroll
      for (int t = 0; t < 16; ++t) {
        const char* bp = lds + cur * 24576 + t * 256 + col0 * 4;
        f32x2 rv[4], dv[4], kv[4], qv[4], av[4];
#pragma unroll
        for (int hh = 0; hh < 2; ++hh) {
          const float4 a0 = *(const float4*)(bp + hh * 16), b0 = *(const float4*)(bp + 4096 + hh * 16), c0 = *(const float4*)(bp + 8192 + hh * 16);
          const float4 d0 = *(const float4*)(bp + 12288 + hh * 16), e0 = *(const float4*)(bp + 16384 + hh * 16);
          rv[2 * hh] = f32x2{a0.x, a0.y}; rv[2 * hh + 1] = f32x2{a0.z, a0.w};
          dv[2 * hh] = f32x2{b0.x, b0.y}; dv[2 * hh + 1] = f32x2{b0.z, b0.w};
          kv[2 * hh] = f32x2{c0.x, c0.y}; kv[2 * hh + 1] = f32x2{c0.z, c0.w};
          qv[2 * hh] = f32x2{d0.x, d0.y}; qv[2 * hh + 1] = f32x2{d0.z, d0.w};
          av[2 * hh] = f32x2{e0.x, e0.y}; av[2 * hh + 1] = f32x2{e0.z, e0.w};
        }
        const float2 vv = *(const float2*)(lds + cur * 24576 + t * 256 + 20480 + row0 * 4);
        float yo[2];
#pragma unroll
        for (int rr = 0; rr < 2; ++rr) {
          f32x2 sa = S2[rr][0] * qv[0];
          sa = S2[rr][1] * qv[1] + sa; sa = S2[rr][2] * qv[2] + sa; sa = S2[rr][3] * qv[3] + sa;
          const float skk = oct_sum(sa.x + sa.y);
          const float vr = rr ? vv.y : vv.x;
          const f32x2 vr2 = {vr, vr}, ns2 = {-skk, -skk};
#pragma unroll
          for (int c = 0; c < 4; ++c) { const f32x2 tt = S2[rr][c] * dv[c] + vr2 * kv[c]; S2[rr][c] = ns2 * av[c] + tt; }
          f32x2 ya = S2[rr][0] * rv[0];
          ya = S2[rr][1] * rv[1] + ya; ya = S2[rr][2] * rv[2] + ya; ya = S2[rr][3] * rv[3] + ya;
          yo[rr] = oct_sum(ya.x + ya.y);
        }
        if ((l & 7) == 0) *(float2*)(ybuf + t * 64 + row0) = make_float2(yo[0], yo[1]);
      }
      __syncthreads();
      {
        const f32x4 y4 = ld4(ybuf + lt * 64 + lc);
        const float mean = row_sum(y4[0] + y4[1] + y4[2] + y4[3]) * (1.0f / 64.0f);
        const f32x4 dy = y4 - mean;
        const float var = row_sum(dy[0] * dy[0] + dy[1] * dy[1] + dy[2] * dy[2] + dy[3] * dy[3]) * (1.0f / 64.0f);
        const float rs = rsqrtf(var + 64e-5f);
        const f32x4 v4 = ld4((const float*)(lds + cur * 24576 + 20480 + lt * 256 + lc * 4));
        const float cb = cbuf[cur * 16 + lt];
        const f32x4 g4 = unpack4(gq);
        const f32x4 o = (dy * rs * lng + lnb + v4 * cb) * g4;
        *(uint2*)(YG + goff) = pack4(o);
      }
      if (more) stage(cur ^ 1);
      __syncthreads();
    }
    float* so = p->out + (samp ? OFF_WKVS : OFF_WKVP) + ((size_t)(b * 16 + h) * 64 + row0) * 64 + col0;
#pragma unroll
    for (int rr = 0; rr < 2; ++rr) {
      st4(so + rr * 64, f32x4{S2[rr][0].x, S2[rr][0].y, S2[rr][1].x, S2[rr][1].y});
      st4(so + rr * 64 + 4, f32x4{S2[rr][2].x, S2[rr][2].y, S2[rr][3].x, S2[rr][3].y});
    }
  }
  int* qQ = (int*)(p->ws + O_CNT) + 62;
  for (;;) {
    __syncthreads();
    if (tid == 0) *s_it = atomicAdd(qQ, 1);
    __syncthreads();
    const int ch = *s_it;
    if (ch >= 1024) break;
    quant_rows(p, ch * 64);
  }
}

__device__ __forceinline__ void phase_ln(KP p, const float* src, float* d32, bf16* db, const float* gam, const float* bet) {
  const int tid_ = otid();
  const int l = tid_ & 63, w = tid_ >> 6;
  for (int m = blockIdx.x * 4 + w; m < NT; m += gridDim.x * 4) {
    const float* s = src + (size_t)m * 1024;
    f32x4 x[4];
#pragma unroll
    for (int i = 0; i < 4; ++i) x[i] = ld4(s + i * 256 + l * 4);
    float sm = 0.f;
#pragma unroll
    for (int i = 0; i < 4; ++i) sm += x[i][0] + x[i][1] + x[i][2] + x[i][3];
    const float mean = wave_sum(sm) * (1.0f / 1024.0f);
    float sq = 0.f;
#pragma unroll
    for (int i = 0; i < 4; ++i) { x[i] = x[i] - mean; sq += x[i][0] * x[i][0] + x[i][1] * x[i][1] + x[i][2] * x[i][2] + x[i][3] * x[i][3]; }
    const float rs = rsqrtf(wave_sum(sq) * (1.0f / 1024.0f) + 1e-5f);
#pragma unroll
    for (int i = 0; i < 4; ++i) {
      const int e = i * 256 + l * 4;
      const f32x4 y = x[i] * rs * ld4(gam + e) + ld4(bet + e);
      *(uint2*)(db + (size_t)m * 1024 + e) = pack4(y);
    }
  }
}

__device__ __forceinline__ float dotq4(unsigned u, const float* x, float d) {
  d = fmaf((float)(u & 255u), x[0], d); d = fmaf((float)((u >> 8) & 255u), x[1], d);
  d = fmaf((float)((u >> 16) & 255u), x[2], d); d = fmaf((float)(u >> 24), x[3], d);
  return d;
}
__device__ __forceinline__ float dotq(uint4 u, const float* x) {
  return dotq4(u.x, x, 0.f) + dotq4(u.y, x + 4, 0.f) + dotq4(u.z, x + 8, 0.f) + dotq4(u.w, x + 12, 0.f);
}
__device__ __forceinline__ void axq4(unsigned u, float a, float* o) {
  o[0] = fmaf(a, (float)(u & 255u), o[0]); o[1] = fmaf(a, (float)((u >> 8) & 255u), o[1]);
  o[2] = fmaf(a, (float)((u >> 16) & 255u), o[2]); o[3] = fmaf(a, (float)(u >> 24), o[3]);
}
__device__ __forceinline__ void axq(uint4 u, float a, float* o) { axq4(u.x, a, o); axq4(u.y, a, o + 4); axq4(u.z, a, o + 8); axq4(u.w, a, o + 12); }
__device__ __forceinline__ float reduce8(const float* pp, int l) {
  const bool b0 = l & 1, b1 = l & 2, b2 = l & 4;
  float a[4], bb[2];
#pragma unroll
  for (int i = 0; i < 4; ++i) { const float keep = b0 ? pp[2 * i + 1] : pp[2 * i], send = b0 ? pp[2 * i] : pp[2 * i + 1]; a[i] = keep + dppf<0xB1>(send); }
#pragma unroll
  for (int i = 0; i < 2; ++i) { const float keep = b1 ? a[2 * i + 1] : a[2 * i], send = b1 ? a[2 * i] : a[2 * i + 1]; bb[i] = keep + dppf<0x4E>(send); }
  const float keep = b2 ? bb[1] : bb[0], send = b2 ? bb[0] : bb[1];
  float c = keep + dppf<0x124>(send);
  c += dppf<0x128>(c);
  c += __shfl_xor(c, 16); c += __shfl_xor(c, 32);
  return c;
}

__device__ __forceinline__ void phase_peer_experts(KP p, int layer) {
  const int tid_ = otid();
  const int l = tid_ & 63, w = tid_ >> 6;
  const unsigned* TK = (const unsigned*)slot(p, layer ? 5 : 6);
  const bf16* X = (const bf16*)slot(p, layer ? 4 : 5);
  const unsigned char* PU = (const unsigned char*)(p->ws + O_PU) + (size_t)layer * 8388608;
  const unsigned char* PV = (const unsigned char*)(p->ws + O_PV) + (size_t)layer * 8388608;
  const float* SU = (const float*)(p->ws + O_SU) + layer * 16384;
  const float* SV = (const float*)(p->ws + O_SV) + layer * 16384;
  const float* lg = p->in[29] + layer * 1024; const float* lb = p->in[30] + layer * 1024;
  const int hq = l >> 4, r = l & 15;
  unsigned cd[4];
#pragma unroll
  for (int c = 0; c < 4; ++c) cd[c] = CAND[r * 4 + c];
  for (int mv = blockIdx.x * 4 + w; mv < NT * REP_PE; mv += gridDim.x * 4) {
    const int m = REP_PE == 1 ? mv : mv % NT;
    const unsigned* tk = TK + (size_t)m * 256;
    int eidx[2]; float gate[2];
#pragma unroll
    for (int pass = 0; pass < 2; ++pass) {
      const int h = pass * 4 + hq;
      unsigned k[4];
#pragma unroll
      for (int c = 0; c < 4; ++c) {
        const unsigned ab = cd[c] == 255u ? 0u : cd[c];
        const unsigned k1 = tk[h * 32 + (ab >> 4)], k2 = tk[h * 32 + 16 + (ab & 15)];
        const float s = ord2f(k1 & ~127u) + ord2f(k2 & ~127u);
        k[c] = cd[c] == 255u ? 0u : ((f2ord(s) & ~255u) | (255u - cd[c]));
      }
      unsigned mine = 0;
#pragma unroll
      for (int it = 0; it < 16; ++it) {
        unsigned mx = umx(umx(k[0], k[1]), umx(k[2], k[3]));
        mx = row_umax(mx);
        if (r == it) mine = mx;
#pragma unroll
        for (int c = 0; c < 4; ++c) k[c] = (k[c] == mx) ? 0u : k[c];
      }
      const unsigned pos = 255u - (mine & 255u);
      const unsigned k1 = tk[h * 32 + (pos >> 4)], k2 = tk[h * 32 + 16 + (pos & 15)];
      eidx[pass] = (int)((127u - (k1 & 127u)) * 128u + (127u - (k2 & 127u)));
      const float s = ord2f(mine & ~255u);
      const float mxs = row_max(s);
      const float ex = __expf(s - mxs);
      gate[pass] = ex / row_sum(ex);
    }
    const bf16* xr = X + (size_t)m * 1024;
    float xv[16], out[16];
    {
      const uint4 u0 = *(const uint4*)(xr + l * 16), u1 = *(const uint4*)(xr + l * 16 + 8);
      const f32x4 a = unpack4(make_uint2(u0.x, u0.y)), b = unpack4(make_uint2(u0.z, u0.w)), c = unpack4(make_uint2(u1.x, u1.y)), d = unpack4(make_uint2(u1.z, u1.w));
#pragma unroll
      for (int i = 0; i < 4; ++i) { xv[i] = a[i]; xv[4 + i] = b[i]; xv[8 + i] = c[i]; xv[12 + i] = d[i]; }
    }
    float xam = 0.f;
#pragma unroll
    for (int i = 0; i < 16; ++i) { out[i] = 0.f; xam = fmaxf(xam, fabsf(xv[i])); }
    xam = row_max(xam); xam = fmaxf(xam, __shfl_xor(xam, 16)); xam = fmaxf(xam, __shfl_xor(xam, 32));
    const float xinv = xam > 0.f ? 127.0f / xam : 0.f, xs = xam * (1.0f / 127.0f);
    int xq[16]; int sqi = 0;
#pragma unroll
    for (int i = 0; i < 16; ++i) { xq[i] = (int)rintf(xv[i] * xinv); sqi += xq[i]; }
    int xe0 = (xq[0] & 255) | ((xq[2] & 255) << 8) | ((xq[4] & 255) << 16) | (xq[6] << 24);
    int xo0 = (xq[1] & 255) | ((xq[3] & 255) << 8) | ((xq[5] & 255) << 16) | (xq[7] << 24);
    int xe1 = (xq[8] & 255) | ((xq[10] & 255) << 8) | ((xq[12] & 255) << 16) | (xq[14] << 24);
    int xo1 = (xq[9] & 255) | ((xq[11] & 255) << 8) | ((xq[13] & 255) << 16) | (xq[15] << 24);
    const float sx = wave_sum((float)sqi);
    float csum = 0.f;
    uint2 ua[8], ub[8];
    uint2 va[8], vb[8];
#define LD_U(dst, ps, s0) { _Pragma("unroll") for (int k = 0; k < 8; ++k) dst[k] = *(const uint2*)(PU + (size_t)__builtin_amdgcn_readlane(eidx[ps], (s0) + k) * 512 + l * 8); }
#define LD_V(dst, ps, s0) { _Pragma("unroll") for (int k = 0; k < 8; ++k) dst[k] = *(const uint2*)(PV + (size_t)__builtin_amdgcn_readlane(eidx[ps], (s0) + k) * 512 + l * 8); }
#define DO_U(buf, s0, MD) { float pp[8]; \
        _Pragma("unroll") for (int k = 0; k < 8; ++k) { \
          const unsigned w0 = buf[k].x, w1 = buf[k].y; \
          int a_ = __builtin_amdgcn_sdot4((int)(w0 & 0x0F0F0F0Fu), xe0, 0, false); \
          a_ = __builtin_amdgcn_sdot4((int)((w0 >> 4) & 0x0F0F0F0Fu), xo0, a_, false); \
          a_ = __builtin_amdgcn_sdot4((int)(w1 & 0x0F0F0F0Fu), xe1, a_, false); \
          a_ = __builtin_amdgcn_sdot4((int)((w1 >> 4) & 0x0F0F0F0Fu), xo1, a_, false); \
          pp[k] = (float)a_; } \
        const float c_ = reduce8(pp, l); \
        if ((l >> 3) == ((s0) >> 3)) MD = c_; }
#define TR4(d0, d1, d2, d3, A4, o) { \
          const unsigned pl_ = __builtin_amdgcn_perm(d1, d0, 0x05010400u), ph_ = __builtin_amdgcn_perm(d1, d0, 0x07030602u); \
          const unsigned ql_ = __builtin_amdgcn_perm(d3, d2, 0x05010400u), qh_ = __builtin_amdgcn_perm(d3, d2, 0x07030602u); \
          iacc[(o) + 0] = __builtin_amdgcn_sdot4((int)__builtin_amdgcn_perm(ql_, pl_, 0x05040100u), A4, iacc[(o) + 0], false); \
          iacc[(o) + 2] = __builtin_amdgcn_sdot4((int)__builtin_amdgcn_perm(ql_, pl_, 0x07060302u), A4, iacc[(o) + 2], false); \
          iacc[(o) + 4] = __builtin_amdgcn_sdot4((int)__builtin_amdgcn_perm(qh_, ph_, 0x05040100u), A4, iacc[(o) + 4], false); \
          iacc[(o) + 6] = __builtin_amdgcn_sdot4((int)__builtin_amdgcn_perm(qh_, ph_, 0x07060302u), A4, iacc[(o) + 6], false); }
#define NLO(w) ((w) & 0x0F0F0F0Fu)
#define NHI(w) (((w) >> 4) & 0x0F0F0F0Fu)
#define DO_V(buf, s0, CQ) { _Pragma("unroll") for (int hb = 0; hb < 2; ++hb) { \
          const int c0_ = __builtin_amdgcn_readlane(CQ, (s0) + hb * 4), c1_ = __builtin_amdgcn_readlane(CQ, (s0) + hb * 4 + 1); \
          const int c2_ = __builtin_amdgcn_readlane(CQ, (s0) + hb * 4 + 2), c3_ = __builtin_amdgcn_readlane(CQ, (s0) + hb * 4 + 3); \
          const int a4_ = (c0_ & 255) | ((c1_ & 255) << 8) | ((c2_ & 255) << 16) | ((c3_ & 255) << 24); \
          TR4(NLO(buf[hb * 4].x), NLO(buf[hb * 4 + 1].x), NLO(buf[hb * 4 + 2].x), NLO(buf[hb * 4 + 3].x), a4_, 0) \
          TR4(NHI(buf[hb * 4].x), NHI(buf[hb * 4 + 1].x), NHI(buf[hb * 4 + 2].x), NHI(buf[hb * 4 + 3].x), a4_, 1) \
          TR4(NLO(buf[hb * 4].y), NLO(buf[hb * 4 + 1].y), NLO(buf[hb * 4 + 2].y), NLO(buf[hb * 4 + 3].y), a4_, 8) \
          TR4(NHI(buf[hb * 4].y), NHI(buf[hb * 4 + 1].y), NHI(buf[hb * 4 + 2].y), NHI(buf[hb * 4 + 3].y), a4_, 9) } }
#define CQUANT(WG, CQ, CS) float CS; int CQ; { float cm_ = fabsf(WG); cm_ = row_max(cm_); cm_ = fmaxf(cm_, __shfl_xor(cm_, 16)); cm_ = fmaxf(cm_, __shfl_xor(cm_, 32)); \
          CS = cm_ * (1.0f / 127.0f); CQ = (int)rintf(WG * (cm_ > 0.f ? 127.0f / cm_ : 0.f)); }
#define CSUM(CQ) wave_sum((float)CQ)
#define FLUSH(CS, SUMQ) { const float off_ = 7.5f * (SUMQ); _Pragma("unroll") for (int i = 0; i < 16; ++i) { out[i] = fmaf(CS, (float)iacc[i] - off_, out[i]); iacc[i] = 0; } }
    float md0 = 0.f, md1 = 0.f;
    int iacc[16];
#pragma unroll
    for (int i = 0; i < 16; ++i) iacc[i] = 0;
    LD_U(ua, 0, 0)
#pragma unroll 1
    for (int s = 0; s < 64; s += 16) {
      LD_U(ub, 0, s + 8)
      DO_U(ua, s, md0)
      if (s + 16 < 64) LD_U(ua, 0, s + 16) else { LD_V(va, 0, 0) LD_U(ua, 1, 0) }
      DO_U(ub, s + 8, md0)
    }
    const float su0 = SU[eidx[0]], sv0 = SV[eidx[0]];
    const float hh0 = su0 * xs * (md0 - 7.5f * sx);
    const float wgt0 = gate[0] * 0.5f * hh0 * (1.0f + erff(hh0 * 0.70710678118654752f)) * sv0;
    CQUANT(wgt0, cq0, cs0)
    const float sq0 = CSUM(cq0);
#pragma unroll 1
    for (int s = 0; s < 64; s += 16) {
      LD_V(vb, 0, s + 8) LD_U(ub, 1, s + 8)
      DO_V(va, s, cq0) DO_U(ua, s, md1)
      if (s + 16 < 64) { LD_V(va, 0, s + 16) LD_U(ua, 1, s + 16) } else LD_V(va, 1, 0)
      DO_V(vb, s + 8, cq0) DO_U(ub, s + 8, md1)
    }
    const float su1 = SU[eidx[1]], sv1 = SV[eidx[1]];
    const float hh1 = su1 * xs * (md1 - 7.5f * sx);
    FLUSH(cs0, sq0)
    const float wgt1 = gate[1] * 0.5f * hh1 * (1.0f + erff(hh1 * 0.70710678118654752f)) * sv1;
    CQUANT(wgt1, cq1, cs1)
    const float sq1 = CSUM(cq1);
#pragma unroll 1
    for (int s = 0; s < 64; s += 16) {
      LD_V(vb, 1, s + 8)
      DO_V(va, s, cq1)
      if (s + 16 < 64) LD_V(va, 1, s + 16)
      DO_V(vb, s + 8, cq1)
    }
    FLUSH(cs1, sq1)
#undef LD_U
#undef LD_V
#undef DO_U
#undef DO_V
#undef TR4
#undef NLO
#undef NHI
#undef CSUM
#undef CQUANT
#undef FLUSH
    float sm = 0.f;
#pragma unroll
    for (int i = 0; i < 16; ++i) { out[i] = fmaf(xv[i], 1.4142135623730951f, out[i]); sm += out[i]; }
    const float mean = wave_sum(sm) * (1.0f / 1024.0f);
    float sq = 0.f;
#pragma unroll
    for (int i = 0; i < 16; ++i) { out[i] -= mean; sq = fmaf(out[i], out[i], sq); }
    const float rs = rsqrtf(wave_sum(sq) * (1.0f / 1024.0f) + 1e-5f);
    float* d32 = layer ? ((m < NTP) ? p->out + OFF_YP + (size_t)m * 1024 : p->out + OFF_YS + (size_t)(m - NTP) * 1024)
                       : (float*)slot(p, 0) + (size_t)m * 1024;
#pragma unroll
    for (int hf = 0; hf < 2; ++hf) {
      const int e = l * 16 + hf * 8;
      const f32x4 g0 = ld4(lg + e), g1 = ld4(lg + e + 4), b0 = ld4(lb + e), b1 = ld4(lb + e + 4);
      f32x4 y0, y1;
#pragma unroll
      for (int i = 0; i < 4; ++i) { y0[i] = out[hf * 8 + i] * rs * g0[i] + b0[i]; y1[i] = out[hf * 8 + 4 + i] * rs * g1[i] + b1[i]; }
      if (layer) { st4(d32 + e, y0); st4(d32 + e + 4, y1); }
      else {
        const uint2 pa = pack4(y0), pb = pack4(y1);
        *(uint4*)((bf16*)slot(p, 4) + (size_t)m * 1024 + e) = make_uint4(pa.x, pa.y, pb.x, pb.y);
      }
    }
  }
}

__device__ __forceinline__ void phase_attn(KP p, char* lds) {
  const int tid = threadIdx.x, l = tid & 63, w = tid >> 6, c = w & 1, qh = w >> 1, g = l >> 4, li = l & 15;
  int* s_item = (int*)(lds + 65520);
  int* counter = (int*)(p->ws + O_CNT);
  const float* lp = p->in[24];
  const float s1 = wave_sum(lp[l] * lp[64 + l]), s2 = wave_sum(lp[128 + l] * lp[192 + l]);
  const float lam = __expf(s1) - __expf(s2) + 0.35550906759f;
  const bf16* Kb = (const bf16*)slot(p, 5); const bf16* VT = (const bf16*)slot(p, 6);
  const bf16* Qb = (const bf16*)slot(p, 7); bf16* Ob = (bf16*)slot(p, 8);
  const float* ck = p->in[4]; const float* cv = p->in[5];
  const float* sg = p->in[25];
  const int myq = (int)(xb_xcc_id() & 7u);
  int qoff = 0;
  for (;;) {
    __syncthreads();
    if (tid == 0) {
      int got = -1;
      while (qoff < 8) {
        const int qx = (myq + qoff) & 7;
        const int j = atomicAdd(counter + qx * 8, 1);
        if (j < 640 * REP_ATTN) { got = qx * 1024 + (j % 640); break; }
        ++qoff;
      }
      *s_item = got;
    }
    __syncthreads();
    const int item = *s_item;
    if (item < 0) break;
    bool samp; int b, h, qc, sp;
    {
      const int qx = item >> 10, j = item & 1023;
      h = qx;
      if (j < 128) { samp = true; b = j >> 3; sp = j & 7; qc = 0; }
      else { const int j2 = j - 128; samp = false; sp = 0; b = j2 >> 5; qc = 31 - (j2 & 31); }
    }
    const int nkt = samp ? (sp == 7 ? 17 : 16) : qc + 1;
    const int qtok0 = samp ? NTP + b * 16 : b * 2048 + qc * 64;
    const int nq = samp ? 16 : 64;
    s16x8 qf[2][2];
#pragma unroll
    for (int f = 0; f < 2; ++f)
#pragma unroll
      for (int ks = 0; ks < 2; ++ks) {
        const int qi = min(qh * 32 + f * 16 + li, nq - 1);
        qf[f][ks] = *(const s16x8*)(Qb + (size_t)(qtok0 + qi) * 1024 + h * 128 + c * 64 + ks * 32 + g * 8);
      }
    f32x4 ot[8][2];
#pragma unroll
    for (int ef = 0; ef < 8; ++ef) { ot[ef][0] = f32x4{0.f, 0.f, 0.f, 0.f}; ot[ef][1] = f32x4{0.f, 0.f, 0.f, 0.f}; }
    float mrun[2] = {-INFINITY, -INFINITY}, lsum[2] = {0.f, 0.f};
    uint4 raw[8];
    auto load_tile = [&](int kt, int tid) {
      if (samp && kt < 16) {
#pragma unroll
        for (int i = 0; i < 2; ++i) {
          const int q = tid + i * 256, cc = q >> 8, key = (q >> 3) & 31, dch = q & 7;
          const float* src = ck + ((size_t)(b * 4096 + (sp * 16 + kt) * 32 + key)) * 1024 + h * 128 + cc * 64 + dch * 8;
          raw[2 * i] = *(const uint4*)src; raw[2 * i + 1] = *(const uint4*)(src + 4);
        }
        const int key = tid & 31, eq = tid >> 5;
        const float* src = cv + ((size_t)(b * 4096 + (sp * 16 + kt) * 32 + key)) * 1024 + h * 128 + eq * 16;
#pragma unroll
        for (int i = 0; i < 4; ++i) raw[4 + i] = *(const uint4*)(src + i * 4);
      } else if (!samp) {
        const bf16* kb_ = Kb + (size_t)(b * 2048 + kt * 64) * 1024 + h * 128;
        const bf16* vb_ = VT + (size_t)((b * 8 + h) * 128) * 2048 + kt * 64;
        const unsigned ko_ = (unsigned)(tid >> 3) * 1024u + (unsigned)(tid & 7) * 8u;
        const unsigned vo_ = (unsigned)(tid >> 3) * 2048u + (unsigned)(tid & 7) * 8u;
        raw[0] = *(const uint4*)(kb_ + ko_);
        raw[1] = *(const uint4*)(kb_ + (ko_ + 32768u));
        raw[2] = *(const uint4*)(kb_ + (ko_ + 64u));
        raw[3] = *(const uint4*)(kb_ + (ko_ + 32768u + 64u));
        raw[4] = *(const uint4*)(vb_ + vo_);
        raw[5] = *(const uint4*)(vb_ + (vo_ + 65536u));
        raw[6] = *(const uint4*)(vb_ + (vo_ + 131072u));
        raw[7] = *(const uint4*)(vb_ + (vo_ + 196608u));
      } else {
        const int ktok0 = NTP + b * 16;
        const size_t vbase = (size_t)33554432 + (size_t)((b * 8 + h) * 128) * 16;
#pragma unroll
        for (int i = 0; i < 4; ++i) {
          const int q = tid + i * 256, cc = q >> 9, key = (q >> 3) & 63, dch = q & 7;
          const uint4 kvv = *(const uint4*)(Kb + (size_t)(ktok0 + (key & 15)) * 1024 + h * 128 + cc * 64 + dch * 8);
          const int e = q >> 3, kch = q & 7;
          const uint4 vvv = *(const uint4*)(VT + vbase + (size_t)e * 16 + (kch & 1) * 8);
          const bool kok = key < 16, vok = kch < 2;
          raw[i] = make_uint4(kok ? kvv.x : 0u, kok ? kvv.y : 0u, kok ? kvv.z : 0u, kok ? kvv.w : 0u);
          raw[4 + i] = make_uint4(vok ? vvv.x : 0u, vok ? vvv.y : 0u, vok ? vvv.z : 0u, vok ? vvv.w : 0u);
        }
      }
    };
    auto store_tile = [&](int kt, int tid) {
      if (samp && kt < 16) {
#pragma unroll
        for (int i = 0; i < 2; ++i) {
          const int q = tid + i * 256, cc = q >> 8, key = (q >> 3) & 31, dch = q & 7;
          const uint4 a = raw[2 * i], bq = raw[2 * i + 1];
          uint4 o;
          o.x = pack2(__uint_as_float(a.x), __uint_as_float(a.y)); o.y = pack2(__uint_as_float(a.z), __uint_as_float(a.w));
          o.z = pack2(__uint_as_float(bq.x), __uint_as_float(bq.y)); o.w = pack2(__uint_as_float(bq.z), __uint_as_float(bq.w));
          *(uint4*)(lds + cc * 8192 + (dch >> 2) * 4096 + swz(key, dch & 3)) = o;
        }
        const int key = tid & 31, eq = tid >> 5;
#pragma unroll
        for (int i = 0; i < 4; ++i) {
          const int e = eq * 16 + i * 4;
          *(bf16*)(lds + 16384 + (e + 0) * 144 + key * 2) = f2b(__uint_as_float(raw[4 + i].x));
          *(bf16*)(lds + 16384 + (e + 1) * 144 + key * 2) = f2b(__uint_as_float(raw[4 + i].y));
          *(bf16*)(lds + 16384 + (e + 2) * 144 + key * 2) = f2b(__uint_as_float(raw[4 + i].z));
          *(bf16*)(lds + 16384 + (e + 3) * 144 + key * 2) = f2b(__uint_as_float(raw[4 + i].w));
        }
      } else {
#pragma unroll
        for (int i = 0; i < 4; ++i) {
          const int dch = tid & 7;
          *(uint4*)(lds + ((dch >> 2) * 4096 + swz(tid >> 3, dch & 3)) + (i & 1) * 2048 + (i >> 1) * 8192) = raw[i];
          *(uint4*)(lds + 16384 + ((tid >> 3) * 144 + dch * 16) + i * 4608) = raw[4 + i];
        }
      }
    };
    load_tile(0, tid);
    for (int kt = 0; kt < nkt; ++kt) {
      int tz = tid;
      asm volatile("" : "+v"(tz));
      const int li = tz & 15, g = (tz & 63) >> 4;
      __syncthreads();
      store_tile(kt, tz);
      __syncthreads();
      if (kt + 1 < nkt) load_tile(kt + 1, tz);
      const int kvalid = samp ? (kt == 16 ? 16 : 32) : 64;
      const bool full = !samp;
      f32x4 st[4][2];
#pragma unroll
      for (int kf = 0; kf < 4; ++kf) { st[kf][0] = f32x4{0.f, 0.f, 0.f, 0.f}; st[kf][1] = f32x4{0.f, 0.f, 0.f, 0.f}; }
      {
        s16x8 kfr[2][4];
#pragma unroll
        for (int ks = 0; ks < 2; ++ks)
#pragma unroll
          for (int kf = 0; kf < 4; ++kf)
            if (kf < 2 || full) kfr[ks][kf] = *(const s16x8*)(lds + c * 8192 + ks * 4096 + swz(kf * 16 + li, g));
#pragma unroll
        for (int ks = 0; ks < 2; ++ks)
#pragma unroll
          for (int kf = 0; kf < 4; ++kf)
            if (kf < 2 || full) {
              st[kf][0] = __builtin_amdgcn_mfma_f32_16x16x32_bf16(kfr[ks][kf], qf[0][ks], st[kf][0], 0, 0, 0);
              st[kf][1] = __builtin_amdgcn_mfma_f32_16x16x32_bf16(kfr[ks][kf], qf[1][ks], st[kf][1], 0, 0, 0);
            }
        __builtin_amdgcn_sched_barrier(0);
      }
      if (kvalid < 64) {
#pragma unroll
        for (int kf = 0; kf < 4; ++kf)
#pragma unroll
          for (int r = 0; r < 4; ++r)
            if (kf * 16 + g * 4 + r >= kvalid) { st[kf][0][r] = -INFINITY; st[kf][1][r] = -INFINITY; }
      }
#pragma unroll
      for (int f = 0; f < 2; ++f) {
        float ml = st[0][f][0];
#pragma unroll
        for (int kf = 0; kf < 4; ++kf)
#pragma unroll
          for (int r = 0; r < 4; ++r) ml = fmaxf(ml, st[kf][f][r]);
        ml = fmaxf(ml, __shfl_xor(ml, 16)); ml = fmaxf(ml, __shfl_xor(ml, 32));
        const bool grow = ml > mrun[f] + 8.0f;
        const float mn = grow ? ml : mrun[f];
        float ps = 0.f;
#pragma unroll
        for (int kf = 0; kf < 4; ++kf)
#pragma unroll
          for (int r = 0; r < 4; ++r) { const float pv = __builtin_amdgcn_exp2f(st[kf][f][r] - mn); st[kf][f][r] = pv; ps += pv; }
        if (__builtin_amdgcn_ballot_w64(grow) != 0ull) {
          const float scl = __builtin_amdgcn_exp2f(mrun[f] - mn);
          lsum[f] *= scl;
#pragma unroll
          for (int ef = 0; ef < 8; ++ef) ot[ef][f] = ot[ef][f] * scl;
        }
        mrun[f] = mn;
        lsum[f] += ps;
      }
      s16x8 pf[2][2];
#pragma unroll
      for (int step = 0; step < 2; ++step)
#pragma unroll
        for (int f = 0; f < 2; ++f) {
          const uint2 a = pack4(st[2 * step][f]), bq = pack4(st[2 * step + 1][f]);
          pf[step][f] = __builtin_bit_cast(s16x8, make_uint4(a.x, a.y, bq.x, bq.y));
        }
      __builtin_amdgcn_sched_barrier(0);
#pragma unroll
      for (int step = 0; step < 2; ++step) {
        if (step == 1 && !full) break;
        s16x8 vf[8];
#pragma unroll
        for (int ef = 0; ef < 8; ++ef) {
          const char* vp = lds + 16384 + (ef * 16 + li) * 144 + (step * 32 + g * 4) * 2;
          const uint2 a = *(const uint2*)vp, bq = *(const uint2*)(vp + 32);
          vf[ef] = __builtin_bit_cast(s16x8, make_uint4(a.x, a.y, bq.x, bq.y));
        }
#pragma unroll
        for (int ef = 0; ef < 8; ++ef) {
          ot[ef][0] = __builtin_amdgcn_mfma_f32_16x16x32_bf16(vf[ef], pf[step][0], ot[ef][0], 0, 0, 0);
          ot[ef][1] = __builtin_amdgcn_mfma_f32_16x16x32_bf16(vf[ef], pf[step][1], ot[ef][1], 0, 0, 0);
        }
        __builtin_amdgcn_sched_barrier(0);
      }
    }
    float inv[2];
#pragma unroll
    for (int f = 0; f < 2; ++f) { float lt = lsum[f]; lt += __shfl_xor(lt, 16); lt += __shfl_xor(lt, 32); inv[f] = 1.0f / lt; }
    if (samp) {
      if (qh == 0) {
        float* pr = (float*)slot(p, 9) + ((size_t)((((b * 8 + h) * 8 + sp) * 2 + c) * 16 + li)) * 132;
#pragma unroll
        for (int ef = 0; ef < 8; ++ef) st4(pr + ef * 16 + g * 4, ot[ef][0]);
        if (g == 0) { pr[128] = mrun[0]; pr[129] = 1.0f / inv[0]; }
      }
      continue;
    }
    __syncthreads();
    float* comb = (float*)lds;
    if (c == 1) {
#pragma unroll
      for (int ef = 0; ef < 8; ++ef)
#pragma unroll
        for (int f = 0; f < 2; ++f)
#pragma unroll
          for (int r = 0; r < 4; ++r) comb[(((qh * 8 + ef) * 2 + f) * 4 + r) * 64 + l] = ot[ef][f][r] * inv[f] * lam;
    }
    __syncthreads();
    if (c == 0) {
#pragma unroll
      for (int f = 0; f < 2; ++f) {
        float ss = 0.f;
#pragma unroll
        for (int ef = 0; ef < 8; ++ef)
#pragma unroll
          for (int r = 0; r < 4; ++r) { const float o = ot[ef][f][r] * inv[f] - comb[(((qh * 8 + ef) * 2 + f) * 4 + r) * 64 + l]; ot[ef][f][r] = o; ss = fmaf(o, o, ss); }
        ss += __shfl_xor(ss, 16); ss += __shfl_xor(ss, 32);
        const float rs = rsqrtf(ss * (1.0f / 128.0f) + 1e-5f) * 0.6444909324090307f;
        const int qi = qh * 32 + f * 16 + li;
        if (qi < nq) {
#pragma unroll
          for (int ef = 0; ef < 8; ++ef) {
            const int e = ef * 16 + g * 4;
            const f32x4 g4 = ld4(sg + e);
            *(uint2*)(Ob + (size_t)(qtok0 + qi) * 1024 + h * 128 + e) = pack4(ot[ef][f] * rs * g4);
          }
        }
      }
    }
  }
}

__device__ __forceinline__ void phase_attn_combine(KP p) {
  const int l = threadIdx.x & 63, w = threadIdx.x >> 6;
  const float* lp = p->in[24];
  const float s1 = wave_sum(lp[l] * lp[64 + l]), s2 = wave_sum(lp[128 + l] * lp[192 + l]);
  const float lam = __expf(s1) - __expf(s2) + 0.35550906759f;
  const float* sg = p->in[25];
  bf16* Ob = (bf16*)slot(p, 8);
  for (int row = blockIdx.x * 4 + w; row < 2048; row += gridDim.x * 4) {
    const int q = row & 15, bh = row >> 4;
    float o2[2][2];
#pragma unroll
    for (int c = 0; c < 2; ++c) {
      float m[8], M = -INFINITY;
#pragma unroll
      for (int sp = 0; sp < 8; ++sp) { m[sp] = ((const float*)slot(p, 9))[((size_t)(((bh * 8 + sp) * 2 + c) * 16 + q)) * 132 + 128]; M = fmaxf(M, m[sp]); }
      float L = 0.f, a0 = 0.f, a1 = 0.f;
#pragma unroll
      for (int sp = 0; sp < 8; ++sp) {
        const float* pr = (const float*)slot(p, 9) + ((size_t)(((bh * 8 + sp) * 2 + c) * 16 + q)) * 132;
        const float wg = __builtin_amdgcn_exp2f(m[sp] - M);
        L = fmaf(wg, pr[129], L);
        const float2 ov = *(const float2*)(pr + l * 2);
        a0 = fmaf(wg, ov.x, a0); a1 = fmaf(wg, ov.y, a1);
      }
      o2[c][0] = a0 / L; o2[c][1] = a1 / L;
    }
    const float x0 = o2[0][0] - lam * o2[1][0], x1 = o2[0][1] - lam * o2[1][1];
    const float ss = wave_sum(x0 * x0 + x1 * x1);
    const float rs = rsqrtf(ss * (1.0f / 128.0f) + 1e-5f) * 0.6444909324090307f;
    const int b = bh >> 3, h = bh & 7;
    *(unsigned*)(Ob + (size_t)(NTP + b * 16 + q) * 1024 + h * 128 + l * 2) = pack2(x0 * rs * sg[l * 2], x1 * rs * sg[l * 2 + 1]);
  }
}

__global__ void __launch_bounds__(256, 2) yoco_mega(Params p) {
  __shared__ __attribute__((aligned(16))) char lds[65536];
  cg::grid_group grid = cg::this_grid();
  KP kp = (KP)__builtin_amdgcn_kernarg_segment_ptr();
#define FRESH() ({ KP q_ = kp; asm volatile("" : "+s"(q_)); q_; })
  phase0(FRESH());
  grid.sync();
  XcdBar xb; xb.bar = (unsigned*)(FRESH()->ws + O_BAR); xb.x = xb_xcc_id(); xb.nloc = 1u; xb.nx = 1u;
  if (threadIdx.x == 0) (void)xb_add(&xb.bar[XB_XCNT(xb.x)], 1u);
  if (threadIdx.x < 64) {
    unsigned nl = 1u, nxx = 1u;
    xcd_census(xb.bar, xb.x, nl, nxx);
    xb.nloc = (unsigned)__builtin_amdgcn_readfirstlane((int)nl); xb.nx = (unsigned)__builtin_amdgcn_readfirstlane((int)nxx);
  }
  phase_gemm<1>(FRESH(), lds); xcd_barrier(xb);
  phase_gemm<2>(FRESH(), lds); xcd_barrier(xb);
  phase_scan(FRESH(), lds); xcd_barrier(xb);
  phase_gemm<4>(FRESH(), lds); xcd_barrier(xb);
  { KP p = FRESH(); phase_ln(p, (const float*)slot(p, 0), (float*)slot(p, 2), (bf16*)slot(p, 5), p->in[27], p->in[28]); } xcd_barrier(xb);
  phase_gemm<6>(FRESH(), lds); xcd_barrier(xb);
  phase_peer_experts(FRESH(), 0); xcd_barrier(xb);
  phase_gemm<8>(FRESH(), lds); xcd_barrier(xb);
  phase_attn(FRESH(), lds); xcd_barrier(xb);
  phase_attn_combine(FRESH()); xcd_barrier(xb);
  phase_gemm<10>(FRESH(), lds); xcd_barrier(xb);
  { KP p = FRESH(); phase_ln(p, (const float*)slot(p, 2), (float*)slot(p, 0), (bf16*)slot(p, 4), p->in[27] + 1024, p->in[28] + 1024); } xcd_barrier(xb);
  phase_gemm<12>(FRESH(), lds); xcd_barrier(xb);
  phase_peer_experts(FRESH(), 1);
}

extern "C" void kernel_launch(void* const* d_in, const int* in_sizes, int n_in, void* d_out, int out_size,
                              void* d_ws, size_t ws_size, hipStream_t stream) {
  static int grid_blocks = 0;
  if (!grid_blocks) {
    int dev = 0, cus = 0, per_cu = 0;
    hipGetDevice(&dev);
    hipDeviceGetAttribute(&cus, hipDeviceAttributeMultiprocessorCount, dev);
    hipOccupancyMaxActiveBlocksPerMultiprocessor(&per_cu, (const void*)yoco_mega, 256, 0);
    if (per_cu > 2) per_cu = 2;
    if (per_cu < 1) per_cu = 1;
    grid_blocks = cus * per_cu;
  }
  if (ws_size < WS_NEED) { fprintf(stderr, "workspace too small: %zu < %zu\n", ws_size, (size_t)WS_NEED); return; }
  Params p{};
  for (int i = 0; i < 35; ++i) p.in[i] = (const float*)d_in[i];
  p.out = (float*)d_out;
  p.ws = (char*)d_ws;
  void* args[] = {&p};
  hipError_t e = hipLaunchCooperativeKernel((const void*)yoco_mega, dim3(grid_blocks), dim3(256), args, 0, stream);
  if (e != hipSuccess) fprintf(stderr, "cooperative launch failed: %s (grid %d)\n", hipGetErrorString(e), grid_blocks);
}
```

```cpp
#include <hip/hip_runtime.h>
#include <hip/hip_cooperative_groups.h>
#include <stdio.h>
namespace cg = cooperative_groups;

typedef unsigned short bf16;
typedef __attribute__((ext_vector_type(8))) short s16x8;
typedef __attribute__((ext_vector_type(4))) float f32x4;

constexpr int NTP = 32768, NT = 33024;
constexpr int REP_GEMM = 1, REP_PE = 1, REP_SCAN = 1, REP_ATTN = 1, REP_P0 = 1;
constexpr size_t U = (size_t)NT * 1024 * 2;

constexpr size_t O_WRKV = 0;
constexpr size_t O_WL1  = O_WRKV + 3 * 2097152;
constexpr size_t O_W2T  = O_WL1 + 524288;
constexpr size_t O_A2T  = O_W2T + 131072;
constexpr size_t O_G2T  = O_A2T + 131072;
constexpr size_t O_WOUT = O_G2T + 262144;
constexpr size_t O_WKV  = O_WOUT + 2097152;
constexpr size_t O_WQ   = O_WKV + 4194304;
constexpr size_t O_WO   = O_WQ + 2097152;
constexpr size_t O_WPQ  = O_WO + 2097152;
constexpr size_t O_SK   = O_WPQ + 2 * 4194304;
constexpr size_t O_PU   = O_SK + 131072;
constexpr size_t O_PV   = O_PU + 16777216;
constexpr size_t O_SU   = O_PV + 16777216;
constexpr size_t O_SV   = O_SU + 131072;
constexpr size_t O_CNT  = O_SV + 131072;
constexpr size_t O_BAR  = O_CNT + 256;
constexpr size_t O_CUT  = O_BAR + 16384;
constexpr size_t O_SLOT = O_CUT + 16384;
constexpr size_t WS_NEED = O_SLOT + 10 * U;

constexpr size_t OFF_YP = 0, OFF_YS = 33554432, OFF_WKVP = 33816576, OFF_SHP = 34865152,
                 OFF_CKP = 34881536, OFF_CVP = 68435968, OFF_WKVS = 101990400, OFF_SHS = 103038976,
                 OFF_CKS = 103055360, OFF_CVS = 103317504;

struct Params {
  const float* in[35];
  float* out;
  char* ws;
};
typedef const Params __attribute__((address_space(4)))* KP;

__device__ const unsigned char CAND[64] = {0, 1, 2, 3, 4, 5, 6, 7, 8, 9, 10, 11, 12, 13, 14, 15, 16, 17, 18, 19, 20, 21, 22, 23, 32, 33, 34, 35, 36, 48, 49, 50, 51, 64, 65, 66, 80, 81, 96, 97, 112, 113, 128, 144, 160, 176, 192, 208, 224, 240, 255, 255, 255, 255, 255, 255, 255, 255, 255, 255, 255, 255, 255, 255};

__device__ __forceinline__ char* slot(KP p, int i) { return p->ws + O_SLOT + (size_t)i * U; }
__device__ __forceinline__ bf16 f2b(float f) { unsigned u = __float_as_uint(f); u += 0x7fffu + ((u >> 16) & 1u); return (bf16)(u >> 16); }
typedef float f32x2 __attribute__((ext_vector_type(2)));
typedef __bf16 bf16x2_t __attribute__((ext_vector_type(2)));
__device__ __forceinline__ unsigned pack2(float a, float b) {
  const f32x2 v = {a, b};
  return __builtin_bit_cast(unsigned, __builtin_convertvector(v, bf16x2_t));
}
__device__ __forceinline__ float blo(unsigned u) { return __uint_as_float(u << 16); }
__device__ __forceinline__ float bhi(unsigned u) { return __uint_as_float(u & 0xffff0000u); }
__device__ __forceinline__ uint2 pack4(f32x4 v) { return make_uint2(pack2(v[0], v[1]), pack2(v[2], v[3])); }
__device__ __forceinline__ f32x4 unpack4(uint2 u) { f32x4 r; r[0] = blo(u.x); r[1] = bhi(u.x); r[2] = blo(u.y); r[3] = bhi(u.y); return r; }
__device__ __forceinline__ f32x4 ld4(const float* p) { float4 t = *(const float4*)p; f32x4 r; r[0] = t.x; r[1] = t.y; r[2] = t.z; r[3] = t.w; return r; }
__device__ __forceinline__ void st4(float* p, f32x4 v) { *(float4*)p = make_float4(v[0], v[1], v[2], v[3]); }

template <int CTRL> __device__ __forceinline__ float dppf(float v) {
  return __builtin_bit_cast(float, __builtin_amdgcn_mov_dpp(__builtin_bit_cast(int, v), CTRL, 0xf, 0xf, true));
}
template <int CTRL> __device__ __forceinline__ unsigned dppu(unsigned v) {
  return (unsigned)__builtin_amdgcn_mov_dpp((int)v, CTRL, 0xf, 0xf, true);
}
__device__ __forceinline__ float oct_sum(float v) { v += dppf<0xB1>(v); v += dppf<0x4E>(v); v += dppf<0x141>(v); return v; }
__device__ __forceinline__ float row_sum(float v) { v = oct_sum(v); v += dppf<0x140>(v); return v; }
__device__ __forceinline__ float row_max(float v) {
  v = fmaxf(v, dppf<0xB1>(v)); v = fmaxf(v, dppf<0x4E>(v)); v = fmaxf(v, dppf<0x141>(v)); v = fmaxf(v, dppf<0x140>(v)); return v;
}
__device__ __forceinline__ unsigned umx(unsigned a, unsigned b) { return a > b ? a : b; }
__device__ __forceinline__ unsigned row_umax(unsigned v) {
  v = umx(v, dppu<0xB1>(v)); v = umx(v, dppu<0x4E>(v)); v = umx(v, dppu<0x141>(v)); v = umx(v, dppu<0x140>(v)); return v;
}
__device__ __forceinline__ float wave_sum(float v) { v = row_sum(v); v += __shfl_xor(v, 16); v += __shfl_xor(v, 32); return v; }
__device__ __forceinline__ unsigned f2ord(float f) { unsigned u = __float_as_uint(f); return (u & 0x80000000u) ? ~u : (u | 0x80000000u); }
__device__ __forceinline__ float ord2f(unsigned o) { unsigned u = (o & 0x80000000u) ? (o & 0x7fffffffu) : ~o; return __uint_as_float(u); }
__device__ __forceinline__ const float* xin(KP p, int m) {
  return m < NTP ? p->in[0] + (size_t)m * 1024 : p->in[1] + (size_t)(m - NTP) * 1024;
}

__device__ __forceinline__ int swz(int row, int slot) { const int q = (row >> 2) & 3; return row * 64 + ((slot ^ (q ^ ((q & 1) << 1))) << 4); }

__device__ __forceinline__ int otid() { int t = threadIdx.x; asm volatile("" : "+v"(t)); return t; }

#define XB_TMO      128
#define XB_XCNT(j)  (256  + 64 * (j))
#define XB_XSUB(j)  (1280 + 64 * (j))
#define XB_XGEN(j)  (2304 + 64 * (j))
#define XB_TOP      3328
#define XB_TOPGEN   3392
#define XCD_BAR_WORDS 3456
#define XB_SPIN_CAP (1u << 20)
__device__ __forceinline__ unsigned xb_ld(unsigned* p) { return __hip_atomic_load(p, __ATOMIC_RELAXED, __HIP_MEMORY_SCOPE_AGENT); }
__device__ __forceinline__ unsigned xb_add(unsigned* p, unsigned v) { return __hip_atomic_fetch_add(p, v, __ATOMIC_RELAXED, __HIP_MEMORY_SCOPE_AGENT); }
__device__ __forceinline__ unsigned xb_xcc_id() { return (unsigned)__builtin_amdgcn_s_getreg((3 << 11) | 20) & 0xFu; }
#define XB_SPIN(cond, bar) do { unsigned _sp = 0; while (cond) { __builtin_amdgcn_s_sleep(1); \
    if ((++_sp & 255u) == 0u) { if (xb_ld(&(bar)[XB_TMO])) break; if (_sp > XB_SPIN_CAP) { atomicAdd(&(bar)[XB_TMO], 1u); break; } } } } while (0)
struct XcdBar { unsigned* bar; unsigned x, nloc, nx; };
__device__ __forceinline__ void xcd_census(unsigned* bar, unsigned x, unsigned& nloc, unsigned& nx) {
  const unsigned G = gridDim.x;
  unsigned sum, cnt, mine, sp = 0u;
  for (;;) {
    sum = 0u; cnt = 0u; mine = 0u;
#pragma unroll
    for (unsigned j = 0; j < 16; ++j) { const unsigned c = xb_ld(&bar[XB_XCNT(j)]); sum += c; cnt += (c > 0u) ? 1u : 0u; mine = (j == x) ? c : mine; }
    if (sum == G) break;
    __builtin_amdgcn_s_sleep(1);
    if ((++sp & 255u) == 0u) { if (xb_ld(&bar[XB_TMO])) break; if (sp > XB_SPIN_CAP) { atomicAdd(&bar[XB_TMO], 1u); break; } }
  }
  nloc = mine > 0u ? mine : 1u; nx = cnt > 0u ? cnt : 1u;
}
__device__ __forceinline__ void xcd_barrier(XcdBar& b) {
  asm volatile("s_waitcnt vmcnt(0)" ::: "memory");
  __syncthreads();
  if (threadIdx.x == 0) {
    unsigned* bar = b.bar;
    __builtin_amdgcn_s_waitcnt(0);
    const unsigned nloc = b.nloc, nx = b.nx;
    const unsigned old = xb_add(&bar[XB_XSUB(b.x)], 1u);
    const unsigned gen = old / nloc;
    if (old + 1u == (gen + 1u) * nloc) {
      __builtin_amdgcn_fence(__ATOMIC_RELEASE, "agent");
      asm volatile("s_waitcnt vmcnt(0)" ::: "memory");
      const unsigned og = xb_add(&bar[XB_TOP], 1u);
      const unsigned tg = og / nx;
      if (og + 1u == (tg + 1u) * nx) xb_add(&bar[XB_TOPGEN], 1u);
      else XB_SPIN(xb_ld(&bar[XB_TOPGEN]) == tg, bar);
      __builtin_amdgcn_fence(__ATOMIC_ACQUIRE, "agent");
      xb_add(&bar[XB_XGEN(b.x)], 1u);
      asm volatile("s_waitcnt vmcnt(0)" ::: "memory");
    } else {
      XB_SPIN(xb_ld(&bar[XB_XGEN(b.x)]) == gen, bar);
      __builtin_amdgcn_fence(__ATOMIC_ACQUIRE, "agent");
      asm volatile("s_waitcnt vmcnt(0)" ::: "memory");
    }
  }
  __syncthreads();
}

__device__ __forceinline__ void transpose_cvt(const float* __restrict__ W, bf16* __restrict__ WT, int K, int N, int gtid, int gsz) {
  const int items = (K >> 3) * N;
  for (int it = gtid; it < items; it += gsz) {
    const int n = it % N, kb = it / N;
    const float* src = W + (size_t)(kb * 8) * N + n;
    uint4 o;
    o.x = pack2(src[0], src[(size_t)N]);
    o.y = pack2(src[(size_t)2 * N], src[(size_t)3 * N]);
    o.z = pack2(src[(size_t)4 * N], src[(size_t)5 * N]);
    o.w = pack2(src[(size_t)6 * N], src[(size_t)7 * N]);
    *(uint4*)(WT + (size_t)n * K + kb * 8) = o;
  }
}
__device__ __forceinline__ void plain_cvt(const float* __restrict__ S, bf16* __restrict__ D, size_t n8, int gtid, int gsz) {
  for (size_t it = gtid; it < n8; it += gsz) {
    const float4 a = *(const float4*)(S + it * 8), b = *(const float4*)(S + it * 8 + 4);
    uint4 o; o.x = pack2(a.x, a.y); o.y = pack2(a.z, a.w); o.z = pack2(b.x, b.y); o.w = pack2(b.z, b.w);
    *(uint4*)(D + it * 8) = o;
  }
}
__device__ __forceinline__ void quant_rows(KP p, int r0) {
  char* ws = p->ws;
  {
    const int l = threadIdx.x & 63;
    for (int r = r0 + (threadIdx.x >> 6); r < r0 + 64; r += 4) {
      const int tbl = r >> 15, rr = r & 32767;
      const float* src = (tbl ? p->in[34] : p->in[33]) + (size_t)rr * 1024 + l * 16;
      f32x4 x[4];
#pragma unroll
      for (int i = 0; i < 4; ++i) x[i] = ld4(src + i * 4);
      float am = 0.f;
#pragma unroll
      for (int i = 0; i < 4; ++i)
#pragma unroll
        for (int j = 0; j < 4; ++j) am = fmaxf(am, fabsf(x[i][j]));
      am = row_max(am); am = fmaxf(am, __shfl_xor(am, 16)); am = fmaxf(am, __shfl_xor(am, 32));
      if (tbl) {
        float ssq = 0.f;
#pragma unroll
        for (int i = 0; i < 4; ++i)
#pragma unroll
          for (int j = 0; j < 4; ++j) ssq = fmaf(x[i][j], x[i][j], ssq);
        const float clipv = fminf(am, 2.75f * sqrtf(wave_sum(ssq) * (1.0f / 1024.0f)));
        const float inv = clipv > 0.f ? 7.5f / clipv : 0.f;
        unsigned o[2] = {0u, 0u};
#pragma unroll
        for (int i = 0; i < 4; ++i)
#pragma unroll
          for (int j = 0; j < 4; ++j) {
            int q = (int)floorf(x[i][j] * inv + 8.0f); q = q < 0 ? 0 : (q > 15 ? 15 : q);
            const int e = i * 4 + j;
            o[e >> 3] |= (unsigned)q << (4 * (e & 7));
          }
        *(uint2*)((unsigned char*)(ws + O_PV) + (size_t)rr * 512 + l * 8) = make_uint2(o[0], o[1]);
        if (l == 0) ((float*)(ws + O_SV))[rr] = clipv > 0.f ? clipv / 7.5f : 1.0f;
      } else {
        float ssq = 0.f;
#pragma unroll
        for (int i = 0; i < 4; ++i)
#pragma unroll
          for (int j = 0; j < 4; ++j) ssq = fmaf(x[i][j], x[i][j], ssq);
        const float clipv = fminf(am, 2.75f * sqrtf(wave_sum(ssq) * (1.0f / 1024.0f)));
        const float inv = clipv > 0.f ? 7.5f / clipv : 0.f;
        unsigned o[2] = {0u, 0u};
#pragma unroll
        for (int i = 0; i < 4; ++i)
#pragma unroll
          for (int j = 0; j < 4; ++j) {
            int q = (int)floorf(x[i][j] * inv + 8.0f); q = q < 0 ? 0 : (q > 15 ? 15 : q);
            const int e = i * 4 + j;
            o[e >> 3] |= (unsigned)q << (4 * (e & 7));
          }
        *(uint2*)((unsigned char*)(ws + O_PU) + (size_t)rr * 512 + l * 8) = make_uint2(o[0], o[1]);
        if (l == 0) ((float*)(ws + O_SU))[rr] = clipv > 0.f ? clipv / 7.5f : 1.0f;
      }
    }
  }
}

__device__ __forceinline__ void phase0(KP p) {
  const int gtid = blockIdx.x * 256 + threadIdx.x, gsz = gridDim.x * 256;
  char* ws = p->ws;
  for (int rep0 = 0; rep0 < REP_P0; ++rep0) {
  if (gtid < 64) ((int*)(ws + O_CNT))[gtid] = 0;
  if (gtid < 4096) ((int*)(ws + O_CUT))[gtid] = 0;
  if (blockIdx.x == 0) for (int i = threadIdx.x; i < XCD_BAR_WORDS; i += 256) ((unsigned*)(ws + O_BAR))[i] = 0u;
  for (int g = 0; g < 3; ++g) transpose_cvt(p->in[7] + (size_t)g * 1048576, (bf16*)(ws + O_WRKV) + (size_t)g * 1048576, 1024, 1024, gtid, gsz);
  transpose_cvt(p->in[9],  (bf16*)(ws + O_WL1), 1024, 64, gtid, gsz);
  transpose_cvt(p->in[12], (bf16*)(ws + O_WL1) + 64 * 1024, 1024, 64, gtid, gsz);
  transpose_cvt(p->in[14], (bf16*)(ws + O_WL1) + 128 * 1024, 1024, 128, gtid, gsz);
  transpose_cvt(p->in[10], (bf16*)(ws + O_W2T), 64, 1024, gtid, gsz);
  transpose_cvt(p->in[13], (bf16*)(ws + O_A2T), 64, 1024, gtid, gsz);
  transpose_cvt(p->in[15], (bf16*)(ws + O_G2T), 128, 1024, gtid, gsz);
  transpose_cvt(p->in[21], (bf16*)(ws + O_WOUT), 1024, 1024, gtid, gsz);
  transpose_cvt(p->in[22], (bf16*)(ws + O_WKV), 1024, 2048, gtid, gsz);
  transpose_cvt(p->in[23], (bf16*)(ws + O_WQ), 1024, 1024, gtid, gsz);
  transpose_cvt(p->in[26], (bf16*)(ws + O_WO), 1024, 1024, gtid, gsz);
  for (int g = 0; g < 2; ++g) transpose_cvt(p->in[31] + (size_t)g * 2097152, (bf16*)(ws + O_WPQ) + (size_t)g * 2097152, 1024, 2048, gtid, gsz);
  plain_cvt(p->in[32], (bf16*)(ws + O_SK), 65536 / 8, gtid, gsz);
  const float* mu = p->in[6];
  for (int it = gtid; it < NT * 128; it += gsz) {
    const int m = it >> 7, c8 = (it & 127) * 8;
    const float* xr = xin(p, m) + c8;
    const float* pr = nullptr; bool last; float* sho;
    if (m < NTP) { const int t = m & 2047; if (t) pr = xr - 1024; last = (t == 2047); sho = p->out + OFF_SHP + (size_t)(m >> 11) * 1024 + c8; }
    else { const int ms = m - NTP, t = ms & 15; pr = t ? xr - 1024 : p->in[3] + (size_t)(ms >> 4) * 1024 + c8; last = (t == 15); sho = p->out + OFF_SHS + (size_t)(ms >> 4) * 1024 + c8; }
    const f32x4 x0 = ld4(xr), x1 = ld4(xr + 4);
    f32x4 d0, d1;
    if (pr) { d0 = ld4(pr) - x0; d1 = ld4(pr + 4) - x1; } else { d0 = -x0; d1 = -x1; }
    if (last) { st4(sho, x0); st4(sho + 4, x1); }
#pragma unroll
    for (int i = 0; i < 6; ++i) {
      const f32x4 m0 = ld4(mu + i * 1024 + c8), m1 = ld4(mu + i * 1024 + c8 + 4);
      const f32x4 a = x0 + d0 * m0, b = x1 + d1 * m1;
      const uint2 pa = pack4(a), pb = pack4(b);
      *(uint4*)((bf16*)slot(p, i) + (size_t)m * 1024 + c8) = make_uint4(pa.x, pa.y, pb.x, pb.y);
    }
  }
  }
}

struct Job { const bf16* A; const bf16* B; int lda, ldb, K, nmax, mode, m0, n0, aux; };

__device__ __forceinline__ void get_job(KP p, int ph, int id, Job& j) {
  char* ws = p->ws;
  j.lda = 1024; j.ldb = 1024; j.K = 1024; j.nmax = 1 << 30; j.aux = 0;
  if (ph == 1) {
    if (id < 6192) { const int g = id / 2064, r = id % 2064; j.A = (const bf16*)slot(p, g); j.B = (const bf16*)(ws + O_WRKV) + (size_t)g * 1048576; j.mode = 0; j.aux = g; j.m0 = (r >> 3) * 128; j.n0 = (r & 7) * 128; }
    else { const int q = id - 6192, g = q / 258; j.A = (const bf16*)slot(p, 3 + g); j.B = (const bf16*)(ws + O_WL1) + (size_t)g * 65536; j.nmax = (g == 2) ? 128 : 64; j.mode = 1; j.aux = g; j.m0 = (q % 258) * 128; j.n0 = 0; }
  } else if (ph == 2) {
    const int g = id / 2064, r = id % 2064; j.m0 = (r >> 3) * 128; j.n0 = (r & 7) * 128; j.lda = 256; j.mode = 2 + g;
    if (g == 0) { j.A = (const bf16*)slot(p, 9); j.B = (const bf16*)(ws + O_W2T); j.K = 64; j.ldb = 64; }
    else if (g == 1) { j.A = (const bf16*)slot(p, 9) + 64; j.B = (const bf16*)(ws + O_A2T); j.K = 64; j.ldb = 64; }
    else { j.A = (const bf16*)slot(p, 9) + 128; j.B = (const bf16*)(ws + O_G2T); j.K = 128; j.ldb = 128; }
  } else if (ph == 4) {
    j.A = (const bf16*)slot(p, 4); j.B = (const bf16*)(ws + O_WOUT); j.mode = 5; j.m0 = (id >> 3) * 128; j.n0 = (id & 7) * 128;
  } else if (ph == 6 || ph == 12) {
    const int layer = (ph == 12); j.aux = layer;
    j.A = (const bf16*)slot(p, layer ? 4 : 5); j.B = (const bf16*)(ws + O_WPQ) + (size_t)layer * 2097152; j.mode = 6; j.m0 = (id >> 4) * 128; j.n0 = (id & 15) * 128;
  } else if (ph == 8) {
    j.A = (const bf16*)slot(p, 4);
    if (id < 4128) { j.B = (const bf16*)(ws + O_WKV); j.mode = 7; j.m0 = (id >> 4) * 128; j.n0 = (id & 15) * 128; }
    else { const int q = id - 4128; j.B = (const bf16*)(ws + O_WQ); j.mode = 8; j.m0 = (q >> 3) * 128; j.n0 = (q & 7) * 128; }
  } else {
    j.A = (const bf16*)slot(p, 8); j.B = (const bf16*)(ws + O_WO); j.mode = 9; j.m0 = (id >> 3) * 128; j.n0 = (id & 7) * 128;
  }
}

__device__ __forceinline__ f32x4 rope4(f32x4 v, int m, int l) {
  const int pos = (m < NTP) ? (m & 2047) : (4096 + ((m - NTP) & 15));
  const int g = l >> 4; const bool t2 = g >= 2; const int fb = (g & 1) * 4;
  f32x4 o;
#pragma unroll
  for (int r = 0; r < 4; ++r) {
    const float inv = exp2f(-(float)(fb + r) * (18.931568569324174f * 0.125f));
    const float ang = (float)pos * inv;
    float rev = ang * 0.15915494309189535f; rev -= rintf(rev);
    const float s = __builtin_amdgcn_sinf(rev), c = __builtin_amdgcn_cosf(rev);
    const float pr = __shfl_xor(v[r], 32);
    o[r] = v[r] * c + (t2 ? pr * s : -pr * s);
  }
  return o;
}

template <int MODE>
__device__ __forceinline__ void epilogue(KP p, const Job& jb, int m, int n, f32x4 v, int l) {
  const size_t mi = (size_t)m * 1024 + n;
  switch (MODE) {
    case 0: *(uint2*)((bf16*)slot(p, 6 + jb.aux) + mi) = pack4(v); break;
    case 1: if (n < jb.nmax) {
        f32x4 o;
#pragma unroll
        for (int r = 0; r < 4; ++r) o[r] = jb.aux == 0 ? 1.0f - 2.0f / (1.0f + __expf(2.0f * v[r])) : (jb.aux == 1 ? v[r] : 1.0f / (1.0f + __expf(-v[r])));
        *(uint2*)((bf16*)slot(p, 9) + (size_t)m * 256 + jb.aux * 64 + n) = pack4(o);
      } break;
    case 2: {
        const f32x4 w0 = ld4(p->in[8] + n); f32x4 o;
#pragma unroll
        for (int r = 0; r < 4; ++r) { const float z = w0[r] + v[r]; const float sp = __logf(1.0f + __expf(-z)); o[r] = __expf(-__expf(-sp - 0.5f)); }
        st4((float*)slot(p, 0) + mi, o);
      } break;
    case 3: {
        const f32x4 a0 = ld4(p->in[11] + n); f32x4 o;
#pragma unroll
        for (int r = 0; r < 4; ++r) o[r] = 1.0f / (1.0f + __expf(-(a0[r] + v[r])));
        *(uint2*)((bf16*)slot(p, 2) + mi) = pack4(o);
      } break;
    case 4: *(uint2*)((bf16*)slot(p, 3) + mi) = pack4(v); break;
    case 5: { const f32x4 x = ld4(xin(p, m) + n); *(uint2*)((bf16*)slot(p, 0) + mi) = pack4(x * 1.4142135623730951f + v); } break;
    case 9: { const f32x4 x = unpack4(*(const uint2*)((const bf16*)slot(p, 4) + mi)); *(uint2*)((bf16*)slot(p, 2) + mi) = pack4(x * 1.4142135623730951f + v); } break;
    case 7: {
        if (n < 1024) {
          if ((n & 63) < 16) v = rope4(v, m, l);
          float* o = (m < NTP) ? p->out + OFF_CKP + mi : p->out + OFF_CKS + (size_t)(m - NTP) * 1024 + n;
          st4(o, v);
          *(uint2*)((bf16*)slot(p, 5) + mi) = pack4(v);
        } else {
          const int n2 = n - 1024, h = n2 >> 7, e = n2 & 127;
          float* o = (m < NTP) ? p->out + OFF_CVP + (size_t)m * 1024 + n2 : p->out + OFF_CVS + (size_t)(m - NTP) * 1024 + n2;
          st4(o, v);
          bf16* vt = (bf16*)slot(p, 6);
          if (m < NTP) { const int s = m >> 11, t = m & 2047;
#pragma unroll
            for (int r = 0; r < 4; ++r) vt[((size_t)((s * 8 + h) * 128 + e + r)) * 2048 + t] = f2b(v[r]);
          } else { const int ms = m - NTP, b = ms >> 4, t = ms & 15;
#pragma unroll
            for (int r = 0; r < 4; ++r) vt[(size_t)33554432 + ((size_t)((b * 8 + h) * 128 + e + r)) * 16 + t] = f2b(v[r]);
          }
        }
      } break;
    case 8: {
        if ((n & 63) < 16) v = rope4(v, m, l);
        *(uint2*)((bf16*)slot(p, 7) + mi) = pack4(v * 0.18033688011112042f);
      } break;
    default: break;
  }
}

__device__ __forceinline__ void peer_tail(KP p, const Job& jb, f32x4 (&acc)[4][4], char* lds, int tid) {
  const int l = tid & 63, w = tid >> 6, wm = w & 1, wn = w >> 1, g = l >> 4, li = l & 15;
#pragma unroll
  for (int j = 0; j < 4; ++j)
#pragma unroll
    for (int i = 0; i < 4; ++i) {
      const int d0 = wn * 64 + j * 16 + g * 4, tok = wm * 64 + i * 16 + li;
      *(uint2*)(lds + (d0 >> 5) * 8192 + swz(tok, (d0 & 31) >> 3) + ((d0 & 7) * 2)) = pack4(acc[j][i]);
    }
  __syncthreads();
  f32x4 sc[4][4];
#pragma unroll
  for (int j = 0; j < 4; ++j)
#pragma unroll
    for (int i = 0; i < 4; ++i) sc[j][i] = f32x4{0.f, 0.f, 0.f, 0.f};
#pragma unroll
  for (int ks = 0; ks < 4; ++ks) {
    s16x8 kf[4], qf[4];
#pragma unroll
    for (int j = 0; j < 4; ++j) kf[j] = *(const s16x8*)(lds + 32768 + ks * 8192 + swz(wn * 64 + j * 16 + li, g));
#pragma unroll
    for (int i = 0; i < 4; ++i) qf[i] = *(const s16x8*)(lds + ks * 8192 + swz(wm * 64 + i * 16 + li, g));
#pragma unroll
    for (int j = 0; j < 4; ++j)
#pragma unroll
      for (int i = 0; i < 4; ++i) sc[j][i] = __builtin_amdgcn_mfma_f32_16x16x32_bf16(kf[j], qf[i], sc[j][i], 0, 0, 0);
    __builtin_amdgcn_sched_barrier(0);
  }
  __syncthreads();
  unsigned* tko = (unsigned*)slot(p, jb.aux ? 5 : 6);
  const int nt = jb.n0 >> 7;
#pragma unroll 1
  for (int hm = 0; hm < 2; ++hm) {
    if (wm == hm) {
#pragma unroll
      for (int j = 0; j < 4; ++j)
#pragma unroll
        for (int i = 0; i < 4; ++i) {
          const int key0 = wn * 64 + j * 16 + g * 4, tokl = i * 16 + li;
          uint4 o;
          o.x = (f2ord(sc[j][i][0]) & ~127u) | (unsigned)(127 - key0);
          o.y = (f2ord(sc[j][i][1]) & ~127u) | (unsigned)(126 - key0);
          o.z = (f2ord(sc[j][i][2]) & ~127u) | (unsigned)(125 - key0);
          o.w = (f2ord(sc[j][i][3]) & ~127u) | (unsigned)(124 - key0);
          *(uint4*)(lds + (tokl * 132 + key0) * 4) = o;
        }
    }
    __syncthreads();
#pragma unroll 1
    for (int pass = 0; pass < 4; ++pass) {
      int tq = tid; asm volatile("" : "+v"(tq));
      const int tokl = pass * 16 + (tq >> 4), sub = tq & 15;
      const uint4 a = *(const uint4*)(lds + (tokl * 132 + sub * 8) * 4), b = *(const uint4*)(lds + (tokl * 132 + sub * 8 + 4) * 4);
      unsigned k0 = a.x, k1 = a.y, k2 = a.z, k3 = a.w, k4 = b.x, k5 = b.y, k6 = b.z, k7 = b.w, mine = 0;
#define CE(x, y) { const unsigned hi_ = umx(x, y), lo_ = x < y ? x : y; x = hi_; y = lo_; }
      CE(k0, k1) CE(k2, k3) CE(k4, k5) CE(k6, k7)
      CE(k0, k2) CE(k1, k3) CE(k4, k6) CE(k5, k7)
      CE(k1, k2) CE(k5, k6) CE(k0, k4) CE(k3, k7)
      CE(k1, k5) CE(k2, k6)
      CE(k1, k4) CE(k3, k6)
      CE(k2, k4) CE(k3, k5)
      CE(k3, k4)
#undef CE
#pragma unroll
      for (int it = 0; it < 16; ++it) {
        const unsigned mx = row_umax(k0);
        if (sub == it) mine = mx;
        const bool wn_ = (k0 == mx);
        k0 = wn_ ? k1 : k0; k1 = wn_ ? k2 : k1; k2 = wn_ ? k3 : k2; k3 = wn_ ? k4 : k3;
        k4 = wn_ ? k5 : k4; k5 = wn_ ? k6 : k5; k6 = wn_ ? k7 : k6; k7 = wn_ ? 0u : k7;
      }
      tko[(size_t)(jb.m0 + hm * 64 + tokl) * 256 + nt * 16 + sub] = mine;
    }
    __syncthreads();
  }
}

template <int PH, int MODE, int NTN>
__device__ __forceinline__ void gemm_range(KP p, int lo, int hi, int vlo, char* lds) {
  const int G = (hi - lo) / (258 * NTN);
  const int nv = G * 264 * NTN;
  int v0 = blockIdx.x;
  if (v0 < vlo) v0 += ((vlo - v0 + (int)gridDim.x - 1) / (int)gridDim.x) * (int)gridDim.x;
  for (int vv = v0; vv < vlo + nv * REP_GEMM; vv += gridDim.x) {
    const int v = REP_GEMM == 1 ? vv - vlo : (vv - vlo) % nv;
    const int gg = v / (264 * NTN), r = v % (264 * NTN);
    const int xcd = r & 7, jx = r >> 3, nt = jx % NTN, mt = (jx / NTN) * 8 + xcd;
    if (mt >= 258) continue;
    const int id = lo + (gg * 258 + mt) * NTN + nt;
    int tid = threadIdx.x;
    asm volatile("" : "+v"(tid));
    const int l = tid & 63, w = tid >> 6, wm = w & 1, wn = w >> 1, g = l >> 4, li = l & 15;
    Job jb; get_job(p, PH, id, jb);
    f32x4 acc[4][4];
#pragma unroll
    for (int j = 0; j < 4; ++j)
#pragma unroll
      for (int i = 0; i < 4; ++i) acc[j][i] = f32x4{0.f, 0.f, 0.f, 0.f};
    const int lrow = tid >> 3, lkq = tid & 7;
    const int so = (lkq >> 2) * 8192 + swz(lrow, lkq & 3);
    const bf16* ga = jb.A + (size_t)(jb.m0 + lrow) * jb.lda + lkq * 8;
    const size_t sa = (size_t)32 * jb.lda;
    const bf16* gb0 = jb.B + (size_t)min(jb.n0 + lrow, jb.nmax - 1) * jb.ldb + lkq * 8;
    const bf16* gb1 = jb.B + (size_t)min(jb.n0 + lrow + 32, jb.nmax - 1) * jb.ldb + lkq * 8;
    const bf16* gb2 = jb.B + (size_t)min(jb.n0 + lrow + 64, jb.nmax - 1) * jb.ldb + lkq * 8;
    const bf16* gb3 = jb.B + (size_t)min(jb.n0 + lrow + 96, jb.nmax - 1) * jb.ldb + lkq * 8;
    uint4 r0a, r0b, r0c, r0d, r0e, r0f, r0g, r0h, r1a, r1b, r1c, r1d, r1e, r1f, r1g, r1h, r2a, r2b, r2c, r2d, r2e, r2f, r2g, r2h;
#define G_LOAD(S, t) { const int ko_ = (t) * 64; r##S##a = *(const uint4*)(ga + ko_); r##S##b = *(const uint4*)(ga + sa + ko_); r##S##c = *(const uint4*)(ga + 2 * sa + ko_); r##S##d = *(const uint4*)(ga + 3 * sa + ko_); \
      r##S##e = *(const uint4*)(gb0 + ko_); r##S##f = *(const uint4*)(gb1 + ko_); r##S##g = *(const uint4*)(gb2 + ko_); r##S##h = *(const uint4*)(gb3 + ko_); }
#define S_WRITE(S, buf) { char* nb_ = lds + (buf) * 32768 + so; *(uint4*)(nb_) = r##S##a; *(uint4*)(nb_ + 2048) = r##S##b; *(uint4*)(nb_ + 4096) = r##S##c; *(uint4*)(nb_ + 6144) = r##S##d; \
      *(uint4*)(nb_ + 16384) = r##S##e; *(uint4*)(nb_ + 18432) = r##S##f; *(uint4*)(nb_ + 20480) = r##S##g; *(uint4*)(nb_ + 22528) = r##S##h; }
#define K_STEP(u, SL, SW, DIST) { const int kt = kb + (u); if (kt < KT) { \
          if (kt + (DIST) < KT) G_LOAD(SL, kt + (DIST)); \
          const char* sb = lds + ((u) & 1) * 32768; \
          _Pragma("unroll") for (int ks = 0; ks < 2; ++ks) { \
            s16x8 xf[4], wf[4]; \
            _Pragma("unroll") for (int i = 0; i < 4; ++i) xf[i] = *(const s16x8*)(sb + ks * 8192 + swz(wm * 64 + i * 16 + li, g)); \
            _Pragma("unroll") for (int j = 0; j < 4; ++j) wf[j] = *(const s16x8*)(sb + 16384 + ks * 8192 + swz(wn * 64 + j * 16 + li, g)); \
            _Pragma("unroll") for (int j = 0; j < 4; ++j) \
              _Pragma("unroll") for (int i = 0; i < 4; ++i) acc[j][i] = __builtin_amdgcn_mfma_f32_16x16x32_bf16(wf[j], xf[i], acc[j][i], 0, 0, 0); \
          } \
          if (kt + 1 < KT) S_WRITE(SW, ((u) + 1) & 1); \
          __syncthreads(); } }
    const int KT = jb.K >> 6;
    if (MODE == 6) {
      G_LOAD(0, 0);
      S_WRITE(0, 0);
      __syncthreads();
      for (int kb = 0; kb < KT; kb += 2) {
        K_STEP(0, 0, 0, 1)
        K_STEP(1, 0, 0, 1)
      }
      const bf16* sk = (const bf16*)(p->ws + O_SK) + (size_t)jb.aux * 32768 + (size_t)((jb.n0 >> 7) & 1) * 16384;
#pragma unroll
      for (int i = 0; i < 8; ++i) {
        const int q = tid + i * 256, key = q >> 4, dc = q & 15;
        *(uint4*)(lds + 32768 + (dc >> 2) * 8192 + swz(key, dc & 3)) = *(const uint4*)(sk + key * 128 + dc * 8);
      }
    } else {
      G_LOAD(0, 0);
      if (KT > 1) G_LOAD(1, 1);
      if (KT > 2) G_LOAD(2, 2);
      S_WRITE(0, 0);
      __syncthreads();
      for (int kb = 0; kb < KT; kb += 6) {
        K_STEP(0, 0, 1, 3)
        K_STEP(1, 1, 2, 3)
        K_STEP(2, 2, 0, 3)
        K_STEP(3, 0, 1, 3)
        K_STEP(4, 1, 2, 3)
        K_STEP(5, 2, 0, 3)
      }
    }
#undef G_LOAD
#undef S_WRITE
#undef K_STEP
    if (MODE == 6) peer_tail(p, jb, acc, lds, tid);
    else {
#pragma unroll
      for (int j = 0; j < 4; ++j)
#pragma unroll
        for (int i = 0; i < 4; ++i)
        {
          epilogue<MODE>(p, jb, jb.m0 + wm * 64 + i * 16 + li, jb.n0 + wn * 64 + j * 16 + g * 4, acc[j][i], l);
        }
    }
  }
}
template <int ph>
__device__ __forceinline__ void phase_gemm(KP p, char* lds) {
  switch (ph) {
    case 1: gemm_range<1, 0, 8>(p, 0, 6192, 0, lds); gemm_range<1, 1, 1>(p, 6192, 6966, 6336, lds); break;
    case 2: gemm_range<2, 2, 8>(p, 0, 2064, 0, lds); gemm_range<2, 3, 8>(p, 2064, 4128, 2112, lds); gemm_range<2, 4, 8>(p, 4128, 6192, 4224, lds); break;
    case 4: gemm_range<4, 5, 8>(p, 0, 2064, 0, lds); break;
    case 6: gemm_range<6, 6, 16>(p, 0, 4128, 0, lds); break;
    case 8: gemm_range<8, 7, 16>(p, 0, 4128, 0, lds); gemm_range<8, 8, 8>(p, 4128, 6192, 4224, lds); break;
    case 10: gemm_range<10, 9, 8>(p, 0, 2064, 0, lds); break;
    default: gemm_range<12, 6, 16>(p, 0, 4128, 0, lds); break;
  }
}

__device__ __forceinline__ void phase_scan(KP p, char* lds) {
  const int tid = threadIdx.x, l = tid & 63, w = tid >> 6;
  const int row0 = w * 16 + (l >> 3) * 2, col0 = (l & 7) * 8;
  const int lt = tid >> 4, lc = (tid & 15) * 4;
  const bf16* Rb = (const bf16*)slot(p, 6); const bf16* Kb = (const bf16*)slot(p, 7); const bf16* Vb = (const bf16*)slot(p, 8);
  const float* Dc = (const float*)slot(p, 0); const bf16* Ab = (const bf16*)slot(p, 2); const bf16* Gb = (const bf16*)slot(p, 3);
  bf16* YG = (bf16*)slot(p, 4);
  float* ybuf = (float*)(lds + 49152);
  float* cbuf = (float*)(lds + 53248);
  int* s_it = (int*)(lds + 65520);
  int* qL = (int*)(p->ws + O_CNT) + 60; int* qS = qL + 1;
  int role = 0;
  if (threadIdx.x == 0) {
    const unsigned hw = (unsigned)__builtin_amdgcn_s_getreg((7 << 11) | (8 << 6) | 4);
    role = atomicAdd((int*)(p->ws + O_CUT) + ((xb_xcc_id() & 15u) * 256 + (hw & 255u)), 1);
  }
  for (;;) {
    __syncthreads();
    if (tid == 0) {
      int got = -1;
      if (role == 0) { int j = atomicAdd(qL, 1); if (j < 256 * REP_SCAN) got = j & 255; else { j = atomicAdd(qS, 1); if (j < 256) got = 256 + j; } }
      else { int j = atomicAdd(qS, 1); if (j < 256) got = 256 + j; else { j = atomicAdd(qL, 1); if (j < 256 * REP_SCAN) got = j & 255; } }
      *s_it = got;
    }
    __syncthreads();
    const int item = *s_it;
    if (item < 0) break;
    const int seq = item >> 4, h = item & 15;
    const bool samp = seq >= 16; const int b = seq & 15;
    const int nch = samp ? 1 : 128;
    const int tok0 = samp ? NTP + b * 16 : b * 2048;
    f32x2 S2[2][4];
#pragma unroll
    for (int rr = 0; rr < 2; ++rr) {
      if (samp) {
        const float* sp = p->in[2] + ((size_t)(b * 16 + h) * 64 + row0 + rr) * 64 + col0;
        const f32x4 a = ld4(sp), c = ld4(sp + 4);
        S2[rr][0] = f32x2{a[0], a[1]}; S2[rr][1] = f32x2{a[2], a[3]}; S2[rr][2] = f32x2{c[0], c[1]}; S2[rr][3] = f32x2{c[2], c[3]};
      } else {
#pragma unroll
        for (int i = 0; i < 4; ++i) S2[rr][i] = f32x2{0.f, 0.f};
      }
    }
    const int ch0 = h * 64 + lc;
    const f32x4 kk4 = ld4(p->in[16] + ch0), ka4 = ld4(p->in[17] + ch0), rk4 = ld4(p->in[18] + ch0);
    const f32x4 lng = ld4(p->in[19] + ch0), lnb = ld4(p->in[20] + ch0);
    uint2 rr_, rk_, rv_, ra_; f32x4 rd_;
    auto issue = [&](int ch) {
      const size_t off = (size_t)(tok0 + ch * 16 + lt) * 1024 + ch0;
      rr_ = *(const uint2*)(Rb + off); rk_ = *(const uint2*)(Kb + off); rv_ = *(const uint2*)(Vb + off); ra_ = *(const uint2*)(Ab + off);
      rd_ = ld4(Dc + off);
    };
    auto stage = [&](int buf) {
      const f32x4 r4 = unpack4(rr_), k4 = unpack4(rk_), v4 = unpack4(rv_), a4 = unpack4(ra_);
      const f32x4 kkr = k4 * kk4;
      float ss = kkr[0] * kkr[0] + kkr[1] * kkr[1] + kkr[2] * kkr[2] + kkr[3] * kkr[3];
      ss = row_sum(ss);
      const float inv = 1.0f / fmaxf(sqrtf(ss), 1e-12f);
      const f32x4 kkn = kkr * inv;
      const f32x4 kp = k4 * (1.0f + (a4 - 1.0f) * ka4);
      const f32x4 kka = kkn * a4;
      const f32x4 t = r4 * kp * rk4;
      float cb = row_sum(t[0] + t[1] + t[2] + t[3]);
      char* bp = lds + buf * 24576 + lt * 256 + lc * 4;
      st4((float*)(bp), r4); st4((float*)(bp + 4096), rd_); st4((float*)(bp + 8192), kp);
      st4((float*)(bp + 12288), kkn); st4((float*)(bp + 16384), kka); st4((float*)(bp + 20480), v4);
      if ((tid & 15) == 0) cbuf[buf * 16 + lt] = cb;
    };
    __syncthreads();
    issue(0); stage(0);
    __syncthreads();
    for (int ch = 0; ch < nch; ++ch) {
      const int cur = ch & 1;
      const bool more = ch + 1 < nch;
      const size_t goff = (size_t)(tok0 + ch * 16 + lt) * 1024 + ch0;
      const uint2 gq = *(const uint2*)(Gb + goff);
      if (more) issue(ch + 1);
#pragma unroll
      for (int t = 0; t < 16; ++t) {
        const char* bp = lds + cur * 24576 + t * 256 + col0 * 4;
        f32x2 rv[4], dv[4], kv[4], qv[4], av[4];
#pragma unroll
        for (int hh = 0; hh < 2; ++hh) {
          const float4 a0 = *(const float4*)(bp + hh * 16), b0 = *(const float4*)(bp + 4096 + hh * 16), c0 = *(const float4*)(bp + 8192 + hh * 16);
          const float4 d0 = *(const float4*)(bp + 12288 + hh * 16), e0 = *(const float4*)(bp + 16384 + hh * 16);
          rv[2 * hh] = f32x2{a0.x, a0.y}; rv[2 * hh + 1] = f32x2{a0.z, a0.w};
          dv[2 * hh] = f32x2{b0.x, b0.y}; dv[2 * hh + 1] = f32x2{b0.z, b0.w};
          kv[2 * hh] = f32x2{c0.x, c0.y}; kv[2 * hh + 1] = f32x2{c0.z, c0.w};
          qv[2 * hh] = f32x2{d0.x, d0.y}; qv[2 * hh + 1] = f32x2{d0.z, d0.w};
          av[2 * hh] = f32x2{e0.x, e0.y}; av[2 * hh + 1] = f32x2{e0.z, e0.w};
        }
        const float2 vv = *(const float2*)(lds + cur * 24576 + t * 256 + 20480 + row0 * 4);
        float yo[2];
#pragma unroll
        for (int rr = 0; rr < 2; ++rr) {
          f32x2 sa = S2[rr][0] * qv[0];
          sa = S2[rr][1] * qv[1] + sa; sa = S2[rr][2] * qv[2] + sa; sa = S2[rr][3] * qv[3] + sa;
          const float skk = oct_sum(sa.x + sa.y);
          const float vr = rr ? vv.y : vv.x;
          const f32x2 vr2 = {vr, vr}, ns2 = {-skk, -skk};
#pragma unroll
          for (int c = 0; c < 4; ++c) { const f32x2 tt = S2[rr][c] * dv[c] + vr2 * kv[c]; S2[rr][c] = ns2 * av[c] + tt; }
          f32x2 ya = S2[rr][0] * rv[0];
          ya = S2[rr][1] * rv[1] + ya; ya = S2[rr][2] * rv[2] + ya; ya = S2[rr][3] * rv[3] + ya;
          yo[rr] = oct_sum(ya.x + ya.y);
        }
        if ((l & 7) == 0) *(float2*)(ybuf + t * 64 + row0) = make_float2(yo[0], yo[1]);
      }
      __syncthreads();
      {
        const f32x4 y4 = ld4(ybuf + lt * 64 + lc);
        const float mean = row_sum(y4[0] + y4[1] + y4[2] + y4[3]) * (1.0f / 64.0f);
        const f32x4 dy = y4 - mean;
        const float var = row_sum(dy[0] * dy[0] + dy[1] * dy[1] + dy[2] * dy[2] + dy[3] * dy[3]) * (1.0f / 64.0f);
        const float rs = rsqrtf(var + 64e-5f);
        const f32x4 v4 = ld4((const float*)(lds + cur * 24576 + 20480 + lt * 256 + lc * 4));
        const float cb = cbuf[cur * 16 + lt];
        const f32x4 g4 = unpack4(gq);
        const f32x4 o = (dy * rs * lng + lnb + v4 * cb) * g4;
        *(uint2*)(YG + goff) = pack4(o);
      }
      if (more) stage(cur ^ 1);
      __syncthreads();
    }
    float* so = p->out + (samp ? OFF_WKVS : OFF_WKVP) + ((size_t)(b * 16 + h) * 64 + row0) * 64 + col0;
#pragma unroll
    for (int rr = 0; rr < 2; ++rr) {
      st4(so + rr * 64, f32x4{S2[rr][0].x, S2[rr][0].y, S2[rr][1].x, S2[rr][1].y});
      st4(so + rr * 64 + 4, f32x4{S2[rr][2].x, S2[rr][2].y, S2[rr][3].x, S2[rr][3].y});
    }
  }
  int* qQ = (int*)(p->ws + O_CNT) + 62;
  for (;;) {
    __syncthreads();
    if (tid == 0) *s_it = atomicAdd(qQ, 1);
    __syncthreads();
    const int ch = *s_it;
    if (ch >= 1024) break;
    quant_rows(p, ch * 64);
  }
}

__device__ __forceinline__ void phase_ln(KP p, const bf16* src, float* d32, bf16* db, const float* gam, const float* bet) {
  const int tid_ = otid();
  const int l = tid_ & 63, w = tid_ >> 6;
  for (int m = blockIdx.x * 4 + w; m < NT; m += gridDim.x * 4) {
    const bf16* s = src + (size_t)m * 1024;
    f32x4 x[4];
#pragma unroll
    for (int i = 0; i < 4; ++i) x[i] = unpack4(*(const uint2*)(s + i * 256 + l * 4));
    float sm = 0.f;
#pragma unroll
    for (int i = 0; i < 4; ++i) sm += x[i][0] + x[i][1] + x[i][2] + x[i][3];
    const float mean = wave_sum(sm) * (1.0f / 1024.0f);
    float sq = 0.f;
#pragma unroll
    for (int i = 0; i < 4; ++i) { x[i] = x[i] - mean; sq += x[i][0] * x[i][0] + x[i][1] * x[i][1] + x[i][2] * x[i][2] + x[i][3] * x[i][3]; }
    const float rs = rsqrtf(wave_sum(sq) * (1.0f / 1024.0f) + 1e-5f);
#pragma unroll
    for (int i = 0; i < 4; ++i) {
      const int e = i * 256 + l * 4;
      const f32x4 y = x[i] * rs * ld4(gam + e) + ld4(bet + e);
      *(uint2*)(db + (size_t)m * 1024 + e) = pack4(y);
    }
  }
}

__device__ __forceinline__ float dotq4(unsigned u, const float* x, float d) {
  d = fmaf((float)(u & 255u), x[0], d); d = fmaf((float)((u >> 8) & 255u), x[1], d);
  d = fmaf((float)((u >> 16) & 255u), x[2], d); d = fmaf((float)(u >> 24), x[3], d);
  return d;
}
__device__ __forceinline__ float dotq(uint4 u, const float* x) {
  return dotq4(u.x, x, 0.f) + dotq4(u.y, x + 4, 0.f) + dotq4(u.z, x + 8, 0.f) + dotq4(u.w, x + 12, 0.f);
}
__device__ __forceinline__ void axq4(unsigned u, float a, float* o) {
  o[0] = fmaf(a, (float)(u & 255u), o[0]); o[1] = fmaf(a, (float)((u >> 8) & 255u), o[1]);
  o[2] = fmaf(a, (float)((u >> 16) & 255u), o[2]); o[3] = fmaf(a, (float)(u >> 24), o[3]);
}
__device__ __forceinline__ void axq(uint4 u, float a, float* o) { axq4(u.x, a, o); axq4(u.y, a, o + 4); axq4(u.z, a, o + 8); axq4(u.w, a, o + 12); }
__device__ __forceinline__ float reduce8(const float* pp, int l) {
  const bool b0 = l & 1, b1 = l & 2, b2 = l & 4;
  float a[4], bb[2];
#pragma unroll
  for (int i = 0; i < 4; ++i) { const float keep = b0 ? pp[2 * i + 1] : pp[2 * i], send = b0 ? pp[2 * i] : pp[2 * i + 1]; a[i] = keep + dppf<0xB1>(send); }
#pragma unroll
  for (int i = 0; i < 2; ++i) { const float keep = b1 ? a[2 * i + 1] : a[2 * i], send = b1 ? a[2 * i] : a[2 * i + 1]; bb[i] = keep + dppf<0x4E>(send); }
  const float keep = b2 ? bb[1] : bb[0], send = b2 ? bb[0] : bb[1];
  float c = keep + dppf<0x124>(send);
  c += dppf<0x128>(c);
  c += __shfl_xor(c, 16); c += __shfl_xor(c, 32);
  return c;
}

__device__ __forceinline__ void phase_peer_experts(KP p, int layer) {
  const int tid_ = otid();
  const int l = tid_ & 63, w = tid_ >> 6;
  const unsigned* TK = (const unsigned*)slot(p, layer ? 5 : 6);
  const bf16* X = (const bf16*)slot(p, layer ? 4 : 5);
  const unsigned char* PU = (const unsigned char*)(p->ws + O_PU) + (size_t)layer * 8388608;
  const unsigned char* PV = (const unsigned char*)(p->ws + O_PV) + (size_t)layer * 8388608;
  const float* SU = (const float*)(p->ws + O_SU) + layer * 16384;
  const float* SV = (const float*)(p->ws + O_SV) + layer * 16384;
  const float* lg = p->in[29] + layer * 1024; const float* lb = p->in[30] + layer * 1024;
  const int hq = l >> 4, r = l & 15;
  unsigned cd[4];
#pragma unroll
  for (int c = 0; c < 4; ++c) cd[c] = CAND[r * 4 + c];
  for (int mv = blockIdx.x * 4 + w; mv < NT * REP_PE; mv += gridDim.x * 4) {
    const int m = REP_PE == 1 ? mv : mv % NT;
    const unsigned* tk = TK + (size_t)m * 256;
    int eidx[2]; float gate[2];
#pragma unroll
    for (int pass = 0; pass < 2; ++pass) {
      const int h = pass * 4 + hq;
      unsigned k[4];
#pragma unroll
      for (int c = 0; c < 4; ++c) {
        const unsigned ab = cd[c] == 255u ? 0u : cd[c];
        const unsigned k1 = tk[h * 32 + (ab >> 4)], k2 = tk[h * 32 + 16 + (ab & 15)];
        const float s = ord2f(k1 & ~127u) + ord2f(k2 & ~127u);
        k[c] = cd[c] == 255u ? 0u : ((f2ord(s) & ~255u) | (255u - cd[c]));
      }
      unsigned mine = 0;
#pragma unroll
      for (int it = 0; it < 16; ++it) {
        unsigned mx = umx(umx(k[0], k[1]), umx(k[2], k[3]));
        mx = row_umax(mx);
        if (r == it) mine = mx;
#pragma unroll
        for (int c = 0; c < 4; ++c) k[c] = (k[c] == mx) ? 0u : k[c];
      }
      const unsigned pos = 255u - (mine & 255u);
      const unsigned k1 = tk[h * 32 + (pos >> 4)], k2 = tk[h * 32 + 16 + (pos & 15)];
      eidx[pass] = (int)((127u - (k1 & 127u)) * 128u + (127u - (k2 & 127u)));
      const float s = ord2f(mine & ~255u);
      const float mxs = row_max(s);
      const float ex = __expf(s - mxs);
      gate[pass] = ex / row_sum(ex);
    }
    const bf16* xr = X + (size_t)m * 1024;
    float xv[16], out[16];
    {
      const uint4 u0 = *(const uint4*)(xr + l * 16), u1 = *(const uint4*)(xr + l * 16 + 8);
      const f32x4 a = unpack4(make_uint2(u0.x, u0.y)), b = unpack4(make_uint2(u0.z, u0.w)), c = unpack4(make_uint2(u1.x, u1.y)), d = unpack4(make_uint2(u1.z, u1.w));
#pragma unroll
      for (int i = 0; i < 4; ++i) { xv[i] = a[i]; xv[4 + i] = b[i]; xv[8 + i] = c[i]; xv[12 + i] = d[i]; }
    }
    float xam = 0.f;
#pragma unroll
    for (int i = 0; i < 16; ++i) { out[i] = 0.f; xam = fmaxf(xam, fabsf(xv[i])); }
    xam = row_max(xam); xam = fmaxf(xam, __shfl_xor(xam, 16)); xam = fmaxf(xam, __shfl_xor(xam, 32));
    const float xinv = xam > 0.f ? 127.0f / xam : 0.f, xs = xam * (1.0f / 127.0f);
    int xq[16]; int sqi = 0;
#pragma unroll
    for (int i = 0; i < 16; ++i) { xq[i] = (int)rintf(xv[i] * xinv); sqi += xq[i]; }
    int xe0 = (xq[0] & 255) | ((xq[2] & 255) << 8) | ((xq[4] & 255) << 16) | (xq[6] << 24);
    int xo0 = (xq[1] & 255) | ((xq[3] & 255) << 8) | ((xq[5] & 255) << 16) | (xq[7] << 24);
    int xe1 = (xq[8] & 255) | ((xq[10] & 255) << 8) | ((xq[12] & 255) << 16) | (xq[14] << 24);
    int xo1 = (xq[9] & 255) | ((xq[11] & 255) << 8) | ((xq[13] & 255) << 16) | (xq[15] << 24);
    const float sx = wave_sum((float)sqi);
    float csum = 0.f;
    uint2 ua[8], ub[8];
    uint2 va[8], vb[8];
#define LD_U(dst, ps, s0) { _Pragma("unroll") for (int k = 0; k < 8; ++k) dst[k] = *(const uint2*)(PU + (size_t)__builtin_amdgcn_readlane(eidx[ps], (s0) + k) * 512 + l * 8); }
#define LD_V(dst, ps, s0) { _Pragma("unroll") for (int k = 0; k < 8; ++k) dst[k] = *(const uint2*)(PV + (size_t)__builtin_amdgcn_readlane(eidx[ps], (s0) + k) * 512 + l * 8); }
#define DO_U(buf, s0, MD) { float pp[8]; \
        _Pragma("unroll") for (int k = 0; k < 8; ++k) { \
          const unsigned w0 = buf[k].x, w1 = buf[k].y; \
          int a_ = __builtin_amdgcn_sdot4((int)(w0 & 0x0F0F0F0Fu), xe0, 0, false); \
          a_ = __builtin_amdgcn_sdot4((int)((w0 >> 4) & 0x0F0F0F0Fu), xo0, a_, false); \
          a_ = __builtin_amdgcn_sdot4((int)(w1 & 0x0F0F0F0Fu), xe1, a_, false); \
          a_ = __builtin_amdgcn_sdot4((int)((w1 >> 4) & 0x0F0F0F0Fu), xo1, a_, false); \
          pp[k] = (float)a_; } \
        const float c_ = reduce8(pp, l); \
        if ((l >> 3) == ((s0) >> 3)) MD = c_; }
#define TR4(d0, d1, d2, d3, A4, o) { \
          const unsigned pl_ = __builtin_amdgcn_perm(d1, d0, 0x05010400u), ph_ = __builtin_amdgcn_perm(d1, d0, 0x07030602u); \
          const unsigned ql_ = __builtin_amdgcn_perm(d3, d2, 0x05010400u), qh_ = __builtin_amdgcn_perm(d3, d2, 0x07030602u); \
          iacc[(o) + 0] = __builtin_amdgcn_sdot4((int)__builtin_amdgcn_perm(ql_, pl_, 0x05040100u), A4, iacc[(o) + 0], false); \
          iacc[(o) + 2] = __builtin_amdgcn_sdot4((int)__builtin_amdgcn_perm(ql_, pl_, 0x07060302u), A4, iacc[(o) + 2], false); \
          iacc[(o) + 4] = __builtin_amdgcn_sdot4((int)__builtin_amdgcn_perm(qh_, ph_, 0x05040100u), A4, iacc[(o) + 4], false); \
          iacc[(o) + 6] = __builtin_amdgcn_sdot4((int)__builtin_amdgcn_perm(qh_, ph_, 0x07060302u), A4, iacc[(o) + 6], false); }
#define NLO(w) ((w) & 0x0F0F0F0Fu)
#define NHI(w) (((w) >> 4) & 0x0F0F0F0Fu)
#define DO_V(buf, s0, CQ) { _Pragma("unroll") for (int hb = 0; hb < 2; ++hb) { \
          const int c0_ = __builtin_amdgcn_readlane(CQ, (s0) + hb * 4), c1_ = __builtin_amdgcn_readlane(CQ, (s0) + hb * 4 + 1); \
          const int c2_ = __builtin_amdgcn_readlane(CQ, (s0) + hb * 4 + 2), c3_ = __builtin_amdgcn_readlane(CQ, (s0) + hb * 4 + 3); \
          const int a4_ = (c0_ & 255) | ((c1_ & 255) << 8) | ((c2_ & 255) << 16) | ((c3_ & 255) << 24); \
          TR4(NLO(buf[hb * 4].x), NLO(buf[hb * 4 + 1].x), NLO(buf[hb * 4 + 2].x), NLO(buf[hb * 4 + 3].x), a4_, 0) \
          TR4(NHI(buf[hb * 4].x), NHI(buf[hb * 4 + 1].x), NHI(buf[hb * 4 + 2].x), NHI(buf[hb * 4 + 3].x), a4_, 1) \
          TR4(NLO(buf[hb * 4].y), NLO(buf[hb * 4 + 1].y), NLO(buf[hb * 4 + 2].y), NLO(buf[hb * 4 + 3].y), a4_, 8) \
          TR4(NHI(buf[hb * 4].y), NHI(buf[hb * 4 + 1].y), NHI(buf[hb * 4 + 2].y), NHI(buf[hb * 4 + 3].y), a4_, 9) } }
#define CQUANT(WG, CQ, CS) float CS; int CQ; { float cm_ = fabsf(WG); cm_ = row_max(cm_); cm_ = fmaxf(cm_, __shfl_xor(cm_, 16)); cm_ = fmaxf(cm_, __shfl_xor(cm_, 32)); \
          CS = cm_ * (1.0f / 127.0f); CQ = (int)rintf(WG * (cm_ > 0.f ? 127.0f / cm_ : 0.f)); }
#define CSUM(CQ) wave_sum((float)CQ)
#define FLUSH(CS, SUMQ) { const float off_ = 7.5f * (SUMQ); _Pragma("unroll") for (int i = 0; i < 16; ++i) { out[i] = fmaf(CS, (float)iacc[i] - off_, out[i]); iacc[i] = 0; } }
    float md0 = 0.f, md1 = 0.f;
    int iacc[16];
#pragma unroll
    for (int i = 0; i < 16; ++i) iacc[i] = 0;
    LD_U(ua, 0, 0)
#pragma unroll 1
    for (int s = 0; s < 64; s += 16) {
      LD_U(ub, 0, s + 8)
      DO_U(ua, s, md0)
      if (s + 16 < 64) LD_U(ua, 0, s + 16) else { LD_V(va, 0, 0) LD_U(ua, 1, 0) }
      DO_U(ub, s + 8, md0)
    }
    const float su0 = SU[eidx[0]], sv0 = SV[eidx[0]];
    const float hh0 = su0 * xs * (md0 - 7.5f * sx);
    const float wgt0 = gate[0] * 0.5f * hh0 * (1.0f + erff(hh0 * 0.70710678118654752f)) * sv0;
    CQUANT(wgt0, cq0, cs0)
    const float sq0 = CSUM(cq0);
#pragma unroll 1
    for (int s = 0; s < 64; s += 16) {
      LD_V(vb, 0, s + 8) LD_U(ub, 1, s + 8)
      DO_V(va, s, cq0) DO_U(ua, s, md1)
      if (s + 16 < 64) { LD_V(va, 0, s + 16) LD_U(ua, 1, s + 16) } else LD_V(va, 1, 0)
      DO_V(vb, s + 8, cq0) DO_U(ub, s + 8, md1)
    }
    const float su1 = SU[eidx[1]], sv1 = SV[eidx[1]];
    const float hh1 = su1 * xs * (md1 - 7.5f * sx);
    FLUSH(cs0, sq0)
    const float wgt1 = gate[1] * 0.5f * hh1 * (1.0f + erff(hh1 * 0.70710678118654752f)) * sv1;
    CQUANT(wgt1, cq1, cs1)
    const float sq1 = CSUM(cq1);
#pragma unroll 1
    for (int s = 0; s < 64; s += 16) {
      LD_V(vb, 1, s + 8)
      DO_V(va, s, cq1)
      if (s + 16 < 64) LD_V(va, 1, s + 16)
      DO_V(vb, s + 8, cq1)
    }
    FLUSH(cs1, sq1)
#undef LD_U
#undef LD_V
#undef DO_U
#undef DO_V
#undef TR4
#undef NLO
#undef NHI
#undef CSUM
#undef CQUANT
#undef FLUSH
    float sm = 0.f;
#pragma unroll
    for (int i = 0; i < 16; ++i) { out[i] = fmaf(xv[i], 1.4142135623730951f, out[i]); sm += out[i]; }
    const float mean = wave_sum(sm) * (1.0f / 1024.0f);
    float sq = 0.f;
#pragma unroll
    for (int i = 0; i < 16; ++i) { out[i] -= mean; sq = fmaf(out[i], out[i], sq); }
    const float rs = rsqrtf(wave_sum(sq) * (1.0f / 1024.0f) + 1e-5f);
    float* d32 = layer ? ((m < NTP) ? p->out + OFF_YP + (size_t)m * 1024 : p->out + OFF_YS + (size_t)(m - NTP) * 1024)
                       : (float*)slot(p, 0) + (size_t)m * 1024;
#pragma unroll
    for (int hf = 0; hf < 2; ++hf) {
      const int e = l * 16 + hf * 8;
      const f32x4 g0 = ld4(lg + e), g1 = ld4(lg + e + 4), b0 = ld4(lb + e), b1 = ld4(lb + e + 4);
      f32x4 y0, y1;
#pragma unroll
      for (int i = 0; i < 4; ++i) { y0[i] = out[hf * 8 + i] * rs * g0[i] + b0[i]; y1[i] = out[hf * 8 + 4 + i] * rs * g1[i] + b1[i]; }
      if (layer) { st4(d32 + e, y0); st4(d32 + e + 4, y1); }
      else {
        const uint2 pa = pack4(y0), pb = pack4(y1);
        *(uint4*)((bf16*)slot(p, 4) + (size_t)m * 1024 + e) = make_uint4(pa.x, pa.y, pb.x, pb.y);
      }
    }
  }
}

__device__ __forceinline__ void phase_attn(KP p, char* lds) {
  const int tid = threadIdx.x, l = tid & 63, w = tid >> 6, c = w & 1, qh = w >> 1, g = l >> 4, li = l & 15;
  int* s_item = (int*)(lds + 65520);
  int* counter = (int*)(p->ws + O_CNT);
  const float* lp = p->in[24];
  const float s1 = wave_sum(lp[l] * lp[64 + l]), s2 = wave_sum(lp[128 + l] * lp[192 + l]);
  const float lam = __expf(s1) - __expf(s2) + 0.35550906759f;
  const bf16* Kb = (const bf16*)slot(p, 5); const bf16* VT = (const bf16*)slot(p, 6);
  const bf16* Qb = (const bf16*)slot(p, 7); bf16* Ob = (bf16*)slot(p, 8);
  const float* ck = p->in[4]; const float* cv = p->in[5];
  const float* sg = p->in[25];
  const int myq = (int)(xb_xcc_id() & 7u);
  int qoff = 0;
  for (;;) {
    __syncthreads();
    if (tid == 0) {
      int got = -1;
      while (qoff < 8) {
        const int qx = (myq + qoff) & 7;
        const int j = atomicAdd(counter + qx * 8, 1);
        if (j < 640 * REP_ATTN) { got = qx * 1024 + (j % 640); break; }
        ++qoff;
      }
      *s_item = got;
    }
    __syncthreads();
    const int item = *s_item;
    if (item < 0) break;
    bool samp; int b, h, qc, sp;
    {
      const int qx = item >> 10, j = item & 1023;
      h = qx;
      if (j < 128) { samp = true; b = j >> 3; sp = j & 7; qc = 0; }
      else { const int j2 = j - 128; samp = false; sp = 0; b = j2 >> 5; qc = 31 - (j2 & 31); }
    }
    const int nkt = samp ? (sp == 7 ? 17 : 16) : qc + 1;
    const int qtok0 = samp ? NTP + b * 16 : b * 2048 + qc * 64;
    const int nq = samp ? 16 : 64;
    s16x8 qf[2][2];
#pragma unroll
    for (int f = 0; f < 2; ++f)
#pragma unroll
      for (int ks = 0; ks < 2; ++ks) {
        const int qi = min(qh * 32 + f * 16 + li, nq - 1);
        qf[f][ks] = *(const s16x8*)(Qb + (size_t)(qtok0 + qi) * 1024 + h * 128 + c * 64 + ks * 32 + g * 8);
      }
    f32x4 ot[8][2];
#pragma unroll
    for (int ef = 0; ef < 8; ++ef) { ot[ef][0] = f32x4{0.f, 0.f, 0.f, 0.f}; ot[ef][1] = f32x4{0.f, 0.f, 0.f, 0.f}; }
    float mrun[2] = {-INFINITY, -INFINITY}, lsum[2] = {0.f, 0.f};
    uint4 raw[8];
    auto load_tile = [&](int kt, int tid) {
      if (samp && kt < 16) {
#pragma unroll
        for (int i = 0; i < 2; ++i) {
          const int q = tid + i * 256, cc = q >> 8, key = (q >> 3) & 31, dch = q & 7;
          const float* src = ck + ((size_t)(b * 4096 + (sp * 16 + kt) * 32 + key)) * 1024 + h * 128 + cc * 64 + dch * 8;
          raw[2 * i] = *(const uint4*)src; raw[2 * i + 1] = *(const uint4*)(src + 4);
        }
        const int key = tid & 31, eq = tid >> 5;
        const float* src = cv + ((size_t)(b * 4096 + (sp * 16 + kt) * 32 + key)) * 1024 + h * 128 + eq * 16;
#pragma unroll
        for (int i = 0; i < 4; ++i) raw[4 + i] = *(const uint4*)(src + i * 4);
      } else if (!samp) {
        const bf16* kb_ = Kb + (size_t)(b * 2048 + kt * 64) * 1024 + h * 128;
        const bf16* vb_ = VT + (size_t)((b * 8 + h) * 128) * 2048 + kt * 64;
        const unsigned ko_ = (unsigned)(tid >> 3) * 1024u + (unsigned)(tid & 7) * 8u;
        const unsigned vo_ = (unsigned)(tid >> 3) * 2048u + (unsigned)(tid & 7) * 8u;
        raw[0] = *(const uint4*)(kb_ + ko_);
        raw[1] = *(const uint4*)(kb_ + (ko_ + 32768u));
        raw[2] = *(const uint4*)(kb_ + (ko_ + 64u));
        raw[3] = *(const uint4*)(kb_ + (ko_ + 32768u + 64u));
        raw[4] = *(const uint4*)(vb_ + vo_);
        raw[5] = *(const uint4*)(vb_ + (vo_ + 65536u));
        raw[6] = *(const uint4*)(vb_ + (vo_ + 131072u));
        raw[7] = *(const uint4*)(vb_ + (vo_ + 196608u));
      } else {
        const int ktok0 = NTP + b * 16;
        const size_t vbase = (size_t)33554432 + (size_t)((b * 8 + h) * 128) * 16;
#pragma unroll
        for (int i = 0; i < 4; ++i) {
          const int q = tid + i * 256, cc = q >> 9, key = (q >> 3) & 63, dch = q & 7;
          const uint4 kvv = *(const uint4*)(Kb + (size_t)(ktok0 + (key & 15)) * 1024 + h * 128 + cc * 64 + dch * 8);
          const int e = q >> 3, kch = q & 7;
          const uint4 vvv = *(const uint4*)(VT + vbase + (size_t)e * 16 + (kch & 1) * 8);
          const bool kok = key < 16, vok = kch < 2;
          raw[i] = make_uint4(kok ? kvv.x : 0u, kok ? kvv.y : 0u, kok ? kvv.z : 0u, kok ? kvv.w : 0u);
          raw[4 + i] = make_uint4(vok ? vvv.x : 0u, vok ? vvv.y : 0u, vok ? vvv.z : 0u, vok ? vvv.w : 0u);
        }
      }
    };
    auto store_tile = [&](int kt, int tid) {
      if (samp && kt < 16) {
#pragma unroll
        for (int i = 0; i < 2; ++i) {
          const int q = tid + i * 256, cc = q >> 8, key = (q >> 3) & 31, dch = q & 7;
          const uint4 a = raw[2 * i], bq = raw[2 * i + 1];
          uint4 o;
          o.x = pack2(__uint_as_float(a.x), __uint_as_float(a.y)); o.y = pack2(__uint_as_float(a.z), __uint_as_float(a.w));
          o.z = pack2(__uint_as_float(bq.x), __uint_as_float(bq.y)); o.w = pack2(__uint_as_float(bq.z), __uint_as_float(bq.w));
          *(uint4*)(lds + cc * 8192 + (dch >> 2) * 4096 + swz(key, dch & 3)) = o;
        }
        const int key = tid & 31, eq = tid >> 5;
#pragma unroll
        for (int i = 0; i < 4; ++i) {
          const int e = eq * 16 + i * 4;
          *(bf16*)(lds + 16384 + (e + 0) * 144 + key * 2) = f2b(__uint_as_float(raw[4 + i].x));
          *(bf16*)(lds + 16384 + (e + 1) * 144 + key * 2) = f2b(__uint_as_float(raw[4 + i].y));
          *(bf16*)(lds + 16384 + (e + 2) * 144 + key * 2) = f2b(__uint_as_float(raw[4 + i].z));
          *(bf16*)(lds + 16384 + (e + 3) * 144 + key * 2) = f2b(__uint_as_float(raw[4 + i].w));
        }
      } else {
#pragma unroll
        for (int i = 0; i < 4; ++i) {
          const int dch = tid & 7;
          *(uint4*)(lds + ((dch >> 2) * 4096 + swz(tid >> 3, dch & 3)) + (i & 1) * 2048 + (i >> 1) * 8192) = raw[i];
          *(uint4*)(lds + 16384 + ((tid >> 3) * 144 + dch * 16) + i * 4608) = raw[4 + i];
        }
      }
    };
    load_tile(0, tid);
    for (int kt = 0; kt < nkt; ++kt) {
      int tz = tid;
      asm volatile("" : "+v"(tz));
      const int li = tz & 15, g = (tz & 63) >> 4;
      __syncthreads();
      store_tile(kt, tz);
      __syncthreads();
      if (kt + 1 < nkt) load_tile(kt + 1, tz);
      const int kvalid = samp ? (kt == 16 ? 16 : 32) : 64;
      const bool full = !samp;
      f32x4 st[4][2];
#pragma unroll
      for (int kf = 0; kf < 4; ++kf) { st[kf][0] = f32x4{0.f, 0.f, 0.f, 0.f}; st[kf][1] = f32x4{0.f, 0.f, 0.f, 0.f}; }
      {
        s16x8 kfr[2][4];
#pragma unroll
        for (int ks = 0; ks < 2; ++ks)
#pragma unroll
          for (int kf = 0; kf < 4; ++kf)
            if (kf < 2 || full) kfr[ks][kf] = *(const s16x8*)(lds + c * 8192 + ks * 4096 + swz(kf * 16 + li, g));
#pragma unroll
        for (int ks = 0; ks < 2; ++ks)
#pragma unroll
          for (int kf = 0; kf < 4; ++kf)
            if (kf < 2 || full) {
              st[kf][0] = __builtin_amdgcn_mfma_f32_16x16x32_bf16(kfr[ks][kf], qf[0][ks], st[kf][0], 0, 0, 0);
              st[kf][1] = __builtin_amdgcn_mfma_f32_16x16x32_bf16(kfr[ks][kf], qf[1][ks], st[kf][1], 0, 0, 0);
            }
        __builtin_amdgcn_sched_barrier(0);
      }
      if (kvalid < 64) {
#pragma unroll
        for (int kf = 0; kf < 4; ++kf)
#pragma unroll
          for (int r = 0; r < 4; ++r)
            if (kf * 16 + g * 4 + r >= kvalid) { st[kf][0][r] = -INFINITY; st[kf][1][r] = -INFINITY; }
      }
#pragma unroll
      for (int f = 0; f < 2; ++f) {
        float ml = st[0][f][0];
#pragma unroll
        for (int kf = 0; kf < 4; ++kf)
#pragma unroll
          for (int r = 0; r < 4; ++r) ml = fmaxf(ml, st[kf][f][r]);
        ml = fmaxf(ml, __shfl_xor(ml, 16)); ml = fmaxf(ml, __shfl_xor(ml, 32));
        const bool grow = ml > mrun[f] + 8.0f;
        const float mn = grow ? ml : mrun[f];
        float ps = 0.f;
#pragma unroll
        for (int kf = 0; kf < 4; ++kf)
#pragma unroll
          for (int r = 0; r < 4; ++r) { const float pv = __builtin_amdgcn_exp2f(st[kf][f][r] - mn); st[kf][f][r] = pv; ps += pv; }
        if (__builtin_amdgcn_ballot_w64(grow) != 0ull) {
          const float scl = __builtin_amdgcn_exp2f(mrun[f] - mn);
          lsum[f] *= scl;
#pragma unroll
          for (int ef = 0; ef < 8; ++ef) ot[ef][f] = ot[ef][f] * scl;
        }
        mrun[f] = mn;
        lsum[f] += ps;
      }
      s16x8 pf[2][2];
#pragma unroll
      for (int step = 0; step < 2; ++step)
#pragma unroll
        for (int f = 0; f < 2; ++f) {
          const uint2 a = pack4(st[2 * step][f]), bq = pack4(st[2 * step + 1][f]);
          pf[step][f] = __builtin_bit_cast(s16x8, make_uint4(a.x, a.y, bq.x, bq.y));
        }
      __builtin_amdgcn_sched_barrier(0);
#pragma unroll
      for (int step = 0; step < 2; ++step) {
        if (step == 1 && !full) break;
        s16x8 vf[8];
#pragma unroll
        for (int ef = 0; ef < 8; ++ef) {
          const char* vp = lds + 16384 + (ef * 16 + li) * 144 + (step * 32 + g * 4) * 2;
          const uint2 a = *(const uint2*)vp, bq = *(const uint2*)(vp + 32);
          vf[ef] = __builtin_bit_cast(s16x8, make_uint4(a.x, a.y, bq.x, bq.y));
        }
#pragma unroll
        for (int ef = 0; ef < 8; ++ef) {
          ot[ef][0] = __builtin_amdgcn_mfma_f32_16x16x32_bf16(vf[ef], pf[step][0], ot[ef][0], 0, 0, 0);
          ot[ef][1] = __builtin_amdgcn_mfma_f32_16x16x32_bf16(vf[ef], pf[step][1], ot[ef][1], 0, 0, 0);
        }
        __builtin_amdgcn_sched_barrier(0);
      }
    }
    float inv[2];
#pragma unroll
    for (int f = 0; f < 2; ++f) { float lt = lsum[f]; lt += __shfl_xor(lt, 16); lt += __shfl_xor(lt, 32); inv[f] = 1.0f / lt; }
    if (samp) {
      if (qh == 0) {
        float* pr = (float*)slot(p, 9) + ((size_t)((((b * 8 + h) * 8 + sp) * 2 + c) * 16 + li)) * 132;
#pragma unroll
        for (int ef = 0; ef < 8; ++ef) st4(pr + ef * 16 + g * 4, ot[ef][0]);
        if (g == 0) { pr[128] = mrun[0]; pr[129] = 1.0f / inv[0]; }
      }
      continue;
    }
    __syncthreads();
    float* comb = (float*)lds;
    if (c == 1) {
#pragma unroll
      for (int ef = 0; ef < 8; ++ef)
#pragma unroll
        for (int f = 0; f < 2; ++f)
#pragma unroll
          for (int r = 0; r < 4; ++r) comb[(((qh * 8 + ef) * 2 + f) * 4 + r) * 64 + l] = ot[ef][f][r] * inv[f] * lam;
    }
    __syncthreads();
    if (c == 0) {
#pragma unroll
      for (int f = 0; f < 2; ++f) {
        float ss = 0.f;
#pragma unroll
        for (int ef = 0; ef < 8; ++ef)
#pragma unroll
          for (int r = 0; r < 4; ++r) { const float o = ot[ef][f][r] * inv[f] - comb[(((qh * 8 + ef) * 2 + f) * 4 + r) * 64 + l]; ot[ef][f][r] = o; ss = fmaf(o, o, ss); }
        ss += __shfl_xor(ss, 16); ss += __shfl_xor(ss, 32);
        const float rs = rsqrtf(ss * (1.0f / 128.0f) + 1e-5f) * 0.6444909324090307f;
        const int qi = qh * 32 + f * 16 + li;
        if (qi < nq) {
#pragma unroll
          for (int ef = 0; ef < 8; ++ef) {
            const int e = ef * 16 + g * 4;
            const f32x4 g4 = ld4(sg + e);
            *(uint2*)(Ob + (size_t)(qtok0 + qi) * 1024 + h * 128 + e) = pack4(ot[ef][f] * rs * g4);
          }
        }
      }
    }
  }
}

__device__ __forceinline__ void phase_attn_combine(KP p) {
  const int l = threadIdx.x & 63, w = threadIdx.x >> 6;
  const float* lp = p->in[24];
  const float s1 = wave_sum(lp[l] * lp[64 + l]), s2 = wave_sum(lp[128 + l] * lp[192 + l]);
  const float lam = __expf(s1) - __expf(s2) + 0.35550906759f;
  const float* sg = p->in[25];
  bf16* Ob = (bf16*)slot(p, 8);
  for (int row = blockIdx.x * 4 + w; row < 2048; row += gridDim.x * 4) {
    const int q = row & 15, bh = row >> 4;
    float o2[2][2];
#pragma unroll
    for (int c = 0; c < 2; ++c) {
      float m[8], M = -INFINITY;
#pragma unroll
      for (int sp = 0; sp < 8; ++sp) { m[sp] = ((const float*)slot(p, 9))[((size_t)(((bh * 8 + sp) * 2 + c) * 16 + q)) * 132 + 128]; M = fmaxf(M, m[sp]); }
      float L = 0.f, a0 = 0.f, a1 = 0.f;
#pragma unroll
      for (int sp = 0; sp < 8; ++sp) {
        const float* pr = (const float*)slot(p, 9) + ((size_t)(((bh * 8 + sp) * 2 + c) * 16 + q)) * 132;
        const float wg = __builtin_amdgcn_exp2f(m[sp] - M);
        L = fmaf(wg, pr[129], L);
        const float2 ov = *(const float2*)(pr + l * 2);
        a0 = fmaf(wg, ov.x, a0); a1 = fmaf(wg, ov.y, a1);
      }
      o2[c][0] = a0 / L; o2[c][1] = a1 / L;
    }
    const float x0 = o2[0][0] - lam * o2[1][0], x1 = o2[0][1] - lam * o2[1][1];
    const float ss = wave_sum(x0 * x0 + x1 * x1);
    const float rs = rsqrtf(ss * (1.0f / 128.0f) + 1e-5f) * 0.6444909324090307f;
    const int b = bh >> 3, h = bh & 7;
    *(unsigned*)(Ob + (size_t)(NTP + b * 16 + q) * 1024 + h * 128 + l * 2) = pack2(x0 * rs * sg[l * 2], x1 * rs * sg[l * 2 + 1]);
  }
}

__global__ void __launch_bounds__(256, 2) yoco_mega(Params p) {
  __shared__ __attribute__((aligned(16))) char lds[65536];
  cg::grid_group grid = cg::this_grid();
  KP kp = (KP)__builtin_amdgcn_kernarg_segment_ptr();
#define FRESH() ({ KP q_ = kp; asm volatile("" : "+s"(q_)); q_; })
  phase0(FRESH());
  grid.sync();
  XcdBar xb; xb.bar = (unsigned*)(FRESH()->ws + O_BAR); xb.x = xb_xcc_id(); xb.nloc = 1u; xb.nx = 1u;
  if (threadIdx.x == 0) (void)xb_add(&xb.bar[XB_XCNT(xb.x)], 1u);
  if (threadIdx.x < 64) {
    unsigned nl = 1u, nxx = 1u;
    xcd_census(xb.bar, xb.x, nl, nxx);
    xb.nloc = (unsigned)__builtin_amdgcn_readfirstlane((int)nl); xb.nx = (unsigned)__builtin_amdgcn_readfirstlane((int)nxx);
  }
  phase_gemm<1>(FRESH(), lds); xcd_barrier(xb);
  phase_gemm<2>(FRESH(), lds); xcd_barrier(xb);
  phase_scan(FRESH(), lds); xcd_barrier(xb);
  phase_gemm<4>(FRESH(), lds); xcd_barrier(xb);
  { KP p = FRESH(); phase_ln(p, (const bf16*)slot(p, 0), (float*)slot(p, 2), (bf16*)slot(p, 5), p->in[27], p->in[28]); } xcd_barrier(xb);
  phase_gemm<6>(FRESH(), lds); xcd_barrier(xb);
  phase_peer_experts(FRESH(), 0); xcd_barrier(xb);
  phase_gemm<8>(FRESH(), lds); xcd_barrier(xb);
  phase_attn(FRESH(), lds); xcd_barrier(xb);
  phase_attn_combine(FRESH()); xcd_barrier(xb);
  phase_gemm<10>(FRESH(), lds); xcd_barrier(xb);
  { KP p = FRESH(); phase_ln(p, (const bf16*)slot(p, 2), (float*)slot(p, 0), (bf16*)slot(p, 4), p->in[27] + 1024, p->in[28] + 1024); } xcd_barrier(xb);
  phase_gemm<12>(FRESH(), lds); xcd_barrier(xb);
  phase_peer_experts(FRESH(), 1);
}

extern "C" void kernel_launch(void* const* d_in, const int* in_sizes, int n_in, void* d_out, int out_size,
                              void* d_ws, size_t ws_size, hipStream_t stream) {
  static int grid_blocks = 0;
  if (!grid_blocks) {
    int dev = 0, cus = 0, per_cu = 0;
    hipGetDevice(&dev);
    hipDeviceGetAttribute(&cus, hipDeviceAttributeMultiprocessorCount, dev);
    hipOccupancyMaxActiveBlocksPerMultiprocessor(&per_cu, (const void*)yoco_mega, 256, 0);
    if (per_cu > 2) per_cu = 2;
    if (per_cu < 1) per_cu = 1;
    grid_blocks = cus * per_cu;
  }
  if (ws_size < WS_NEED) { fprintf(stderr, "workspace too small: %zu < %zu\n", ws_size, (size_t)WS_NEED); return; }
  Params p{};
  for (int i = 0; i < 35; ++i) p.in[i] = (const float*)d_in[i];
  p.out = (float*)d_out;
  p.ws = (char*)d_ws;
  void* args[] = {&p};
  hipError_t e = hipLaunchCooperativeKernel((const void*)yoco_mega, dim3(grid_blocks), dim3(256), args, 0, stream);
  if (e != hipSuccess) fprintf(stderr, "cooperative launch failed: %s (grid %d)\n", hipGetErrorString(e), grid_blocks);
}
```

```cpp
#include <hip/hip_runtime.h>
#include <hip/hip_cooperative_groups.h>
#include <stdio.h>
namespace cg = cooperative_groups;

typedef unsigned short bf16;
typedef __attribute__((ext_vector_type(8))) short s16x8;
typedef __attribute__((ext_vector_type(4))) float f32x4;

constexpr int NTP = 32768, NT = 33024;
constexpr int REP_GEMM = 1, REP_PE = 1, REP_SCAN = 1, REP_ATTN = 1, REP_P0 = 1;
constexpr size_t U = (size_t)NT * 1024 * 2;

constexpr size_t O_WRKV = 0;
constexpr size_t O_WL1  = O_WRKV + 3 * 2097152;
constexpr size_t O_W2T  = O_WL1 + 524288;
constexpr size_t O_A2T  = O_W2T + 131072;
constexpr size_t O_G2T  = O_A2T + 131072;
constexpr size_t O_WOUT = O_G2T + 262144;
constexpr size_t O_WKV  = O_WOUT + 2097152;
constexpr size_t O_WQ   = O_WKV + 4194304;
constexpr size_t O_WO   = O_WQ + 2097152;
constexpr size_t O_WPQ  = O_WO + 2097152;
constexpr size_t O_SK   = O_WPQ + 2 * 4194304;
constexpr size_t O_PU   = O_SK + 131072;
constexpr size_t O_PV   = O_PU + 16777216;
constexpr size_t O_SU   = O_PV + 16777216;
constexpr size_t O_SV   = O_SU + 131072;
constexpr size_t O_CNT  = O_SV + 131072;
constexpr size_t O_BAR  = O_CNT + 256;
constexpr size_t O_CUT  = O_BAR + 16384;
constexpr size_t O_SLOT = O_CUT + 16384;
constexpr size_t WS_NEED = O_SLOT + 10 * U;

constexpr size_t OFF_YP = 0, OFF_YS = 33554432, OFF_WKVP = 33816576, OFF_SHP = 34865152,
                 OFF_CKP = 34881536, OFF_CVP = 68435968, OFF_WKVS = 101990400, OFF_SHS = 103038976,
                 OFF_CKS = 103055360, OFF_CVS = 103317504;

struct Params {
  const float* in[35];
  float* out;
  char* ws;
};
typedef const Params __attribute__((address_space(4)))* KP;

__device__ const unsigned char CAND[64] = {0, 1, 2, 3, 4, 5, 6, 7, 8, 9, 10, 11, 12, 13, 14, 15, 16, 17, 18, 19, 20, 21, 22, 23, 32, 33, 34, 35, 36, 48, 49, 50, 51, 64, 65, 66, 80, 81, 96, 97, 112, 113, 128, 144, 160, 176, 192, 208, 224, 240, 255, 255, 255, 255, 255, 255, 255, 255, 255, 255, 255, 255, 255, 255};

__device__ __forceinline__ char* slot(KP p, int i) { return p->ws + O_SLOT + (size_t)i * U; }
__device__ __forceinline__ bf16 f2b(float f) { unsigned u = __float_as_uint(f); u += 0x7fffu + ((u >> 16) & 1u); return (bf16)(u >> 16); }
typedef float f32x2 __attribute__((ext_vector_type(2)));
typedef __bf16 bf16x2_t __attribute__((ext_vector_type(2)));
__device__ __forceinline__ unsigned pack2(float a, float b) {
  const f32x2 v = {a, b};
  return __builtin_bit_cast(unsigned, __builtin_convertvector(v, bf16x2_t));
}
__device__ __forceinline__ float blo(unsigned u) { return __uint_as_float(u << 16); }
__device__ __forceinline__ float bhi(unsigned u) { return __uint_as_float(u & 0xffff0000u); }
__device__ __forceinline__ uint2 pack4(f32x4 v) { return make_uint2(pack2(v[0], v[1]), pack2(v[2], v[3])); }
__device__ __forceinline__ f32x4 unpack4(uint2 u) { f32x4 r; r[0] = blo(u.x); r[1] = bhi(u.x); r[2] = blo(u.y); r[3] = bhi(u.y); return r; }
__device__ __forceinline__ f32x4 ld4(const float* p) { float4 t = *(const float4*)p; f32x4 r; r[0] = t.x; r[1] = t.y; r[2] = t.z; r[3] = t.w; return r; }
__device__ __forceinline__ void st4(float* p, f32x4 v) { *(float4*)p = make_float4(v[0], v[1], v[2], v[3]); }

template <int CTRL> __device__ __forceinline__ float dppf(float v) {
  return __builtin_bit_cast(float, __builtin_amdgcn_mov_dpp(__builtin_bit_cast(int, v), CTRL, 0xf, 0xf, true));
}
template <int CTRL> __device__ __forceinline__ unsigned dppu(unsigned v) {
  return (unsigned)__builtin_amdgcn_mov_dpp((int)v, CTRL, 0xf, 0xf, true);
}
__device__ __forceinline__ float oct_sum(float v) { v += dppf<0xB1>(v); v += dppf<0x4E>(v); v += dppf<0x141>(v); return v; }
__device__ __forceinline__ float row_sum(float v) { v = oct_sum(v); v += dppf<0x140>(v); return v; }
__device__ __forceinline__ float row_max(float v) {
  v = fmaxf(v, dppf<0xB1>(v)); v = fmaxf(v, dppf<0x4E>(v)); v = fmaxf(v, dppf<0x141>(v)); v = fmaxf(v, dppf<0x140>(v)); return v;
}
__device__ __forceinline__ unsigned umx(unsigned a, unsigned b) { return a > b ? a : b; }
__device__ __forceinline__ unsigned row_umax(unsigned v) {
  v = umx(v, dppu<0xB1>(v)); v = umx(v, dppu<0x4E>(v)); v = umx(v, dppu<0x141>(v)); v = umx(v, dppu<0x140>(v)); return v;
}
__device__ __forceinline__ float wave_sum(float v) { v = row_sum(v); v += __shfl_xor(v, 16); v += __shfl_xor(v, 32); return v; }
__device__ __forceinline__ unsigned f2ord(float f) { unsigned u = __float_as_uint(f); return (u & 0x80000000u) ? ~u : (u | 0x80000000u); }
__device__ __forceinline__ float ord2f(unsigned o) { unsigned u = (o & 0x80000000u) ? (o & 0x7fffffffu) : ~o; return __uint_as_float(u); }
__device__ __forceinline__ const float* xin(KP p, int m) {
  return m < NTP ? p->in[0] + (size_t)m * 1024 : p->in[1] + (size_t)(m - NTP) * 1024;
}

__device__ __forceinline__ int swz(int row, int slot) { const int q = (row >> 2) & 3; return row * 64 + ((slot ^ (q ^ ((q & 1) << 1))) << 4); }

typedef unsigned u32x4_t __attribute__((ext_vector_type(4)));
__device__ __forceinline__ uint4 ldnt(const void* p) { const u32x4_t v = __builtin_nontemporal_load((const u32x4_t*)p); return make_uint4(v.x, v.y, v.z, v.w); }

__device__ __forceinline__ int otid() { int t = threadIdx.x; asm volatile("" : "+v"(t)); return t; }

#define XB_TMO      128
#define XB_XCNT(j)  (256  + 64 * (j))
#define XB_XSUB(j)  (1280 + 64 * (j))
#define XB_XGEN(j)  (2304 + 64 * (j))
#define XB_TOP      3328
#define XB_TOPGEN   3392
#define XCD_BAR_WORDS 3456
#define XB_SPIN_CAP (1u << 20)
__device__ __forceinline__ unsigned xb_ld(unsigned* p) { return __hip_atomic_load(p, __ATOMIC_RELAXED, __HIP_MEMORY_SCOPE_AGENT); }
__device__ __forceinline__ unsigned xb_add(unsigned* p, unsigned v) { return __hip_atomic_fetch_add(p, v, __ATOMIC_RELAXED, __HIP_MEMORY_SCOPE_AGENT); }
__device__ __forceinline__ unsigned xb_xcc_id() { return (unsigned)__builtin_amdgcn_s_getreg((3 << 11) | 20) & 0xFu; }
#define XB_SPIN(cond, bar) do { unsigned _sp = 0; while (cond) { __builtin_amdgcn_s_sleep(1); \
    if ((++_sp & 255u) == 0u) { if (xb_ld(&(bar)[XB_TMO])) break; if (_sp > XB_SPIN_CAP) { atomicAdd(&(bar)[XB_TMO], 1u); break; } } } } while (0)
struct XcdBar { unsigned* bar; unsigned x, nloc, nx; };
__device__ __forceinline__ void xcd_census(unsigned* bar, unsigned x, unsigned& nloc, unsigned& nx) {
  const unsigned G = gridDim.x;
  unsigned sum, cnt, mine, sp = 0u;
  for (;;) {
    sum = 0u; cnt = 0u; mine = 0u;
#pragma unroll
    for (unsigned j = 0; j < 16; ++j) { const unsigned c = xb_ld(&bar[XB_XCNT(j)]); sum += c; cnt += (c > 0u) ? 1u : 0u; mine = (j == x) ? c : mine; }
    if (sum == G) break;
    __builtin_amdgcn_s_sleep(1);
    if ((++sp & 255u) == 0u) { if (xb_ld(&bar[XB_TMO])) break; if (sp > XB_SPIN_CAP) { atomicAdd(&bar[XB_TMO], 1u); break; } }
  }
  nloc = mine > 0u ? mine : 1u; nx = cnt > 0u ? cnt : 1u;
}
__device__ __forceinline__ void xcd_barrier(XcdBar& b) {
  asm volatile("s_waitcnt vmcnt(0)" ::: "memory");
  __syncthreads();
  if (threadIdx.x == 0) {
    unsigned* bar = b.bar;
    __builtin_amdgcn_s_waitcnt(0);
    const unsigned nloc = b.nloc, nx = b.nx;
    const unsigned old = xb_add(&bar[XB_XSUB(b.x)], 1u);
    const unsigned gen = old / nloc;
    if (old + 1u == (gen + 1u) * nloc) {
      __builtin_amdgcn_fence(__ATOMIC_RELEASE, "agent");
      asm volatile("s_waitcnt vmcnt(0)" ::: "memory");
      const unsigned og = xb_add(&bar[XB_TOP], 1u);
      const unsigned tg = og / nx;
      if (og + 1u == (tg + 1u) * nx) xb_add(&bar[XB_TOPGEN], 1u);
      else XB_SPIN(xb_ld(&bar[XB_TOPGEN]) == tg, bar);
      __builtin_amdgcn_fence(__ATOMIC_ACQUIRE, "agent");
      xb_add(&bar[XB_XGEN(b.x)], 1u);
      asm volatile("s_waitcnt vmcnt(0)" ::: "memory");
    } else {
      XB_SPIN(xb_ld(&bar[XB_XGEN(b.x)]) == gen, bar);
      __builtin_amdgcn_fence(__ATOMIC_ACQUIRE, "agent");
      asm volatile("s_waitcnt vmcnt(0)" ::: "memory");
    }
  }
  __syncthreads();
}

__device__ __forceinline__ void transpose_cvt(const float* __restrict__ W, bf16* __restrict__ WT, int K, int N, int gtid, int gsz) {
  const int items = (K >> 3) * N;
  for (int it = gtid; it < items; it += gsz) {
    const int n = it % N, kb = it / N;
    const float* src = W + (size_t)(kb * 8) * N + n;
    uint4 o;
    o.x = pack2(src[0], src[(size_t)N]);
    o.y = pack2(src[(size_t)2 * N], src[(size_t)3 * N]);
    o.z = pack2(src[(size_t)4 * N], src[(size_t)5 * N]);
    o.w = pack2(src[(size_t)6 * N], src[(size_t)7 * N]);
    *(uint4*)(WT + (size_t)n * K + kb * 8) = o;
  }
}
__device__ __forceinline__ void plain_cvt(const float* __restrict__ S, bf16* __restrict__ D, size_t n8, int gtid, int gsz) {
  for (size_t it = gtid; it < n8; it += gsz) {
    const float4 a = *(const float4*)(S + it * 8), b = *(const float4*)(S + it * 8 + 4);
    uint4 o; o.x = pack2(a.x, a.y); o.y = pack2(a.z, a.w); o.z = pack2(b.x, b.y); o.w = pack2(b.z, b.w);
    *(uint4*)(D + it * 8) = o;
  }
}
__device__ __forceinline__ void quant_rows(KP p, int r0) {
  char* ws = p->ws;
  {
    const int l = threadIdx.x & 63;
    for (int r = r0 + (threadIdx.x >> 6); r < r0 + 64; r += 4) {
      const int tbl = r >> 15, rr = r & 32767;
      const float* src = (tbl ? p->in[34] : p->in[33]) + (size_t)rr * 1024 + l * 16;
      f32x4 x[4];
#pragma unroll
      for (int i = 0; i < 4; ++i) { const uint4 t_ = ldnt(src + i * 4); x[i] = f32x4{__uint_as_float(t_.x), __uint_as_float(t_.y), __uint_as_float(t_.z), __uint_as_float(t_.w)}; }
      float am = 0.f;
#pragma unroll
      for (int i = 0; i < 4; ++i)
#pragma unroll
        for (int j = 0; j < 4; ++j) am = fmaxf(am, fabsf(x[i][j]));
      am = row_max(am); am = fmaxf(am, __shfl_xor(am, 16)); am = fmaxf(am, __shfl_xor(am, 32));
      if (tbl) {
        float ssq = 0.f;
#pragma unroll
        for (int i = 0; i < 4; ++i)
#pragma unroll
          for (int j = 0; j < 4; ++j) ssq = fmaf(x[i][j], x[i][j], ssq);
        const float clipv = fminf(am, 2.75f * sqrtf(wave_sum(ssq) * (1.0f / 1024.0f)));
        const float inv = clipv > 0.f ? 7.5f / clipv : 0.f;
        unsigned o[2] = {0u, 0u};
#pragma unroll
        for (int i = 0; i < 4; ++i)
#pragma unroll
          for (int j = 0; j < 4; ++j) {
            int q = (int)floorf(x[i][j] * inv + 8.0f); q = q < 0 ? 0 : (q > 15 ? 15 : q);
            const int e = i * 4 + j;
            o[e >> 3] |= (unsigned)q << (4 * (e & 7));
          }
        *(uint2*)((unsigned char*)(ws + O_PV) + (size_t)rr * 512 + l * 8) = make_uint2(o[0], o[1]);
        if (l == 0) ((float*)(ws + O_SV))[rr] = clipv > 0.f ? clipv / 7.5f : 1.0f;
      } else {
        float ssq = 0.f;
#pragma unroll
        for (int i = 0; i < 4; ++i)
#pragma unroll
          for (int j = 0; j < 4; ++j) ssq = fmaf(x[i][j], x[i][j], ssq);
        const float clipv = fminf(am, 2.75f * sqrtf(wave_sum(ssq) * (1.0f / 1024.0f)));
        const float inv = clipv > 0.f ? 7.5f / clipv : 0.f;
        unsigned o[2] = {0u, 0u};
#pragma unroll
        for (int i = 0; i < 4; ++i)
#pragma unroll
          for (int j = 0; j < 4; ++j) {
            int q = (int)floorf(x[i][j] * inv + 8.0f); q = q < 0 ? 0 : (q > 15 ? 15 : q);
            const int e = i * 4 + j;
            o[e >> 3] |= (unsigned)q << (4 * (e & 7));
          }
        *(uint2*)((unsigned char*)(ws + O_PU) + (size_t)rr * 512 + l * 8) = make_uint2(o[0], o[1]);
        if (l == 0) ((float*)(ws + O_SU))[rr] = clipv > 0.f ? clipv / 7.5f : 1.0f;
      }
    }
  }
}

__device__ __forceinline__ void phase0(KP p) {
  const int gtid = blockIdx.x * 256 + threadIdx.x, gsz = gridDim.x * 256;
  char* ws = p->ws;
  for (int rep0 = 0; rep0 < REP_P0; ++rep0) {
  if (gtid < 64) ((int*)(ws + O_CNT))[gtid] = 0;
  if (gtid < 4096) ((int*)(ws + O_CUT))[gtid] = 0;
  if (blockIdx.x == 0) for (int i = threadIdx.x; i < XCD_BAR_WORDS; i += 256) ((unsigned*)(ws + O_BAR))[i] = 0u;
  for (int g = 0; g < 3; ++g) transpose_cvt(p->in[7] + (size_t)g * 1048576, (bf16*)(ws + O_WRKV) + (size_t)g * 1048576, 1024, 1024, gtid, gsz);
  transpose_cvt(p->in[9],  (bf16*)(ws + O_WL1), 1024, 64, gtid, gsz);
  transpose_cvt(p->in[12], (bf16*)(ws + O_WL1) + 64 * 1024, 1024, 64, gtid, gsz);
  transpose_cvt(p->in[14], (bf16*)(ws + O_WL1) + 128 * 1024, 1024, 128, gtid, gsz);
  transpose_cvt(p->in[10], (bf16*)(ws + O_W2T), 64, 1024, gtid, gsz);
  transpose_cvt(p->in[13], (bf16*)(ws + O_A2T), 64, 1024, gtid, gsz);
  transpose_cvt(p->in[15], (bf16*)(ws + O_G2T), 128, 1024, gtid, gsz);
  transpose_cvt(p->in[21], (bf16*)(ws + O_WOUT), 1024, 1024, gtid, gsz);
  transpose_cvt(p->in[22], (bf16*)(ws + O_WKV), 1024, 2048, gtid, gsz);
  transpose_cvt(p->in[23], (bf16*)(ws + O_WQ), 1024, 1024, gtid, gsz);
  transpose_cvt(p->in[26], (bf16*)(ws + O_WO), 1024, 1024, gtid, gsz);
  for (int g = 0; g < 2; ++g) transpose_cvt(p->in[31] + (size_t)g * 2097152, (bf16*)(ws + O_WPQ) + (size_t)g * 2097152, 1024, 2048, gtid, gsz);
  plain_cvt(p->in[32], (bf16*)(ws + O_SK), 65536 / 8, gtid, gsz);
  const float* mu = p->in[6];
  for (int it = gtid; it < NT * 128; it += gsz) {
    const int m = it >> 7, c8 = (it & 127) * 8;
    const float* xr = xin(p, m) + c8;
    const float* pr = nullptr; bool last; float* sho;
    if (m < NTP) { const int t = m & 2047; if (t) pr = xr - 1024; last = (t == 2047); sho = p->out + OFF_SHP + (size_t)(m >> 11) * 1024 + c8; }
    else { const int ms = m - NTP, t = ms & 15; pr = t ? xr - 1024 : p->in[3] + (size_t)(ms >> 4) * 1024 + c8; last = (t == 15); sho = p->out + OFF_SHS + (size_t)(ms >> 4) * 1024 + c8; }
    const f32x4 x0 = ld4(xr), x1 = ld4(xr + 4);
    f32x4 d0, d1;
    if (pr) { d0 = ld4(pr) - x0; d1 = ld4(pr + 4) - x1; } else { d0 = -x0; d1 = -x1; }
    if (last) { st4(sho, x0); st4(sho + 4, x1); }
#pragma unroll
    for (int i = 0; i < 6; ++i) {
      const f32x4 m0 = ld4(mu + i * 1024 + c8), m1 = ld4(mu + i * 1024 + c8 + 4);
      const f32x4 a = x0 + d0 * m0, b = x1 + d1 * m1;
      const uint2 pa = pack4(a), pb = pack4(b);
      *(uint4*)((bf16*)slot(p, i) + (size_t)m * 1024 + c8) = make_uint4(pa.x, pa.y, pb.x, pb.y);
    }
  }
  }
}

struct Job { const bf16* A; const bf16* B; int lda, ldb, K, nmax, mode, m0, n0, aux; };

__device__ __forceinline__ void get_job(KP p, int ph, int id, Job& j) {
  char* ws = p->ws;
  j.lda = 1024; j.ldb = 1024; j.K = 1024; j.nmax = 1 << 30; j.aux = 0;
  if (ph == 1) {
    if (id < 6192) { const int g = id / 2064, r = id % 2064; j.A = (const bf16*)slot(p, g); j.B = (const bf16*)(ws + O_WRKV) + (size_t)g * 1048576; j.mode = 0; j.aux = g; j.m0 = (r >> 3) * 128; j.n0 = (r & 7) * 128; }
    else { const int q = id - 6192, g = q / 258; j.A = (const bf16*)slot(p, 3 + g); j.B = (const bf16*)(ws + O_WL1) + (size_t)g * 65536; j.nmax = (g == 2) ? 128 : 64; j.mode = 1; j.aux = g; j.m0 = (q % 258) * 128; j.n0 = 0; }
  } else if (ph == 2) {
    const int g = id / 2064, r = id % 2064; j.m0 = (r >> 3) * 128; j.n0 = (r & 7) * 128; j.lda = 256; j.mode = 2 + g;
    if (g == 0) { j.A = (const bf16*)slot(p, 9); j.B = (const bf16*)(ws + O_W2T); j.K = 64; j.ldb = 64; }
    else if (g == 1) { j.A = (const bf16*)slot(p, 9) + 64; j.B = (const bf16*)(ws + O_A2T); j.K = 64; j.ldb = 64; }
    else { j.A = (const bf16*)slot(p, 9) + 128; j.B = (const bf16*)(ws + O_G2T); j.K = 128; j.ldb = 128; }
  } else if (ph == 4) {
    j.A = (const bf16*)slot(p, 4); j.B = (const bf16*)(ws + O_WOUT); j.mode = 5; j.m0 = (id >> 3) * 128; j.n0 = (id & 7) * 128;
  } else if (ph == 6 || ph == 12) {
    const int layer = (ph == 12); j.aux = layer;
    j.A = (const bf16*)slot(p, layer ? 4 : 5); j.B = (const bf16*)(ws + O_WPQ) + (size_t)layer * 2097152; j.mode = 6; j.m0 = (id >> 4) * 128; j.n0 = (id & 15) * 128;
  } else if (ph == 8) {
    j.A = (const bf16*)slot(p, 4);
    if (id < 4128) { j.B = (const bf16*)(ws + O_WKV); j.mode = 7; j.m0 = (id >> 4) * 128; j.n0 = (id & 15) * 128; }
    else { const int q = id - 4128; j.B = (const bf16*)(ws + O_WQ); j.mode = 8; j.m0 = (q >> 3) * 128; j.n0 = (q & 7) * 128; }
  } else {
    j.A = (const bf16*)slot(p, 8); j.B = (const bf16*)(ws + O_WO); j.mode = 9; j.m0 = (id >> 3) * 128; j.n0 = (id & 7) * 128;
  }
}

__device__ __forceinline__ f32x4 rope4(f32x4 v, int m, int l) {
  const int pos = (m < NTP) ? (m & 2047) : (4096 + ((m - NTP) & 15));
  const int g = l >> 4; const bool t2 = g >= 2; const int fb = (g & 1) * 4;
  f32x4 o;
#pragma unroll
  for (int r = 0; r < 4; ++r) {
    const float inv = exp2f(-(float)(fb + r) * (18.931568569324174f * 0.125f));
    const float ang = (float)pos * inv;
    float rev = ang * 0.15915494309189535f; rev -= rintf(rev);
    const float s = __builtin_amdgcn_sinf(rev), c = __builtin_amdgcn_cosf(rev);
    const float pr = __shfl_xor(v[r], 32);
    o[r] = v[r] * c + (t2 ? pr * s : -pr * s);
  }
  return o;
}

template <int MODE>
__device__ __forceinline__ void epilogue(KP p, const Job& jb, int m, int n, f32x4 v, int l) {
  const size_t mi = (size_t)m * 1024 + n;
  switch (MODE) {
    case 0: *(uint2*)((bf16*)slot(p, 6 + jb.aux) + mi) = pack4(v); break;
    case 1: if (n < jb.nmax) {
        f32x4 o;
#pragma unroll
        for (int r = 0; r < 4; ++r) o[r] = jb.aux == 0 ? 1.0f - 2.0f / (1.0f + __expf(2.0f * v[r])) : (jb.aux == 1 ? v[r] : 1.0f / (1.0f + __expf(-v[r])));
        *(uint2*)((bf16*)slot(p, 9) + (size_t)m * 256 + jb.aux * 64 + n) = pack4(o);
      } break;
    case 2: {
        const f32x4 w0 = ld4(p->in[8] + n); f32x4 o;
#pragma unroll
        for (int r = 0; r < 4; ++r) { const float z = w0[r] + v[r]; const float sp = __logf(1.0f + __expf(-z)); o[r] = __expf(-__expf(-sp - 0.5f)); }
        st4((float*)slot(p, 0) + mi, o);
      } break;
    case 3: {
        const f32x4 a0 = ld4(p->in[11] + n); f32x4 o;
#pragma unroll
        for (int r = 0; r < 4; ++r) o[r] = 1.0f / (1.0f + __expf(-(a0[r] + v[r])));
        *(uint2*)((bf16*)slot(p, 2) + mi) = pack4(o);
      } break;
    case 4: *(uint2*)((bf16*)slot(p, 3) + mi) = pack4(v); break;
    case 5: { const f32x4 x = ld4(xin(p, m) + n); *(uint2*)((bf16*)slot(p, 0) + mi) = pack4(x * 1.4142135623730951f + v); } break;
    case 9: { const f32x4 x = unpack4(*(const uint2*)((const bf16*)slot(p, 4) + mi)); *(uint2*)((bf16*)slot(p, 2) + mi) = pack4(x * 1.4142135623730951f + v); } break;
    case 7: {
        if (n < 1024) {
          if ((n & 63) < 16) v = rope4(v, m, l);
          float* o = (m < NTP) ? p->out + OFF_CKP + mi : p->out + OFF_CKS + (size_t)(m - NTP) * 1024 + n;
          st4(o, v);
          *(uint2*)((bf16*)slot(p, 5) + mi) = pack4(v);
        } else {
          const int n2 = n - 1024, h = n2 >> 7, e = n2 & 127;
          float* o = (m < NTP) ? p->out + OFF_CVP + (size_t)m * 1024 + n2 : p->out + OFF_CVS + (size_t)(m - NTP) * 1024 + n2;
          st4(o, v);
          bf16* vt = (bf16*)slot(p, 6);
          if (m < NTP) { const int s = m >> 11, t = m & 2047;
#pragma unroll
            for (int r = 0; r < 4; ++r) vt[((size_t)((s * 8 + h) * 128 + e + r)) * 2048 + t] = f2b(v[r]);
          } else { const int ms = m - NTP, b = ms >> 4, t = ms & 15;
#pragma unroll
            for (int r = 0; r < 4; ++r) vt[(size_t)33554432 + ((size_t)((b * 8 + h) * 128 + e + r)) * 16 + t] = f2b(v[r]);
          }
        }
      } break;
    case 8: {
        if ((n & 63) < 16) v = rope4(v, m, l);
        *(uint2*)((bf16*)slot(p, 7) + mi) = pack4(v * 0.18033688011112042f);
      } break;
    default: break;
  }
}

__device__ __forceinline__ void peer_tail(KP p, const Job& jb, f32x4 (&acc)[4][4], char* lds, int tid) {
  const int l = tid & 63, w = tid >> 6, wm = w & 1, wn = w >> 1, g = l >> 4, li = l & 15;
#pragma unroll
  for (int j = 0; j < 4; ++j)
#pragma unroll
    for (int i = 0; i < 4; ++i) {
      const int d0 = wn * 64 + j * 16 + g * 4, tok = wm * 64 + i * 16 + li;
      *(uint2*)(lds + (d0 >> 5) * 8192 + swz(tok, (d0 & 31) >> 3) + ((d0 & 7) * 2)) = pack4(acc[j][i]);
    }
  __syncthreads();
  f32x4 sc[4][4];
#pragma unroll
  for (int j = 0; j < 4; ++j)
#pragma unroll
    for (int i = 0; i < 4; ++i) sc[j][i] = f32x4{0.f, 0.f, 0.f, 0.f};
#pragma unroll
  for (int ks = 0; ks < 4; ++ks) {
    s16x8 kf[4], qf[4];
#pragma unroll
    for (int j = 0; j < 4; ++j) kf[j] = *(const s16x8*)(lds + 32768 + ks * 8192 + swz(wn * 64 + j * 16 + li, g));
#pragma unroll
    for (int i = 0; i < 4; ++i) qf[i] = *(const s16x8*)(lds + ks * 8192 + swz(wm * 64 + i * 16 + li, g));
#pragma unroll
    for (int j = 0; j < 4; ++j)
#pragma unroll
      for (int i = 0; i < 4; ++i) sc[j][i] = __builtin_amdgcn_mfma_f32_16x16x32_bf16(kf[j], qf[i], sc[j][i], 0, 0, 0);
    __builtin_amdgcn_sched_barrier(0);
  }
  __syncthreads();
  unsigned* tko = (unsigned*)slot(p, jb.aux ? 5 : 6);
  const int nt = jb.n0 >> 7;
#pragma unroll 1
  for (int hm = 0; hm < 2; ++hm) {
    if (wm == hm) {
#pragma unroll
      for (int j = 0; j < 4; ++j)
#pragma unroll
        for (int i = 0; i < 4; ++i) {
          const int key0 = wn * 64 + j * 16 + g * 4, tokl = i * 16 + li;
          uint4 o;
          o.x = (f2ord(sc[j][i][0]) & ~127u) | (unsigned)(127 - key0);
          o.y = (f2ord(sc[j][i][1]) & ~127u) | (unsigned)(126 - key0);
          o.z = (f2ord(sc[j][i][2]) & ~127u) | (unsigned)(125 - key0);
          o.w = (f2ord(sc[j][i][3]) & ~127u) | (unsigned)(124 - key0);
          *(uint4*)(lds + (tokl * 132 + key0) * 4) = o;
        }
    }
    __syncthreads();
#pragma unroll 1
    for (int pass = 0; pass < 4; ++pass) {
      int tq = tid; asm volatile("" : "+v"(tq));
      const int tokl = pass * 16 + (tq >> 4), sub = tq & 15;
      const uint4 a = *(const uint4*)(lds + (tokl * 132 + sub * 8) * 4), b = *(const uint4*)(lds + (tokl * 132 + sub * 8 + 4) * 4);
      unsigned k0 = a.x, k1 = a.y, k2 = a.z, k3 = a.w, k4 = b.x, k5 = b.y, k6 = b.z, k7 = b.w, mine = 0;
#define CE(x, y) { const unsigned hi_ = umx(x, y), lo_ = x < y ? x : y; x = hi_; y = lo_; }
      CE(k0, k1) CE(k2, k3) CE(k4, k5) CE(k6, k7)
      CE(k0, k2) CE(k1, k3) CE(k4, k6) CE(k5, k7)
      CE(k1, k2) CE(k5, k6) CE(k0, k4) CE(k3, k7)
      CE(k1, k5) CE(k2, k6)
      CE(k1, k4) CE(k3, k6)
      CE(k2, k4) CE(k3, k5)
      CE(k3, k4)
#undef CE
#pragma unroll
      for (int it = 0; it < 16; ++it) {
        const unsigned mx = row_umax(k0);
        if (sub == it) mine = mx;
        const bool wn_ = (k0 == mx);
        k0 = wn_ ? k1 : k0; k1 = wn_ ? k2 : k1; k2 = wn_ ? k3 : k2; k3 = wn_ ? k4 : k3;
        k4 = wn_ ? k5 : k4; k5 = wn_ ? k6 : k5; k6 = wn_ ? k7 : k6; k7 = wn_ ? 0u : k7;
      }
      tko[(size_t)(jb.m0 + hm * 64 + tokl) * 256 + nt * 16 + sub] = mine;
    }
    __syncthreads();
  }
}

template <int PH, int MODE, int NTN>
__device__ __forceinline__ void gemm_range(KP p, int lo, int hi, int vlo, char* lds) {
  const int G = (hi - lo) / (258 * NTN);
  const int nv = G * 264 * NTN;
  int v0 = blockIdx.x;
  if (v0 < vlo) v0 += ((vlo - v0 + (int)gridDim.x - 1) / (int)gridDim.x) * (int)gridDim.x;
  for (int vv = v0; vv < vlo + nv * REP_GEMM; vv += gridDim.x) {
    const int v = REP_GEMM == 1 ? vv - vlo : (vv - vlo) % nv;
    const int gg = v / (264 * NTN), r = v % (264 * NTN);
    const int xcd = r & 7, jx = r >> 3, nt = jx % NTN, mt = (jx / NTN) * 8 + xcd;
    if (mt >= 258) continue;
    const int id = lo + (gg * 258 + mt) * NTN + nt;
    int tid = threadIdx.x;
    asm volatile("" : "+v"(tid));
    const int l = tid & 63, w = tid >> 6, wm = w & 1, wn = w >> 1, g = l >> 4, li = l & 15;
    Job jb; get_job(p, PH, id, jb);
    f32x4 acc[4][4];
#pragma unroll
    for (int j = 0; j < 4; ++j)
#pragma unroll
      for (int i = 0; i < 4; ++i) acc[j][i] = f32x4{0.f, 0.f, 0.f, 0.f};
    const int lrow = tid >> 3, lkq = tid & 7;
    const int so = (lkq >> 2) * 8192 + swz(lrow, lkq & 3);
    const bf16* ga = jb.A + (size_t)(jb.m0 + lrow) * jb.lda + lkq * 8;
    const size_t sa = (size_t)32 * jb.lda;
    const bf16* gb0 = jb.B + (size_t)min(jb.n0 + lrow, jb.nmax - 1) * jb.ldb + lkq * 8;
    const bf16* gb1 = jb.B + (size_t)min(jb.n0 + lrow + 32, jb.nmax - 1) * jb.ldb + lkq * 8;
    const bf16* gb2 = jb.B + (size_t)min(jb.n0 + lrow + 64, jb.nmax - 1) * jb.ldb + lkq * 8;
    const bf16* gb3 = jb.B + (size_t)min(jb.n0 + lrow + 96, jb.nmax - 1) * jb.ldb + lkq * 8;
    uint4 r0a, r0b, r0c, r0d, r0e, r0f, r0g, r0h, r1a, r1b, r1c, r1d, r1e, r1f, r1g, r1h, r2a, r2b, r2c, r2d, r2e, r2f, r2g, r2h;
#define G_LOAD(S, t) { const int ko_ = (t) * 64; r##S##a = *(const uint4*)(ga + ko_); r##S##b = *(const uint4*)(ga + sa + ko_); r##S##c = *(const uint4*)(ga + 2 * sa + ko_); r##S##d = *(const uint4*)(ga + 3 * sa + ko_); \
      r##S##e = *(const uint4*)(gb0 + ko_); r##S##f = *(const uint4*)(gb1 + ko_); r##S##g = *(const uint4*)(gb2 + ko_); r##S##h = *(const uint4*)(gb3 + ko_); }
#define S_WRITE(S, buf) { char* nb_ = lds + (buf) * 32768 + so; *(uint4*)(nb_) = r##S##a; *(uint4*)(nb_ + 2048) = r##S##b; *(uint4*)(nb_ + 4096) = r##S##c; *(uint4*)(nb_ + 6144) = r##S##d; \
      *(uint4*)(nb_ + 16384) = r##S##e; *(uint4*)(nb_ + 18432) = r##S##f; *(uint4*)(nb_ + 20480) = r##S##g; *(uint4*)(nb_ + 22528) = r##S##h; }
#define K_STEP(u, SL, SW, DIST) { const int kt = kb + (u); if (kt < KT) { \
          if (kt + (DIST) < KT) G_LOAD(SL, kt + (DIST)); \
          const char* sb = lds + ((u) & 1) * 32768; \
          _Pragma("unroll") for (int ks = 0; ks < 2; ++ks) { \
            s16x8 xf[4], wf[4]; \
            _Pragma("unroll") for (int i = 0; i < 4; ++i) xf[i] = *(const s16x8*)(sb + ks * 8192 + swz(wm * 64 + i * 16 + li, g)); \
            _Pragma("unroll") for (int j = 0; j < 4; ++j) wf[j] = *(const s16x8*)(sb + 16384 + ks * 8192 + swz(wn * 64 + j * 16 + li, g)); \
            _Pragma("unroll") for (int j = 0; j < 4; ++j) \
              _Pragma("unroll") for (int i = 0; i < 4; ++i) acc[j][i] = __builtin_amdgcn_mfma_f32_16x16x32_bf16(wf[j], xf[i], acc[j][i], 0, 0, 0); \
          } \
          if (kt + 1 < KT) S_WRITE(SW, ((u) + 1) & 1); \
          __syncthreads(); } }
    const int KT = jb.K >> 6;
    if (MODE == 6) {
      G_LOAD(0, 0);
      S_WRITE(0, 0);
      __syncthreads();
      for (int kb = 0; kb < KT; kb += 2) {
        K_STEP(0, 0, 0, 1)
        K_STEP(1, 0, 0, 1)
      }
      const bf16* sk = (const bf16*)(p->ws + O_SK) + (size_t)jb.aux * 32768 + (size_t)((jb.n0 >> 7) & 1) * 16384;
#pragma unroll
      for (int i = 0; i < 8; ++i) {
        const int q = tid + i * 256, key = q >> 4, dc = q & 15;
        *(uint4*)(lds + 32768 + (dc >> 2) * 8192 + swz(key, dc & 3)) = *(const uint4*)(sk + key * 128 + dc * 8);
      }
    } else {
      G_LOAD(0, 0);
      if (KT > 1) G_LOAD(1, 1);
      if (KT > 2) G_LOAD(2, 2);
      S_WRITE(0, 0);
      __syncthreads();
      for (int kb = 0; kb < KT; kb += 6) {
        K_STEP(0, 0, 1, 3)
        K_STEP(1, 1, 2, 3)
        K_STEP(2, 2, 0, 3)
        K_STEP(3, 0, 1, 3)
        K_STEP(4, 1, 2, 3)
        K_STEP(5, 2, 0, 3)
      }
    }
#undef G_LOAD
#undef S_WRITE
#undef K_STEP
    if (MODE == 6) peer_tail(p, jb, acc, lds, tid);
    else {
#pragma unroll
      for (int j = 0; j < 4; ++j)
#pragma unroll
        for (int i = 0; i < 4; ++i)
        {
          epilogue<MODE>(p, jb, jb.m0 + wm * 64 + i * 16 + li, jb.n0 + wn * 64 + j * 16 + g * 4, acc[j][i], l);
        }
    }
  }
}
template <int ph>
__device__ __forceinline__ void phase_gemm(KP p, char* lds) {
  switch (ph) {
    case 1: gemm_range<1, 0, 8>(p, 0, 6192, 0, lds); gemm_range<1, 1, 1>(p, 6192, 6966, 6336, lds); break;
    case 2: gemm_range<2, 2, 8>(p, 0, 2064, 0, lds); gemm_range<2, 3, 8>(p, 2064, 4128, 2112, lds); gemm_range<2, 4, 8>(p, 4128, 6192, 4224, lds); break;
    case 4: gemm_range<4, 5, 8>(p, 0, 2064, 0, lds); break;
    case 6: gemm_range<6, 6, 16>(p, 0, 4128, 0, lds); break;
    case 8: gemm_range<8, 7, 16>(p, 0, 4128, 0, lds); gemm_range<8, 8, 8>(p, 4128, 6192, 4224, lds); break;
    case 10: gemm_range<10, 9, 8>(p, 0, 2064, 0, lds); break;
    default: gemm_range<12, 6, 16>(p, 0, 4128, 0, lds); break;
  }
}

__device__ __forceinline__ void phase_scan(KP p, char* lds) {
  const int tid = threadIdx.x, l = tid & 63, w = tid >> 6;
  const int row0 = w * 16 + (l >> 3) * 2, col0 = (l & 7) * 8;
  const int lt = tid >> 4, lc = (tid & 15) * 4;
  const bf16* Rb = (const bf16*)slot(p, 6); const bf16* Kb = (const bf16*)slot(p, 7); const bf16* Vb = (const bf16*)slot(p, 8);
  const float* Dc = (const float*)slot(p, 0); const bf16* Ab = (const bf16*)slot(p, 2); const bf16* Gb = (const bf16*)slot(p, 3);
  bf16* YG = (bf16*)slot(p, 4);
  float* ybuf = (float*)(lds + 49152);
  float* cbuf = (float*)(lds + 53248);
  int* s_it = (int*)(lds + 65520);
  int* qL = (int*)(p->ws + O_CNT) + 60; int* qS = qL + 1;
  int role = 0;
  if (threadIdx.x == 0) {
    const unsigned hw = (unsigned)__builtin_amdgcn_s_getreg((7 << 11) | (8 << 6) | 4);
    role = atomicAdd((int*)(p->ws + O_CUT) + ((xb_xcc_id() & 15u) * 256 + (hw & 255u)), 1);
  }
  for (;;) {
    __syncthreads();
    if (tid == 0) {
      int got = -1;
      if (role == 0) { int j = atomicAdd(qL, 1); if (j < 256 * REP_SCAN) got = j & 255; else { j = atomicAdd(qS, 1); if (j < 256) got = 256 + j; } }
      else { int j = atomicAdd(qS, 1); if (j < 256) got = 256 + j; else { j = atomicAdd(qL, 1); if (j < 256 * REP_SCAN) got = j & 255; } }
      *s_it = got;
    }
    __syncthreads();
    const int item = *s_it;
    if (item < 0) break;
    const int seq = item >> 4, h = item & 15;
    const bool samp = seq >= 16; const int b = seq & 15;
    const int nch = samp ? 1 : 128;
    const int tok0 = samp ? NTP + b * 16 : b * 2048;
    f32x2 S2[2][4];
#pragma unroll
    for (int rr = 0; rr < 2; ++rr) {
      if (samp) {
        const float* sp = p->in[2] + ((size_t)(b * 16 + h) * 64 + row0 + rr) * 64 + col0;
        const f32x4 a = ld4(sp), c = ld4(sp + 4);
        S2[rr][0] = f32x2{a[0], a[1]}; S2[rr][1] = f32x2{a[2], a[3]}; S2[rr][2] = f32x2{c[0], c[1]}; S2[rr][3] = f32x2{c[2], c[3]};
      } else {
#pragma unroll
        for (int i = 0; i < 4; ++i) S2[rr][i] = f32x2{0.f, 0.f};
      }
    }
    const int ch0 = h * 64 + lc;
    const f32x4 kk4 = ld4(p->in[16] + ch0), ka4 = ld4(p->in[17] + ch0), rk4 = ld4(p->in[18] + ch0);
    const f32x4 lng = ld4(p->in[19] + ch0), lnb = ld4(p->in[20] + ch0);
    uint2 rr_, rk_, rv_, ra_; f32x4 rd_;
    auto issue = [&](int ch) {
      const size_t off = (size_t)(tok0 + ch * 16 + lt) * 1024 + ch0;
      rr_ = *(const uint2*)(Rb + off); rk_ = *(const uint2*)(Kb + off); rv_ = *(const uint2*)(Vb + off); ra_ = *(const uint2*)(Ab + off);
      rd_ = ld4(Dc + off);
    };
    auto stage = [&](int buf) {
      const f32x4 r4 = unpack4(rr_), k4 = unpack4(rk_), v4 = unpack4(rv_), a4 = unpack4(ra_);
      const f32x4 kkr = k4 * kk4;
      float ss = kkr[0] * kkr[0] + kkr[1] * kkr[1] + kkr[2] * kkr[2] + kkr[3] * kkr[3];
      ss = row_sum(ss);
      const float inv = 1.0f / fmaxf(sqrtf(ss), 1e-12f);
      const f32x4 kkn = kkr * inv;
      const f32x4 kp = k4 * (1.0f + (a4 - 1.0f) * ka4);
      const f32x4 kka = kkn * a4;
      const f32x4 t = r4 * kp * rk4;
      float cb = row_sum(t[0] + t[1] + t[2] + t[3]);
      char* bp = lds + buf * 24576 + lt * 256 + lc * 4;
      st4((float*)(bp), r4); st4((float*)(bp + 4096), rd_); st4((float*)(bp + 8192), kp);
      st4((float*)(bp + 12288), kkn); st4((float*)(bp + 16384), kka); st4((float*)(bp + 20480), v4);
      if ((tid & 15) == 0) cbuf[buf * 16 + lt] = cb;
    };
    __syncthreads();
    issue(0); stage(0);
    __syncthreads();
    for (int ch = 0; ch < nch; ++ch) {
      const int cur = ch & 1;
      const bool more = ch + 1 < nch;
      const size_t goff = (size_t)(tok0 + ch * 16 + lt) * 1024 + ch0;
      const uint2 gq = *(const uint2*)(Gb + goff);
      if (more) issue(ch + 1);
#pragma unroll
      for (int t = 0; t < 16; ++t) {
        const char* bp = lds + cur * 24576 + t * 256 + col0 * 4;
        f32x2 rv[4], dv[4], kv[4], qv[4], av[4];
#pragma unroll
        for (int hh = 0; hh < 2; ++hh) {
          const float4 a0 = *(const float4*)(bp + hh * 16), b0 = *(const float4*)(bp + 4096 + hh * 16), c0 = *(const float4*)(bp + 8192 + hh * 16);
          const float4 d0 = *(const float4*)(bp + 12288 + hh * 16), e0 = *(const float4*)(bp + 16384 + hh * 16);
          rv[2 * hh] = f32x2{a0.x, a0.y}; rv[2 * hh + 1] = f32x2{a0.z, a0.w};
          dv[2 * hh] = f32x2{b0.x, b0.y}; dv[2 * hh + 1] = f32x2{b0.z, b0.w};
          kv[2 * hh] = f32x2{c0.x, c0.y}; kv[2 * hh + 1] = f32x2{c0.z, c0.w};
          qv[2 * hh] = f32x2{d0.x, d0.y}; qv[2 * hh + 1] = f32x2{d0.z, d0.w};
          av[2 * hh] = f32x2{e0.x, e0.y}; av[2 * hh + 1] = f32x2{e0.z, e0.w};
        }
        const float2 vv = *(const float2*)(lds + cur * 24576 + t * 256 + 20480 + row0 * 4);
        float yo[2];
#pragma unroll
        for (int rr = 0; rr < 2; ++rr) {
          f32x2 sa = S2[rr][0] * qv[0];
          sa = S2[rr][1] * qv[1] + sa; sa = S2[rr][2] * qv[2] + sa; sa = S2[rr][3] * qv[3] + sa;
          const float skk = oct_sum(sa.x + sa.y);
          const float vr = rr ? vv.y : vv.x;
          const f32x2 vr2 = {vr, vr}, ns2 = {-skk, -skk};
#pragma unroll
          for (int c = 0; c < 4; ++c) { const f32x2 tt = S2[rr][c] * dv[c] + vr2 * kv[c]; S2[rr][c] = ns2 * av[c] + tt; }
          f32x2 ya = S2[rr][0] * rv[0];
          ya = S2[rr][1] * rv[1] + ya; ya = S2[rr][2] * rv[2] + ya; ya = S2[rr][3] * rv[3] + ya;
          yo[rr] = oct_sum(ya.x + ya.y);
        }
        if ((l & 7) == 0) *(float2*)(ybuf + t * 64 + row0) = make_float2(yo[0], yo[1]);
      }
      __syncthreads();
      {
        const f32x4 y4 = ld4(ybuf + lt * 64 + lc);
        const float mean = row_sum(y4[0] + y4[1] + y4[2] + y4[3]) * (1.0f / 64.0f);
        const f32x4 dy = y4 - mean;
        const float var = row_sum(dy[0] * dy[0] + dy[1] * dy[1] + dy[2] * dy[2] + dy[3] * dy[3]) * (1.0f / 64.0f);
        const float rs = rsqrtf(var + 64e-5f);
        const f32x4 v4 = ld4((const float*)(lds + cur * 24576 + 20480 + lt * 256 + lc * 4));
        const float cb = cbuf[cur * 16 + lt];
        const f32x4 g4 = unpack4(gq);
        const f32x4 o = (dy * rs * lng + lnb + v4 * cb) * g4;
        *(uint2*)(YG + goff) = pack4(o);
      }
      if (more) stage(cur ^ 1);
      __syncthreads();
    }
    float* so = p->out + (samp ? OFF_WKVS : OFF_WKVP) + ((size_t)(b * 16 + h) * 64 + row0) * 64 + col0;
#pragma unroll
    for (int rr = 0; rr < 2; ++rr) {
      st4(so + rr * 64, f32x4{S2[rr][0].x, S2[rr][0].y, S2[rr][1].x, S2[rr][1].y});
      st4(so + rr * 64 + 4, f32x4{S2[rr][2].x, S2[rr][2].y, S2[rr][3].x, S2[rr][3].y});
    }
  }
  int* qQ = (int*)(p->ws + O_CNT) + 62;
  for (;;) {
    __syncthreads();
    if (tid == 0) *s_it = atomicAdd(qQ, 1);
    __syncthreads();
    const int ch = *s_it;
    if (ch >= 1024) break;
    quant_rows(p, ch * 64);
  }
}

__device__ __forceinline__ void phase_ln(KP p, const bf16* src, float* d32, bf16* db, const float* gam, const float* bet) {
  const int tid_ = otid();
  const int l = tid_ & 63, w = tid_ >> 6;
  for (int m = blockIdx.x * 4 + w; m < NT; m += gridDim.x * 4) {
    const bf16* s = src + (size_t)m * 1024;
    f32x4 x[4];
#pragma unroll
    for (int i = 0; i < 4; ++i) x[i] = unpack4(*(const uint2*)(s + i * 256 + l * 4));
    float sm = 0.f;
#pragma unroll
    for (int i = 0; i < 4; ++i) sm += x[i][0] + x[i][1] + x[i][2] + x[i][3];
    const float mean = wave_sum(sm) * (1.0f / 1024.0f);
    float sq = 0.f;
#pragma unroll
    for (int i = 0; i < 4; ++i) { x[i] = x[i] - mean; sq += x[i][0] * x[i][0] + x[i][1] * x[i][1] + x[i][2] * x[i][2] + x[i][3] * x[i][3]; }
    const float rs = rsqrtf(wave_sum(sq) * (1.0f / 1024.0f) + 1e-5f);
#pragma unroll
    for (int i = 0; i < 4; ++i) {
      const int e = i * 256 + l * 4;
      const f32x4 y = x[i] * rs * ld4(gam + e) + ld4(bet + e);
      *(uint2*)(db + (size_t)m * 1024 + e) = pack4(y);
    }
  }
}

__device__ __forceinline__ float dotq4(unsigned u, const float* x, float d) {
  d = fmaf((float)(u & 255u), x[0], d); d = fmaf((float)((u >> 8) & 255u), x[1], d);
  d = fmaf((float)((u >> 16) & 255u), x[2], d); d = fmaf((float)(u >> 24), x[3], d);
  return d;
}
__device__ __forceinline__ float dotq(uint4 u, const float* x) {
  return dotq4(u.x, x, 0.f) + dotq4(u.y, x + 4, 0.f) + dotq4(u.z, x + 8, 0.f) + dotq4(u.w, x + 12, 0.f);
}
__device__ __forceinline__ void axq4(unsigned u, float a, float* o) {
  o[0] = fmaf(a, (float)(u & 255u), o[0]); o[1] = fmaf(a, (float)((u >> 8) & 255u), o[1]);
  o[2] = fmaf(a, (float)((u >> 16) & 255u), o[2]); o[3] = fmaf(a, (float)(u >> 24), o[3]);
}
__device__ __forceinline__ void axq(uint4 u, float a, float* o) { axq4(u.x, a, o); axq4(u.y, a, o + 4); axq4(u.z, a, o + 8); axq4(u.w, a, o + 12); }
__device__ __forceinline__ float reduce8(const float* pp, int l) {
  const bool b0 = l & 1, b1 = l & 2, b2 = l & 4;
  float a[4], bb[2];
#pragma unroll
  for (int i = 0; i < 4; ++i) { const float keep = b0 ? pp[2 * i + 1] : pp[2 * i], send = b0 ? pp[2 * i] : pp[2 * i + 1]; a[i] = keep + dppf<0xB1>(send); }
#pragma unroll
  for (int i = 0; i < 2; ++i) { const float keep = b1 ? a[2 * i + 1] : a[2 * i], send = b1 ? a[2 * i] : a[2 * i + 1]; bb[i] = keep + dppf<0x4E>(send); }
  const float keep = b2 ? bb[1] : bb[0], send = b2 ? bb[0] : bb[1];
  float c = keep + dppf<0x124>(send);
  c += dppf<0x128>(c);
  c += __shfl_xor(c, 16); c += __shfl_xor(c, 32);
  return c;
}

__device__ __forceinline__ void phase_peer_experts(KP p, int layer) {
  const int tid_ = otid();
  const int l = tid_ & 63, w = tid_ >> 6;
  const unsigned* TK = (const unsigned*)slot(p, layer ? 5 : 6);
  const bf16* X = (const bf16*)slot(p, layer ? 4 : 5);
  const unsigned char* PU = (const unsigned char*)(p->ws + O_PU) + (size_t)layer * 8388608;
  const unsigned char* PV = (const unsigned char*)(p->ws + O_PV) + (size_t)layer * 8388608;
  const float* SU = (const float*)(p->ws + O_SU) + layer * 16384;
  const float* SV = (const float*)(p->ws + O_SV) + layer * 16384;
  const float* lg = p->in[29] + layer * 1024; const float* lb = p->in[30] + layer * 1024;
  const int hq = l >> 4, r = l & 15;
  unsigned cd[4];
#pragma unroll
  for (int c = 0; c < 4; ++c) cd[c] = CAND[r * 4 + c];
  for (int mv = blockIdx.x * 4 + w; mv < NT * REP_PE; mv += gridDim.x * 4) {
    const int m = REP_PE == 1 ? mv : mv % NT;
    const unsigned* tk = TK + (size_t)m * 256;
    int eidx[2]; float gate[2];
#pragma unroll
    for (int pass = 0; pass < 2; ++pass) {
      const int h = pass * 4 + hq;
      unsigned k[4];
#pragma unroll
      for (int c = 0; c < 4; ++c) {
        const unsigned ab = cd[c] == 255u ? 0u : cd[c];
        const unsigned k1 = tk[h * 32 + (ab >> 4)], k2 = tk[h * 32 + 16 + (ab & 15)];
        const float s = ord2f(k1 & ~127u) + ord2f(k2 & ~127u);
        k[c] = cd[c] == 255u ? 0u : ((f2ord(s) & ~255u) | (255u - cd[c]));
      }
      unsigned mine = 0;
#pragma unroll
      for (int it = 0; it < 16; ++it) {
        unsigned mx = umx(umx(k[0], k[1]), umx(k[2], k[3]));
        mx = row_umax(mx);
        if (r == it) mine = mx;
#pragma unroll
        for (int c = 0; c < 4; ++c) k[c] = (k[c] == mx) ? 0u : k[c];
      }
      const unsigned pos = 255u - (mine & 255u);
      const unsigned k1 = tk[h * 32 + (pos >> 4)], k2 = tk[h * 32 + 16 + (pos & 15)];
      eidx[pass] = (int)((127u - (k1 & 127u)) * 128u + (127u - (k2 & 127u)));
      const float s = ord2f(mine & ~255u);
      const float mxs = row_max(s);
      const float ex = __expf(s - mxs);
      gate[pass] = ex / row_sum(ex);
    }
    const bf16* xr = X + (size_t)m * 1024;
    float xv[16], out[16];
    {
      const uint4 u0 = *(const uint4*)(xr + l * 16), u1 = *(const uint4*)(xr + l * 16 + 8);
      const f32x4 a = unpack4(make_uint2(u0.x, u0.y)), b = unpack4(make_uint2(u0.z, u0.w)), c = unpack4(make_uint2(u1.x, u1.y)), d = unpack4(make_uint2(u1.z, u1.w));
#pragma unroll
      for (int i = 0; i < 4; ++i) { xv[i] = a[i]; xv[4 + i] = b[i]; xv[8 + i] = c[i]; xv[12 + i] = d[i]; }
    }
    float xam = 0.f;
#pragma unroll
    for (int i = 0; i < 16; ++i) { out[i] = 0.f; xam = fmaxf(xam, fabsf(xv[i])); }
    xam = row_max(xam); xam = fmaxf(xam, __shfl_xor(xam, 16)); xam = fmaxf(xam, __shfl_xor(xam, 32));
    const float xinv = xam > 0.f ? 127.0f / xam : 0.f, xs = xam * (1.0f / 127.0f);
    int xq[16]; int sqi = 0;
#pragma unroll
    for (int i = 0; i < 16; ++i) { xq[i] = (int)rintf(xv[i] * xinv); sqi += xq[i]; }
    int xe0 = (xq[0] & 255) | ((xq[2] & 255) << 8) | ((xq[4] & 255) << 16) | (xq[6] << 24);
    int xo0 = (xq[1] & 255) | ((xq[3] & 255) << 8) | ((xq[5] & 255) << 16) | (xq[7] << 24);
    int xe1 = (xq[8] & 255) | ((xq[10] & 255) << 8) | ((xq[12] & 255) << 16) | (xq[14] << 24);
    int xo1 = (xq[9] & 255) | ((xq[11] & 255) << 8) | ((xq[13] & 255) << 16) | (xq[15] << 24);
    const float sx = wave_sum((float)sqi);
    float csum = 0.f;
    uint2 ua[8], ub[8];
    uint2 va[8], vb[8];
#define LD_U(dst, ps, s0) { _Pragma("unroll") for (int k = 0; k < 8; ++k) dst[k] = *(const uint2*)(PU + (size_t)__builtin_amdgcn_readlane(eidx[ps], (s0) + k) * 512 + l * 8); }
#define LD_V(dst, ps, s0) { _Pragma("unroll") for (int k = 0; k < 8; ++k) dst[k] = *(const uint2*)(PV + (size_t)__builtin_amdgcn_readlane(eidx[ps], (s0) + k) * 512 + l * 8); }
#define DO_U(buf, s0, MD) { float pp[8]; \
        _Pragma("unroll") for (int k = 0; k < 8; ++k) { \
          const unsigned w0 = buf[k].x, w1 = buf[k].y; \
          int a_ = __builtin_amdgcn_sdot4((int)(w0 & 0x0F0F0F0Fu), xe0, 0, false); \
          a_ = __builtin_amdgcn_sdot4((int)((w0 >> 4) & 0x0F0F0F0Fu), xo0, a_, false); \
          a_ = __builtin_amdgcn_sdot4((int)(w1 & 0x0F0F0F0Fu), xe1, a_, false); \
          a_ = __builtin_amdgcn_sdot4((int)((w1 >> 4) & 0x0F0F0F0Fu), xo1, a_, false); \
          pp[k] = (float)a_; } \
        const float c_ = reduce8(pp, l); \
        if ((l >> 3) == ((s0) >> 3)) MD = c_; }
#define TR4(d0, d1, d2, d3, A4, o) { \
          const unsigned pl_ = __builtin_amdgcn_perm(d1, d0, 0x05010400u), ph_ = __builtin_amdgcn_perm(d1, d0, 0x07030602u); \
          const unsigned ql_ = __builtin_amdgcn_perm(d3, d2, 0x05010400u), qh_ = __builtin_amdgcn_perm(d3, d2, 0x07030602u); \
          iacc[(o) + 0] = __builtin_amdgcn_sdot4((int)__builtin_amdgcn_perm(ql_, pl_, 0x05040100u), A4, iacc[(o) + 0], false); \
          iacc[(o) + 2] = __builtin_amdgcn_sdot4((int)__builtin_amdgcn_perm(ql_, pl_, 0x07060302u), A4, iacc[(o) + 2], false); \
          iacc[(o) + 4] = __builtin_amdgcn_sdot4((int)__builtin_amdgcn_perm(qh_, ph_, 0x05040100u), A4, iacc[(o) + 4], false); \
          iacc[(o) + 6] = __builtin_amdgcn_sdot4((int)__builtin_amdgcn_perm(qh_, ph_, 0x07060302u), A4, iacc[(o) + 6], false); }
#define NLO(w) ((w) & 0x0F0F0F0Fu)
#define NHI(w) (((w) >> 4) & 0x0F0F0F0Fu)
#define DO_V(buf, s0, CQ) { _Pragma("unroll") for (int hb = 0; hb < 2; ++hb) { \
          const int c0_ = __builtin_amdgcn_readlane(CQ, (s0) + hb * 4), c1_ = __builtin_amdgcn_readlane(CQ, (s0) + hb * 4 + 1); \
          const int c2_ = __builtin_amdgcn_readlane(CQ, (s0) + hb * 4 + 2), c3_ = __builtin_amdgcn_readlane(CQ, (s0) + hb * 4 + 3); \
          const int a4_ = (c0_ & 255) | ((c1_ & 255) << 8) | ((c2_ & 255) << 16) | ((c3_ & 255) << 24); \
          TR4(NLO(buf[hb * 4].x), NLO(buf[hb * 4 + 1].x), NLO(buf[hb * 4 + 2].x), NLO(buf[hb * 4 + 3].x), a4_, 0) \
          TR4(NHI(buf[hb * 4].x), NHI(buf[hb * 4 + 1].x), NHI(buf[hb * 4 + 2].x), NHI(buf[hb * 4 + 3].x), a4_, 1) \
          TR4(NLO(buf[hb * 4].y), NLO(buf[hb * 4 + 1].y), NLO(buf[hb * 4 + 2].y), NLO(buf[hb * 4 + 3].y), a4_, 8) \
          TR4(NHI(buf[hb * 4].y), NHI(buf[hb * 4 + 1].y), NHI(buf[hb * 4 + 2].y), NHI(buf[hb * 4 + 3].y), a4_, 9) } }
#define CQUANT(WG, CQ, CS) float CS; int CQ; { float cm_ = fabsf(WG); cm_ = row_max(cm_); cm_ = fmaxf(cm_, __shfl_xor(cm_, 16)); cm_ = fmaxf(cm_, __shfl_xor(cm_, 32)); \
          CS = cm_ * (1.0f / 127.0f); CQ = (int)rintf(WG * (cm_ > 0.f ? 127.0f / cm_ : 0.f)); }
#define CSUM(CQ) wave_sum((float)CQ)
#define FLUSH(CS, SUMQ) { const float off_ = 7.5f * (SUMQ); _Pragma("unroll") for (int i = 0; i < 16; ++i) { out[i] = fmaf(CS, (float)iacc[i] - off_, out[i]); iacc[i] = 0; } }
    float md0 = 0.f, md1 = 0.f;
    int iacc[16];
#pragma unroll
    for (int i = 0; i < 16; ++i) iacc[i] = 0;
    LD_U(ua, 0, 0)
#pragma unroll 1
    for (int s = 0; s < 64; s += 16) {
      LD_U(ub, 0, s + 8)
      DO_U(ua, s, md0)
      if (s + 16 < 64) LD_U(ua, 0, s + 16) else { LD_V(va, 0, 0) LD_U(ua, 1, 0) }
      DO_U(ub, s + 8, md0)
    }
    const float su0 = SU[eidx[0]], sv0 = SV[eidx[0]];
    const float hh0 = su0 * xs * (md0 - 7.5f * sx);
    const float wgt0 = gate[0] * 0.5f * hh0 * (1.0f + erff(hh0 * 0.70710678118654752f)) * sv0;
    CQUANT(wgt0, cq0, cs0)
    const float sq0 = CSUM(cq0);
#pragma unroll 1
    for (int s = 0; s < 64; s += 16) {
      LD_V(vb, 0, s + 8) LD_U(ub, 1, s + 8)
      DO_V(va, s, cq0) DO_U(ua, s, md1)
      if (s + 16 < 64) { LD_V(va, 0, s + 16) LD_U(ua, 1, s + 16) } else LD_V(va, 1, 0)
      DO_V(vb, s + 8, cq0) DO_U(ub, s + 8, md1)
    }
    const float su1 = SU[eidx[1]], sv1 = SV[eidx[1]];
    const float hh1 = su1 * xs * (md1 - 7.5f * sx);
    FLUSH(cs0, sq0)
    const float wgt1 = gate[1] * 0.5f * hh1 * (1.0f + erff(hh1 * 0.70710678118654752f)) * sv1;
    CQUANT(wgt1, cq1, cs1)
    const float sq1 = CSUM(cq1);
#pragma unroll 1
    for (int s = 0; s < 64; s += 16) {
      LD_V(vb, 1, s + 8)
      DO_V(va, s, cq1)
      if (s + 16 < 64) LD_V(va, 1, s + 16)
      DO_V(vb, s + 8, cq1)
    }
    FLUSH(cs1, sq1)
#undef LD_U
#undef LD_V
#undef DO_U
#undef DO_V
#undef TR4
#undef NLO
#undef NHI
#undef CSUM
#undef CQUANT
#undef FLUSH
    float sm = 0.f;
#pragma unroll
    for (int i = 0; i < 16; ++i) { out[i] = fmaf(xv[i], 1.4142135623730951f, out[i]); sm += out[i]; }
    const float mean = wave_sum(sm) * (1.0f / 1024.0f);
    float sq = 0.f;
#pragma unroll
    for (int i = 0; i < 16; ++i) { out[i] -= mean; sq = fmaf(out[i], out[i], sq); }
    const float rs = rsqrtf(wave_sum(sq) * (1.0f / 1024.0f) + 1e-5f);
    float* d32 = layer ? ((m < NTP) ? p->out + OFF_YP + (size_t)m * 1024 : p->out + OFF_YS + (size_t)(m - NTP) * 1024)
                       : (float*)slot(p, 0) + (size_t)m * 1024;
#pragma unroll
    for (int hf = 0; hf < 2; ++hf) {
      const int e = l * 16 + hf * 8;
      const f32x4 g0 = ld4(lg + e), g1 = ld4(lg + e + 4), b0 = ld4(lb + e), b1 = ld4(lb + e + 4);
      f32x4 y0, y1;
#pragma unroll
      for (int i = 0; i < 4; ++i) { y0[i] = out[hf * 8 + i] * rs * g0[i] + b0[i]; y1[i] = out[hf * 8 + 4 + i] * rs * g1[i] + b1[i]; }
      if (layer) { st4(d32 + e, y0); st4(d32 + e + 4, y1); }
      else {
        const uint2 pa = pack4(y0), pb = pack4(y1);
        *(uint4*)((bf16*)slot(p, 4) + (size_t)m * 1024 + e) = make_uint4(pa.x, pa.y, pb.x, pb.y);
      }
    }
  }
}

__device__ __forceinline__ void phase_attn(KP p, char* lds) {
  const int tid = threadIdx.x, l = tid & 63, w = tid >> 6, c = w & 1, qh = w >> 1, g = l >> 4, li = l & 15;
  int* s_item = (int*)(lds + 65520);
  int* counter = (int*)(p->ws + O_CNT);
  const float* lp = p->in[24];
  const float s1 = wave_sum(lp[l] * lp[64 + l]), s2 = wave_sum(lp[128 + l] * lp[192 + l]);
  const float lam = __expf(s1) - __expf(s2) + 0.35550906759f;
  const bf16* Kb = (const bf16*)slot(p, 5); const bf16* VT = (const bf16*)slot(p, 6);
  const bf16* Qb = (const bf16*)slot(p, 7); bf16* Ob = (bf16*)slot(p, 8);
  const float* ck = p->in[4]; const float* cv = p->in[5];
  const float* sg = p->in[25];
  const int myq = (int)(xb_xcc_id() & 7u);
  int qoff = 0;
  for (;;) {
    __syncthreads();
    if (tid == 0) {
      int got = -1;
      while (qoff < 8) {
        const int qx = (myq + qoff) & 7;
        const int j = atomicAdd(counter + qx * 8, 1);
        if (j < 640 * REP_ATTN) { got = qx * 1024 + (j % 640); break; }
        ++qoff;
      }
      *s_item = got;
    }
    __syncthreads();
    const int item = *s_item;
    if (item < 0) break;
    bool samp; int b, h, qc, sp;
    {
      const int qx = item >> 10, j = item & 1023;
      h = qx;
      if (j < 128) { samp = true; b = j >> 3; sp = j & 7; qc = 0; }
      else { const int j2 = j - 128; samp = false; sp = 0; b = j2 >> 5; qc = 31 - (j2 & 31); }
    }
    const int nkt = samp ? (sp == 7 ? 17 : 16) : qc + 1;
    const int qtok0 = samp ? NTP + b * 16 : b * 2048 + qc * 64;
    const int nq = samp ? 16 : 64;
    s16x8 qf[2][2];
#pragma unroll
    for (int f = 0; f < 2; ++f)
#pragma unroll
      for (int ks = 0; ks < 2; ++ks) {
        const int qi = min(qh * 32 + f * 16 + li, nq - 1);
        qf[f][ks] = *(const s16x8*)(Qb + (size_t)(qtok0 + qi) * 1024 + h * 128 + c * 64 + ks * 32 + g * 8);
      }
    f32x4 ot[8][2];
#pragma unroll
    for (int ef = 0; ef < 8; ++ef) { ot[ef][0] = f32x4{0.f, 0.f, 0.f, 0.f}; ot[ef][1] = f32x4{0.f, 0.f, 0.f, 0.f}; }
    float mrun[2] = {-INFINITY, -INFINITY}, lsum[2] = {0.f, 0.f};
    uint4 raw[8];
    auto load_tile = [&](int kt, int tid) {
      if (samp && kt < 16) {
#pragma unroll
        for (int i = 0; i < 2; ++i) {
          const int q = tid + i * 256, cc = q >> 8, key = (q >> 3) & 31, dch = q & 7;
          const float* src = ck + ((size_t)(b * 4096 + (sp * 16 + kt) * 32 + key)) * 1024 + h * 128 + cc * 64 + dch * 8;
          raw[2 * i] = ldnt(src); raw[2 * i + 1] = ldnt(src + 4);
        }
        const int key = tid & 31, eq = tid >> 5;
        const float* src = cv + ((size_t)(b * 4096 + (sp * 16 + kt) * 32 + key)) * 1024 + h * 128 + eq * 16;
#pragma unroll
        for (int i = 0; i < 4; ++i) raw[4 + i] = ldnt(src + i * 4);
      } else if (!samp) {
        const bf16* kb_ = Kb + (size_t)(b * 2048 + kt * 64) * 1024 + h * 128;
        const bf16* vb_ = VT + (size_t)((b * 8 + h) * 128) * 2048 + kt * 64;
        const unsigned ko_ = (unsigned)(tid >> 3) * 1024u + (unsigned)(tid & 7) * 8u;
        const unsigned vo_ = (unsigned)(tid >> 3) * 2048u + (unsigned)(tid & 7) * 8u;
        raw[0] = *(const uint4*)(kb_ + ko_);
        raw[1] = *(const uint4*)(kb_ + (ko_ + 32768u));
        raw[2] = *(const uint4*)(kb_ + (ko_ + 64u));
        raw[3] = *(const uint4*)(kb_ + (ko_ + 32768u + 64u));
        raw[4] = *(const uint4*)(vb_ + vo_);
        raw[5] = *(const uint4*)(vb_ + (vo_ + 65536u));
        raw[6] = *(const uint4*)(vb_ + (vo_ + 131072u));
        raw[7] = *(const uint4*)(vb_ + (vo_ + 196608u));
      } else {
        const int ktok0 = NTP + b * 16;
        const size_t vbase = (size_t)33554432 + (size_t)((b * 8 + h) * 128) * 16;
#pragma unroll
        for (int i = 0; i < 4; ++i) {
          const int q = tid + i * 256, cc = q >> 9, key = (q >> 3) & 63, dch = q & 7;
          const uint4 kvv = *(const uint4*)(Kb + (size_t)(ktok0 + (key & 15)) * 1024 + h * 128 + cc * 64 + dch * 8);
          const int e = q >> 3, kch = q & 7;
          const uint4 vvv = *(const uint4*)(VT + vbase + (size_t)e * 16 + (kch & 1) * 8);
          const bool kok = key < 16, vok = kch < 2;
          raw[i] = make_uint4(kok ? kvv.x : 0u, kok ? kvv.y : 0u, kok ? kvv.z : 0u, kok ? kvv.w : 0u);
          raw[4 + i] = make_uint4(vok ? vvv.x : 0u, vok ? vvv.y : 0u, vok ? vvv.z : 0u, vok ? vvv.w : 0u);
        }
      }
    };
    auto store_tile = [&](int kt, int tid) {
      if (samp && kt < 16) {
#pragma unroll
        for (int i = 0; i < 2; ++i) {
          const int q = tid + i * 256, cc = q >> 8, key = (q >> 3) & 31, dch = q & 7;
          const uint4 a = raw[2 * i], bq = raw[2 * i + 1];
          uint4 o;
          o.x = pack2(__uint_as_float(a.x), __uint_as_float(a.y)); o.y = pack2(__uint_as_float(a.z), __uint_as_float(a.w));
          o.z = pack2(__uint_as_float(bq.x), __uint_as_float(bq.y)); o.w = pack2(__uint_as_float(bq.z), __uint_as_float(bq.w));
          *(uint4*)(lds + cc * 8192 + (dch >> 2) * 4096 + swz(key, dch & 3)) = o;
        }
        const int key = tid & 31, eq = tid >> 5;
#pragma unroll
        for (int i = 0; i < 4; ++i) {
          const int e = eq * 16 + i * 4;
          *(bf16*)(lds + 16384 + (e + 0) * 144 + key * 2) = f2b(__uint_as_float(raw[4 + i].x));
          *(bf16*)(lds + 16384 + (e + 1) * 144 + key * 2) = f2b(__uint_as_float(raw[4 + i].y));
          *(bf16*)(lds + 16384 + (e + 2) * 144 + key * 2) = f2b(__uint_as_float(raw[4 + i].z));
          *(bf16*)(lds + 16384 + (e + 3) * 144 + key * 2) = f2b(__uint_as_float(raw[4 + i].w));
        }
      } else {
#pragma unroll
        for (int i = 0; i < 4; ++i) {
          const int dch = tid & 7;
          *(uint4*)(lds + ((dch >> 2) * 4096 + swz(tid >> 3, dch & 3)) + (i & 1) * 2048 + (i >> 1) * 8192) = raw[i];
          *(uint4*)(lds + 16384 + ((tid >> 3) * 144 + dch * 16) + i * 4608) = raw[4 + i];
        }
      }
    };
    load_tile(0, tid);
    for (int kt = 0; kt < nkt; ++kt) {
      int tz = tid;
      asm volatile("" : "+v"(tz));
      const int li = tz & 15, g = (tz & 63) >> 4;
      __syncthreads();
      store_tile(kt, tz);
      __syncthreads();
      if (kt + 1 < nkt) load_tile(kt + 1, tz);
      const int kvalid = samp ? (kt == 16 ? 16 : 32) : 64;
      const bool full = !samp;
      f32x4 st[4][2];
#pragma unroll
      for (int kf = 0; kf < 4; ++kf) { st[kf][0] = f32x4{0.f, 0.f, 0.f, 0.f}; st[kf][1] = f32x4{0.f, 0.f, 0.f, 0.f}; }
      {
        s16x8 kfr[2][4];
#pragma unroll
        for (int ks = 0; ks < 2; ++ks)
#pragma unroll
          for (int kf = 0; kf < 4; ++kf)
            if (kf < 2 || full) kfr[ks][kf] = *(const s16x8*)(lds + c * 8192 + ks * 4096 + swz(kf * 16 + li, g));
#pragma unroll
        for (int ks = 0; ks < 2; ++ks)
#pragma unroll
          for (int kf = 0; kf < 4; ++kf)
            if (kf < 2 || full) {
              st[kf][0] = __builtin_amdgcn_mfma_f32_16x16x32_bf16(kfr[ks][kf], qf[0][ks], st[kf][0], 0, 0, 0);
              st[kf][1] = __builtin_amdgcn_mfma_f32_16x16x32_bf16(kfr[ks][kf], qf[1][ks], st[kf][1], 0, 0, 0);
            }
        __builtin_amdgcn_sched_barrier(0);
      }
      if (kvalid < 64) {
#pragma unroll
        for (int kf = 0; kf < 4; ++kf)
#pragma unroll
          for (int r = 0; r < 4; ++r)
            if (kf * 16 + g * 4 + r >= kvalid) { st[kf][0][r] = -INFINITY; st[kf][1][r] = -INFINITY; }
      }
#pragma unroll
      for (int f = 0; f < 2; ++f) {
        float ml = st[0][f][0];
#pragma unroll
        for (int kf = 0; kf < 4; ++kf)
#pragma unroll
          for (int r = 0; r < 4; ++r) ml = fmaxf(ml, st[kf][f][r]);
        ml = fmaxf(ml, __shfl_xor(ml, 16)); ml = fmaxf(ml, __shfl_xor(ml, 32));
        const bool grow = ml > mrun[f] + 8.0f;
        const float mn = grow ? ml : mrun[f];
        float ps = 0.f;
#pragma unroll
        for (int kf = 0; kf < 4; ++kf)
#pragma unroll
          for (int r = 0; r < 4; ++r) { const float pv = __builtin_amdgcn_exp2f(st[kf][f][r] - mn); st[kf][f][r] = pv; ps += pv; }
        if (__builtin_amdgcn_ballot_w64(grow) != 0ull) {
          const float scl = __builtin_amdgcn_exp2f(mrun[f] - mn);
          lsum[f] *= scl;
#pragma unroll
          for (int ef = 0; ef < 8; ++ef) ot[ef][f] = ot[ef][f] * scl;
        }
        mrun[f] = mn;
        lsum[f] += ps;
      }
      s16x8 pf[2][2];
#pragma unroll
      for (int step = 0; step < 2; ++step)
#pragma unroll
        for (int f = 0; f < 2; ++f) {
          const uint2 a = pack4(st[2 * step][f]), bq = pack4(st[2 * step + 1][f]);
          pf[step][f] = __builtin_bit_cast(s16x8, make_uint4(a.x, a.y, bq.x, bq.y));
        }
      __builtin_amdgcn_sched_barrier(0);
#pragma unroll
      for (int step = 0; step < 2; ++step) {
        if (step == 1 && !full) break;
        s16x8 vf[8];
#pragma unroll
        for (int ef = 0; ef < 8; ++ef) {
          const char* vp = lds + 16384 + (ef * 16 + li) * 144 + (step * 32 + g * 4) * 2;
          const uint2 a = *(const uint2*)vp, bq = *(const uint2*)(vp + 32);
          vf[ef] = __builtin_bit_cast(s16x8, make_uint4(a.x, a.y, bq.x, bq.y));
        }
#pragma unroll
        for (int ef = 0; ef < 8; ++ef) {
          ot[ef][0] = __builtin_amdgcn_mfma_f32_16x16x32_bf16(vf[ef], pf[step][0], ot[ef][0], 0, 0, 0);
          ot[ef][1] = __builtin_amdgcn_mfma_f32_16x16x32_bf16(vf[ef], pf[step][1], ot[ef][1], 0, 0, 0);
        }
        __builtin_amdgcn_sched_barrier(0);
      }
    }
    float inv[2];
#pragma unroll
    for (int f = 0; f < 2; ++f) { float lt = lsum[f]; lt += __shfl_xor(lt, 16); lt += __shfl_xor(lt, 32); inv[f] = 1.0f / lt; }
    if (samp) {
      if (qh == 0) {
        float* pr = (float*)slot(p, 9) + ((size_t)((((b * 8 + h) * 8 + sp) * 2 + c) * 16 + li)) * 132;
#pragma unroll
        for (int ef = 0; ef < 8; ++ef) st4(pr + ef * 16 + g * 4, ot[ef][0]);
        if (g == 0) { pr[128] = mrun[0]; pr[129] = 1.0f / inv[0]; }
      }
      continue;
    }
    __syncthreads();
    float* comb = (float*)lds;
    if (c == 1) {
#pragma unroll
      for (int ef = 0; ef < 8; ++ef)
#pragma unroll
        for (int f = 0; f < 2; ++f)
#pragma unroll
          for (int r = 0; r < 4; ++r) comb[(((qh * 8 + ef) * 2 + f) * 4 + r) * 64 + l] = ot[ef][f][r] * inv[f] * lam;
    }
    __syncthreads();
    if (c == 0) {
#pragma unroll
      for (int f = 0; f < 2; ++f) {
        float ss = 0.f;
#pragma unroll
        for (int ef = 0; ef < 8; ++ef)
#pragma unroll
          for (int r = 0; r < 4; ++r) { const float o = ot[ef][f][r] * inv[f] - comb[(((qh * 8 + ef) * 2 + f) * 4 + r) * 64 + l]; ot[ef][f][r] = o; ss = fmaf(o, o, ss); }
        ss += __shfl_xor(ss, 16); ss += __shfl_xor(ss, 32);
        const float rs = rsqrtf(ss * (1.0f / 128.0f) + 1e-5f) * 0.6444909324090307f;
        const int qi = qh * 32 + f * 16 + li;
        if (qi < nq) {
#pragma unroll
          for (int ef = 0; ef < 8; ++ef) {
            const int e = ef * 16 + g * 4;
            const f32x4 g4 = ld4(sg + e);
            *(uint2*)(Ob + (size_t)(qtok0 + qi) * 1024 + h * 128 + e) = pack4(ot[ef][f] * rs * g4);
          }
        }
      }
    }
  }
}

__device__ __forceinline__ void phase_attn_combine(KP p) {
  const int l = threadIdx.x & 63, w = threadIdx.x >> 6;
  const float* lp = p->in[24];
  const float s1 = wave_sum(lp[l] * lp[64 + l]), s2 = wave_sum(lp[128 + l] * lp[192 + l]);
  const float lam = __expf(s1) - __expf(s2) + 0.35550906759f;
  const float* sg = p->in[25];
  bf16* Ob = (bf16*)slot(p, 8);
  for (int row = blockIdx.x * 4 + w; row < 2048; row += gridDim.x * 4) {
    const int q = row & 15, bh = row >> 4;
    float o2[2][2];
#pragma unroll
    for (int c = 0; c < 2; ++c) {
      float m[8], M = -INFINITY;
#pragma unroll
      for (int sp = 0; sp < 8; ++sp) { m[sp] = ((const float*)slot(p, 9))[((size_t)(((bh * 8 + sp) * 2 + c) * 16 + q)) * 132 + 128]; M = fmaxf(M, m[sp]); }
      float L = 0.f, a0 = 0.f, a1 = 0.f;
#pragma unroll
      for (int sp = 0; sp < 8; ++sp) {
        const float* pr = (const float*)slot(p, 9) + ((size_t)(((bh * 8 + sp) * 2 + c) * 16 + q)) * 132;
        const float wg = __builtin_amdgcn_exp2f(m[sp] - M);
        L = fmaf(wg, pr[129], L);
        const float2 ov = *(const float2*)(pr + l * 2);
        a0 = fmaf(wg, ov.x, a0); a1 = fmaf(wg, ov.y, a1);
      }
      o2[c][0] = a0 / L; o2[c][1] = a1 / L;
    }
    const float x0 = o2[0][0] - lam * o2[1][0], x1 = o2[0][1] - lam * o2[1][1];
    const float ss = wave_sum(x0 * x0 + x1 * x1);
    const float rs = rsqrtf(ss * (1.0f / 128.0f) + 1e-5f) * 0.6444909324090307f;
    const int b = bh >> 3, h = bh & 7;
    *(unsigned*)(Ob + (size_t)(NTP + b * 16 + q) * 1024 + h * 128 + l * 2) = pack2(x0 * rs * sg[l * 2], x1 * rs * sg[l * 2 + 1]);
  }
}

__global__ void __launch_bounds__(256, 2) yoco_mega(Params p) {
  __shared__ __attribute__((aligned(16))) char lds[65536];
  cg::grid_group grid = cg::this_grid();
  KP kp = (KP)__builtin_amdgcn_kernarg_segment_ptr();
#define FRESH() ({ KP q_ = kp; asm volatile("" : "+s"(q_)); q_; })
  phase0(FRESH());
  grid.sync();
  XcdBar xb; xb.bar = (unsigned*)(FRESH()->ws + O_BAR); xb.x = xb_xcc_id(); xb.nloc = 1u; xb.nx = 1u;
  if (threadIdx.x == 0) (void)xb_add(&xb.bar[XB_XCNT(xb.x)], 1u);
  if (threadIdx.x < 64) {
    unsigned nl = 1u, nxx = 1u;
    xcd_census(xb.bar, xb.x, nl, nxx);
    xb.nloc = (unsigned)__builtin_amdgcn_readfirstlane((int)nl); xb.nx = (unsigned)__builtin_amdgcn_readfirstlane((int)nxx);
  }
  phase_gemm<1>(FRESH(), lds); xcd_barrier(xb);
  phase_gemm<2>(FRESH(), lds); xcd_barrier(xb);
  phase_scan(FRESH(), lds); xcd_barrier(xb);
  phase_gemm<4>(FRESH(), lds); xcd_barrier(xb);
  { KP p = FRESH(); phase_ln(p, (const bf16*)slot(p, 0), (float*)slot(p, 2), (bf16*)slot(p, 5), p->in[27], p->in[28]); } xcd_barrier(xb);
  phase_gemm<6>(FRESH(), lds); xcd_barrier(xb);
  phase_peer_experts(FRESH(), 0); xcd_barrier(xb);
  phase_gemm<8>(FRESH(), lds); xcd_barrier(xb);
  phase_attn(FRESH(), lds); xcd_barrier(xb);
  phase_attn_combine(FRESH()); xcd_barrier(xb);
  phase_gemm<10>(FRESH(), lds); xcd_barrier(xb);
  { KP p = FRESH(); phase_ln(p, (const bf16*)slot(p, 2), (float*)slot(p, 0), (bf16*)slot(p, 4), p->in[27] + 1024, p->in[28] + 1024); } xcd_barrier(xb);
  phase_gemm<12>(FRESH(), lds); xcd_barrier(xb);
  phase_peer_experts(FRESH(), 1);
}

extern "C" void kernel_launch(void* const* d_in, const int* in_sizes, int n_in, void* d_out, int out_size,
                              void* d_ws, size_t ws_size, hipStream_t stream) {
  static int grid_blocks = 0;
  if (!grid_blocks) {
    int dev = 0, cus = 0, per_cu = 0;
    hipGetDevice(&dev);
    hipDeviceGetAttribute(&cus, hipDeviceAttributeMultiprocessorCount, dev);
    hipOccupancyMaxActiveBlocksPerMultiprocessor(&per_cu, (const void*)yoco_mega, 256, 0);
    if (per_cu > 2) per_cu = 2;
    if (per_cu < 1) per_cu = 1;
    grid_blocks = cus * per_cu;
  }
  if (ws_size < WS_NEED) { fprintf(stderr, "workspace too small: %zu < %zu\n", ws_size, (size_t)WS_NEED); return; }
  Params p{};
  for (int i = 0; i < 35; ++i) p.in[i] = (const float*)d_in[i];
  p.out = (float*)d_out;
  p.ws = (char*)d_ws;
  void* args[] = {&p};
  hipError_t e = hipLaunchCooperativeKernel((const void*)yoco_mega, dim3(grid_blocks), dim3(256), args, 0, stream);
  if (e != hipSuccess) fprintf(stderr, "cooperative launch failed: %s (grid %d)\n", hipGetErrorString(e), grid_blocks);
}
```

```cpp
#include <hip/hip_runtime.h>
#include <hip/hip_cooperative_groups.h>
#include <stdio.h>
namespace cg = cooperative_groups;

typedef unsigned short bf16;
typedef __attribute__((ext_vector_type(8))) short s16x8;
typedef __attribute__((ext_vector_type(4))) float f32x4;

constexpr int NTP = 32768, NT = 33024;
constexpr int REP_GEMM = 1, REP_PE = 1, REP_SCAN = 1, REP_ATTN = 1, REP_P0 = 1;
constexpr size_t U = (size_t)NT * 1024 * 2;

constexpr size_t O_WRKV = 0;
constexpr size_t O_WL1  = O_WRKV + 3 * 2097152;
constexpr size_t O_W2T  = O_WL1 + 524288;
constexpr size_t O_A2T  = O_W2T + 131072;
constexpr size_t O_G2T  = O_A2T + 131072;
constexpr size_t O_WOUT = O_G2T + 262144;
constexpr size_t O_WKV  = O_WOUT + 2097152;
constexpr size_t O_WQ   = O_WKV + 4194304;
constexpr size_t O_WO   = O_WQ + 2097152;
constexpr size_t O_WPQ  = O_WO + 2097152;
constexpr size_t O_SK   = O_WPQ + 2 * 4194304;
constexpr size_t O_PU   = O_SK + 131072;
constexpr size_t O_PV   = O_PU + 16777216;
constexpr size_t O_SU   = O_PV + 16777216;
constexpr size_t O_SV   = O_SU + 131072;
constexpr size_t O_CNT  = O_SV + 131072;
constexpr size_t O_BAR  = O_CNT + 256;
constexpr size_t O_CUT  = O_BAR + 16384;
constexpr size_t O_SLOT = O_CUT + 16384;
constexpr size_t WS_NEED = O_SLOT + 10 * U;

constexpr size_t OFF_YP = 0, OFF_YS = 33554432, OFF_WKVP = 33816576, OFF_SHP = 34865152,
                 OFF_CKP = 34881536, OFF_CVP = 68435968, OFF_WKVS = 101990400, OFF_SHS = 103038976,
                 OFF_CKS = 103055360, OFF_CVS = 103317504;

struct Params {
  const float* in[35];
  float* out;
  char* ws;
};
typedef const Params __attribute__((address_space(4)))* KP;

__device__ const unsigned char CAND[64] = {0, 1, 2, 3, 4, 5, 6, 7, 8, 9, 10, 11, 12, 13, 14, 15, 16, 17, 18, 19, 20, 21, 22, 23, 32, 33, 34, 35, 36, 48, 49, 50, 51, 64, 65, 66, 80, 81, 96, 97, 112, 113, 128, 144, 160, 176, 192, 208, 224, 240, 255, 255, 255, 255, 255, 255, 255, 255, 255, 255, 255, 255, 255, 255};

__device__ __forceinline__ char* slot(KP p, int i) { return p->ws + O_SLOT + (size_t)i * U; }
__device__ __forceinline__ bf16 f2b(float f) { unsigned u = __float_as_uint(f); u += 0x7fffu + ((u >> 16) & 1u); return (bf16)(u >> 16); }
typedef float f32x2 __attribute__((ext_vector_type(2)));
typedef __bf16 bf16x2_t __attribute__((ext_vector_type(2)));
__device__ __forceinline__ unsigned pack2(float a, float b) {
  const f32x2 v = {a, b};
  return __builtin_bit_cast(unsigned, __builtin_convertvector(v, bf16x2_t));
}
__device__ __forceinline__ float blo(unsigned u) { return __uint_as_float(u << 16); }
__device__ __forceinline__ float bhi(unsigned u) { return __uint_as_float(u & 0xffff0000u); }
__device__ __forceinline__ uint2 pack4(f32x4 v) { return make_uint2(pack2(v[0], v[1]), pack2(v[2], v[3])); }
__device__ __forceinline__ f32x4 unpack4(uint2 u) { f32x4 r; r[0] = blo(u.x); r[1] = bhi(u.x); r[2] = blo(u.y); r[3] = bhi(u.y); return r; }
__device__ __forceinline__ f32x4 ld4(const float* p) { float4 t = *(const float4*)p; f32x4 r; r[0] = t.x; r[1] = t.y; r[2] = t.z; r[3] = t.w; return r; }
__device__ __forceinline__ void st4(float* p, f32x4 v) { *(float4*)p = make_float4(v[0], v[1], v[2], v[3]); }

template <int CTRL> __device__ __forceinline__ float dppf(float v) {
  return __builtin_bit_cast(float, __builtin_amdgcn_mov_dpp(__builtin_bit_cast(int, v), CTRL, 0xf, 0xf, true));
}
template <int CTRL> __device__ __forceinline__ unsigned dppu(unsigned v) {
  return (unsigned)__builtin_amdgcn_mov_dpp((int)v, CTRL, 0xf, 0xf, true);
}
__device__ __forceinline__ float oct_sum(float v) { v += dppf<0xB1>(v); v += dppf<0x4E>(v); v += dppf<0x141>(v); return v; }
__device__ __forceinline__ float row_sum(float v) { v = oct_sum(v); v += dppf<0x140>(v); return v; }
__device__ __forceinline__ float row_max(float v) {
  v = fmaxf(v, dppf<0xB1>(v)); v = fmaxf(v, dppf<0x4E>(v)); v = fmaxf(v, dppf<0x141>(v)); v = fmaxf(v, dppf<0x140>(v)); return v;
}
__device__ __forceinline__ unsigned umx(unsigned a, unsigned b) { return a > b ? a : b; }
__device__ __forceinline__ unsigned row_umax(unsigned v) {
  v = umx(v, dppu<0xB1>(v)); v = umx(v, dppu<0x4E>(v)); v = umx(v, dppu<0x141>(v)); v = umx(v, dppu<0x140>(v)); return v;
}
__device__ __forceinline__ float wave_sum(float v) { v = row_sum(v); v += __shfl_xor(v, 16); v += __shfl_xor(v, 32); return v; }
__device__ __forceinline__ unsigned f2ord(float f) { unsigned u = __float_as_uint(f); return (u & 0x80000000u) ? ~u : (u | 0x80000000u); }
__device__ __forceinline__ float ord2f(unsigned o) { unsigned u = (o & 0x80000000u) ? (o & 0x7fffffffu) : ~o; return __uint_as_float(u); }
__device__ __forceinline__ const float* xin(KP p, int m) {
  return m < NTP ? p->in[0] + (size_t)m * 1024 : p->in[1] + (size_t)(m - NTP) * 1024;
}

__device__ __forceinline__ int swz(int row, int slot) { const int q = (row >> 2) & 3; return row * 64 + ((slot ^ (q ^ ((q & 1) << 1))) << 4); }

typedef unsigned u32x4_t __attribute__((ext_vector_type(4)));
__device__ __forceinline__ uint4 ldnt(const void* p) { const u32x4_t v = __builtin_nontemporal_load((const u32x4_t*)p); return make_uint4(v.x, v.y, v.z, v.w); }

__device__ __forceinline__ int otid() { int t = threadIdx.x; asm volatile("" : "+v"(t)); return t; }

#define XB_TMO      128
#define XB_XCNT(j)  (256  + 64 * (j))
#define XB_XSUB(j)  (1280 + 64 * (j))
#define XB_XGEN(j)  (2304 + 64 * (j))
#define XB_TOP      3328
#define XB_TOPGEN   3392
#define XCD_BAR_WORDS 3456
#define XB_SPIN_CAP (1u << 20)
__device__ __forceinline__ unsigned xb_ld(unsigned* p) { return __hip_atomic_load(p, __ATOMIC_RELAXED, __HIP_MEMORY_SCOPE_AGENT); }
__device__ __forceinline__ unsigned xb_add(unsigned* p, unsigned v) { return __hip_atomic_fetch_add(p, v, __ATOMIC_RELAXED, __HIP_MEMORY_SCOPE_AGENT); }
__device__ __forceinline__ unsigned xb_xcc_id() { return (unsigned)__builtin_amdgcn_s_getreg((3 << 11) | 20) & 0xFu; }
#define XB_SPIN(cond, bar) do { unsigned _sp = 0; while (cond) { __builtin_amdgcn_s_sleep(1); \
    if ((++_sp & 255u) == 0u) { if (xb_ld(&(bar)[XB_TMO])) break; if (_sp > XB_SPIN_CAP) { atomicAdd(&(bar)[XB_TMO], 1u); break; } } } } while (0)
struct XcdBar { unsigned* bar; unsigned x, nloc, nx; };
__device__ __forceinline__ void xcd_census(unsigned* bar, unsigned x, unsigned& nloc, unsigned& nx) {
  const unsigned G = gridDim.x;
  unsigned sum, cnt, mine, sp = 0u;
  for (;;) {
    sum = 0u; cnt = 0u; mine = 0u;
#pragma unroll
    for (unsigned j = 0; j < 16; ++j) { const unsigned c = xb_ld(&bar[XB_XCNT(j)]); sum += c; cnt += (c > 0u) ? 1u : 0u; mine = (j == x) ? c : mine; }
    if (sum == G) break;
    __builtin_amdgcn_s_sleep(1);
    if ((++sp & 255u) == 0u) { if (xb_ld(&bar[XB_TMO])) break; if (sp > XB_SPIN_CAP) { atomicAdd(&bar[XB_TMO], 1u); break; } }
  }
  nloc = mine > 0u ? mine : 1u; nx = cnt > 0u ? cnt : 1u;
}
__device__ __forceinline__ void xcd_barrier(XcdBar& b) {
  asm volatile("s_waitcnt vmcnt(0)" ::: "memory");
  __syncthreads();
  if (threadIdx.x == 0) {
    unsigned* bar = b.bar;
    __builtin_amdgcn_s_waitcnt(0);
    const unsigned nloc = b.nloc, nx = b.nx;
    const unsigned old = xb_add(&bar[XB_XSUB(b.x)], 1u);
    const unsigned gen = old / nloc;
    if (old + 1u == (gen + 1u) * nloc) {
      __builtin_amdgcn_fence(__ATOMIC_RELEASE, "agent");
      asm volatile("s_waitcnt vmcnt(0)" ::: "memory");
      const unsigned og = xb_add(&bar[XB_TOP], 1u);
      const unsigned tg = og / nx;
      if (og + 1u == (tg + 1u) * nx) xb_add(&bar[XB_TOPGEN], 1u);
      else XB_SPIN(xb_ld(&bar[XB_TOPGEN]) == tg, bar);
      __builtin_amdgcn_fence(__ATOMIC_ACQUIRE, "agent");
      xb_add(&bar[XB_XGEN(b.x)], 1u);
      asm volatile("s_waitcnt vmcnt(0)" ::: "memory");
    } else {
      XB_SPIN(xb_ld(&bar[XB_XGEN(b.x)]) == gen, bar);
      __builtin_amdgcn_fence(__ATOMIC_ACQUIRE, "agent");
      asm volatile("s_waitcnt vmcnt(0)" ::: "memory");
    }
  }
  __syncthreads();
}

__device__ __forceinline__ void transpose_cvt(const float* __restrict__ W, bf16* __restrict__ WT, int K, int N, int gtid, int gsz) {
  const int items = (K >> 3) * N;
  for (int it = gtid; it < items; it += gsz) {
    const int n = it % N, kb = it / N;
    const float* src = W + (size_t)(kb * 8) * N + n;
    uint4 o;
    o.x = pack2(src[0], src[(size_t)N]);
    o.y = pack2(src[(size_t)2 * N], src[(size_t)3 * N]);
    o.z = pack2(src[(size_t)4 * N], src[(size_t)5 * N]);
    o.w = pack2(src[(size_t)6 * N], src[(size_t)7 * N]);
    *(uint4*)(WT + (size_t)n * K + kb * 8) = o;
  }
}
__device__ __forceinline__ void plain_cvt(const float* __restrict__ S, bf16* __restrict__ D, size_t n8, int gtid, int gsz) {
  for (size_t it = gtid; it < n8; it += gsz) {
    const float4 a = *(const float4*)(S + it * 8), b = *(const float4*)(S + it * 8 + 4);
    uint4 o; o.x = pack2(a.x, a.y); o.y = pack2(a.z, a.w); o.z = pack2(b.x, b.y); o.w = pack2(b.z, b.w);
    *(uint4*)(D + it * 8) = o;
  }
}
__device__ __forceinline__ void quant_rows(KP p, int r0) {
  char* ws = p->ws;
  {
    const int l = threadIdx.x & 63;
    for (int r = r0 + (threadIdx.x >> 6); r < r0 + 64; r += 4) {
      const int tbl = r >> 15, rr = r & 32767;
      const float* src = (tbl ? p->in[34] : p->in[33]) + (size_t)rr * 1024 + l * 16;
      f32x4 x[4];
#pragma unroll
      for (int i = 0; i < 4; ++i) { const uint4 t_ = ldnt(src + i * 4); x[i] = f32x4{__uint_as_float(t_.x), __uint_as_float(t_.y), __uint_as_float(t_.z), __uint_as_float(t_.w)}; }
      float am = 0.f;
#pragma unroll
      for (int i = 0; i < 4; ++i)
#pragma unroll
        for (int j = 0; j < 4; ++j) am = fmaxf(am, fabsf(x[i][j]));
      am = row_max(am); am = fmaxf(am, __shfl_xor(am, 16)); am = fmaxf(am, __shfl_xor(am, 32));
      if (tbl) {
        float ssq = 0.f;
#pragma unroll
        for (int i = 0; i < 4; ++i)
#pragma unroll
          for (int j = 0; j < 4; ++j) ssq = fmaf(x[i][j], x[i][j], ssq);
        const float clipv = fminf(am, 2.75f * sqrtf(wave_sum(ssq) * (1.0f / 1024.0f)));
        const float inv = clipv > 0.f ? 7.5f / clipv : 0.f;
        unsigned o[2] = {0u, 0u};
#pragma unroll
        for (int i = 0; i < 4; ++i)
#pragma unroll
          for (int j = 0; j < 4; ++j) {
            int q = (int)floorf(x[i][j] * inv + 8.0f); q = q < 0 ? 0 : (q > 15 ? 15 : q);
            const int e = i * 4 + j;
            o[e >> 3] |= (unsigned)q << (4 * (e & 7));
          }
        *(uint2*)((unsigned char*)(ws + O_PV) + (size_t)rr * 512 + l * 8) = make_uint2(o[0], o[1]);
        if (l == 0) ((float*)(ws + O_SV))[rr] = clipv > 0.f ? clipv / 7.5f : 1.0f;
      } else {
        float ssq = 0.f;
#pragma unroll
        for (int i = 0; i < 4; ++i)
#pragma unroll
          for (int j = 0; j < 4; ++j) ssq = fmaf(x[i][j], x[i][j], ssq);
        const float clipv = fminf(am, 2.75f * sqrtf(wave_sum(ssq) * (1.0f / 1024.0f)));
        const float inv = clipv > 0.f ? 7.5f / clipv : 0.f;
        unsigned o[2] = {0u, 0u};
#pragma unroll
        for (int i = 0; i < 4; ++i)
#pragma unroll
          for (int j = 0; j < 4; ++j) {
            int q = (int)floorf(x[i][j] * inv + 8.0f); q = q < 0 ? 0 : (q > 15 ? 15 : q);
            const int e = i * 4 + j;
            o[e >> 3] |= (unsigned)q << (4 * (e & 7));
          }
        *(uint2*)((unsigned char*)(ws + O_PU) + (size_t)rr * 512 + l * 8) = make_uint2(o[0], o[1]);
        if (l == 0) ((float*)(ws + O_SU))[rr] = clipv > 0.f ? clipv / 7.5f : 1.0f;
      }
    }
  }
}

__device__ __forceinline__ void phase0(KP p) {
  const int gtid = blockIdx.x * 256 + threadIdx.x, gsz = gridDim.x * 256;
  char* ws = p->ws;
  for (int rep0 = 0; rep0 < REP_P0; ++rep0) {
  if (gtid < 64) ((int*)(ws + O_CNT))[gtid] = 0;
  if (gtid < 4096) ((int*)(ws + O_CUT))[gtid] = 0;
  if (blockIdx.x == 0) for (int i = threadIdx.x; i < XCD_BAR_WORDS; i += 256) ((unsigned*)(ws + O_BAR))[i] = 0u;
  for (int g = 0; g < 3; ++g) transpose_cvt(p->in[7] + (size_t)g * 1048576, (bf16*)(ws + O_WRKV) + (size_t)g * 1048576, 1024, 1024, gtid, gsz);
  transpose_cvt(p->in[9],  (bf16*)(ws + O_WL1), 1024, 64, gtid, gsz);
  transpose_cvt(p->in[12], (bf16*)(ws + O_WL1) + 64 * 1024, 1024, 64, gtid, gsz);
  transpose_cvt(p->in[14], (bf16*)(ws + O_WL1) + 128 * 1024, 1024, 128, gtid, gsz);
  transpose_cvt(p->in[10], (bf16*)(ws + O_W2T), 64, 1024, gtid, gsz);
  transpose_cvt(p->in[13], (bf16*)(ws + O_A2T), 64, 1024, gtid, gsz);
  transpose_cvt(p->in[15], (bf16*)(ws + O_G2T), 128, 1024, gtid, gsz);
  transpose_cvt(p->in[21], (bf16*)(ws + O_WOUT), 1024, 1024, gtid, gsz);
  transpose_cvt(p->in[22], (bf16*)(ws + O_WKV), 1024, 2048, gtid, gsz);
  transpose_cvt(p->in[23], (bf16*)(ws + O_WQ), 1024, 1024, gtid, gsz);
  transpose_cvt(p->in[26], (bf16*)(ws + O_WO), 1024, 1024, gtid, gsz);
  for (int g = 0; g < 2; ++g) transpose_cvt(p->in[31] + (size_t)g * 2097152, (bf16*)(ws + O_WPQ) + (size_t)g * 2097152, 1024, 2048, gtid, gsz);
  plain_cvt(p->in[32], (bf16*)(ws + O_SK), 65536 / 8, gtid, gsz);
  const float* mu = p->in[6];
  for (int it = gtid; it < NT * 128; it += gsz) {
    const int m = it >> 7, c8 = (it & 127) * 8;
    const float* xr = xin(p, m) + c8;
    const float* pr = nullptr; bool last; float* sho;
    if (m < NTP) { const int t = m & 2047; if (t) pr = xr - 1024; last = (t == 2047); sho = p->out + OFF_SHP + (size_t)(m >> 11) * 1024 + c8; }
    else { const int ms = m - NTP, t = ms & 15; pr = t ? xr - 1024 : p->in[3] + (size_t)(ms >> 4) * 1024 + c8; last = (t == 15); sho = p->out + OFF_SHS + (size_t)(ms >> 4) * 1024 + c8; }
    const f32x4 x0 = ld4(xr), x1 = ld4(xr + 4);
    f32x4 d0, d1;
    if (pr) { d0 = ld4(pr) - x0; d1 = ld4(pr + 4) - x1; } else { d0 = -x0; d1 = -x1; }
    if (last) { st4(sho, x0); st4(sho + 4, x1); }
#pragma unroll
    for (int i = 0; i < 6; ++i) {
      const f32x4 m0 = ld4(mu + i * 1024 + c8), m1 = ld4(mu + i * 1024 + c8 + 4);
      const f32x4 a = x0 + d0 * m0, b = x1 + d1 * m1;
      const uint2 pa = pack4(a), pb = pack4(b);
      *(uint4*)((bf16*)slot(p, i) + (size_t)m * 1024 + c8) = make_uint4(pa.x, pa.y, pb.x, pb.y);
    }
  }
  }
}

struct Job { const bf16* A; const bf16* B; int lda, ldb, K, nmax, mode, m0, n0, aux; };

__device__ __forceinline__ void get_job(KP p, int ph, int id, Job& j) {
  char* ws = p->ws;
  j.lda = 1024; j.ldb = 1024; j.K = 1024; j.nmax = 1 << 30; j.aux = 0;
  if (ph == 1) {
    if (id < 6192) { const int g = id / 2064, r = id % 2064; j.A = (const bf16*)slot(p, g); j.B = (const bf16*)(ws + O_WRKV) + (size_t)g * 1048576; j.mode = 0; j.aux = g; j.m0 = (r >> 3) * 128; j.n0 = (r & 7) * 128; }
    else { const int q = id - 6192, g = q / 258; j.A = (const bf16*)slot(p, 3 + g); j.B = (const bf16*)(ws + O_WL1) + (size_t)g * 65536; j.nmax = (g == 2) ? 128 : 64; j.mode = 1; j.aux = g; j.m0 = (q % 258) * 128; j.n0 = 0; }
  } else if (ph == 2) {
    const int g = id / 2064, r = id % 2064; j.m0 = (r >> 3) * 128; j.n0 = (r & 7) * 128; j.lda = 256; j.mode = 2 + g;
    if (g == 0) { j.A = (const bf16*)slot(p, 9); j.B = (const bf16*)(ws + O_W2T); j.K = 64; j.ldb = 64; }
    else if (g == 1) { j.A = (const bf16*)slot(p, 9) + 64; j.B = (const bf16*)(ws + O_A2T); j.K = 64; j.ldb = 64; }
    else { j.A = (const bf16*)slot(p, 9) + 128; j.B = (const bf16*)(ws + O_G2T); j.K = 128; j.ldb = 128; }
  } else if (ph == 4) {
    j.A = (const bf16*)slot(p, 4); j.B = (const bf16*)(ws + O_WOUT); j.mode = 5; j.m0 = (id >> 3) * 128; j.n0 = (id & 7) * 128;
  } else if (ph == 6 || ph == 12) {
    const int layer = (ph == 12); j.aux = layer;
    j.A = (const bf16*)slot(p, layer ? 4 : 5); j.B = (const bf16*)(ws + O_WPQ) + (size_t)layer * 2097152; j.mode = 6; j.m0 = (id >> 4) * 128; j.n0 = (id & 15) * 128;
  } else if (ph == 8) {
    j.A = (const bf16*)slot(p, 4);
    if (id < 4128) { j.B = (const bf16*)(ws + O_WKV); j.mode = 7; j.m0 = (id >> 4) * 128; j.n0 = (id & 15) * 128; }
    else { const int q = id - 4128; j.B = (const bf16*)(ws + O_WQ); j.mode = 8; j.m0 = (q >> 3) * 128; j.n0 = (q & 7) * 128; }
  } else {
    j.A = (const bf16*)slot(p, 8); j.B = (const bf16*)(ws + O_WO); j.mode = 9; j.m0 = (id >> 3) * 128; j.n0 = (id & 7) * 128;
  }
}

__device__ __forceinline__ f32x4 rope4(f32x4 v, int m, int l) {
  const int pos = (m < NTP) ? (m & 2047) : (4096 + ((m - NTP) & 15));
  const int g = l >> 4; const bool t2 = g >= 2; const int fb = (g & 1) * 4;
  f32x4 o;
#pragma unroll
  for (int r = 0; r < 4; ++r) {
    const float inv = exp2f(-(float)(fb + r) * (18.931568569324174f * 0.125f));
    const float ang = (float)pos * inv;
    float rev = ang * 0.15915494309189535f; rev -= rintf(rev);
    const float s = __builtin_amdgcn_sinf(rev), c = __builtin_amdgcn_cosf(rev);
    const float pr = __shfl_xor(v[r], 32);
    o[r] = v[r] * c + (t2 ? pr * s : -pr * s);
  }
  return o;
}

template <int MODE>
__device__ __forceinline__ void epilogue(KP p, const Job& jb, int m, int n, f32x4 v, int l) {
  const size_t mi = (size_t)m * 1024 + n;
  switch (MODE) {
    case 0: *(uint2*)((bf16*)slot(p, 6 + jb.aux) + mi) = pack4(v); break;
    case 1: if (n < jb.nmax) {
        f32x4 o;
#pragma unroll
        for (int r = 0; r < 4; ++r) o[r] = jb.aux == 0 ? 1.0f - 2.0f / (1.0f + __expf(2.0f * v[r])) : (jb.aux == 1 ? v[r] : 1.0f / (1.0f + __expf(-v[r])));
        *(uint2*)((bf16*)slot(p, 9) + (size_t)m * 256 + jb.aux * 64 + n) = pack4(o);
      } break;
    case 2: {
        const f32x4 w0 = ld4(p->in[8] + n); f32x4 o;
#pragma unroll
        for (int r = 0; r < 4; ++r) { const float z = w0[r] + v[r]; const float sp = __logf(1.0f + __expf(-z)); o[r] = __expf(-__expf(-sp - 0.5f)); }
        st4((float*)slot(p, 0) + mi, o);
      } break;
    case 3: {
        const f32x4 a0 = ld4(p->in[11] + n); f32x4 o;
#pragma unroll
        for (int r = 0; r < 4; ++r) o[r] = 1.0f / (1.0f + __expf(-(a0[r] + v[r])));
        *(uint2*)((bf16*)slot(p, 2) + mi) = pack4(o);
      } break;
    case 4: *(uint2*)((bf16*)slot(p, 3) + mi) = pack4(v); break;
    case 5: { const f32x4 x = ld4(xin(p, m) + n); *(uint2*)((bf16*)slot(p, 0) + mi) = pack4(x * 1.4142135623730951f + v); } break;
    case 9: { const f32x4 x = unpack4(*(const uint2*)((const bf16*)slot(p, 4) + mi)); *(uint2*)((bf16*)slot(p, 2) + mi) = pack4(x * 1.4142135623730951f + v); } break;
    case 7: {
        if (n < 1024) {
          if ((n & 63) < 16) v = rope4(v, m, l);
          float* o = (m < NTP) ? p->out + OFF_CKP + mi : p->out + OFF_CKS + (size_t)(m - NTP) * 1024 + n;
          st4(o, v);
          *(uint2*)((bf16*)slot(p, 5) + mi) = pack4(v);
        } else {
          const int n2 = n - 1024, h = n2 >> 7, e = n2 & 127;
          float* o = (m < NTP) ? p->out + OFF_CVP + (size_t)m * 1024 + n2 : p->out + OFF_CVS + (size_t)(m - NTP) * 1024 + n2;
          st4(o, v);
          bf16* vt = (bf16*)slot(p, 6);
          if (m < NTP) { const int s = m >> 11, t = m & 2047;
#pragma unroll
            for (int r = 0; r < 4; ++r) vt[((size_t)((s * 8 + h) * 128 + e + r)) * 2048 + t] = f2b(v[r]);
          } else { const int ms = m - NTP, b = ms >> 4, t = ms & 15;
#pragma unroll
            for (int r = 0; r < 4; ++r) vt[(size_t)33554432 + ((size_t)((b * 8 + h) * 128 + e + r)) * 16 + t] = f2b(v[r]);
          }
        }
      } break;
    case 8: {
        if ((n & 63) < 16) v = rope4(v, m, l);
        *(uint2*)((bf16*)slot(p, 7) + mi) = pack4(v * 0.18033688011112042f);
      } break;
    default: break;
  }
}

template <int MODE>
__device__ __forceinline__ f32x4 epi_value(KP p, const Job& jb, int m, int n, f32x4 v, int l) {
  const size_t mi = (size_t)m * 1024 + n;
  if (MODE == 3) {
    const f32x4 a0 = ld4(p->in[11] + n); f32x4 o;
#pragma unroll
    for (int r = 0; r < 4; ++r) o[r] = 1.0f / (1.0f + __expf(-(a0[r] + v[r])));
    return o;
  } else if (MODE == 5) {
    return ld4(xin(p, m) + n) * 1.4142135623730951f + v;
  } else if (MODE == 9) {
    return unpack4(*(const uint2*)((const bf16*)slot(p, 4) + mi)) * 1.4142135623730951f + v;
  } else if (MODE == 8) {
    if ((n & 63) < 16) v = rope4(v, m, l);
    return v * 0.18033688011112042f;
  }
  return v;
}
template <int MODE>
__device__ __forceinline__ bf16* epi_dst(KP p, const Job& jb) {
  return (bf16*)slot(p, MODE == 0 ? 6 + jb.aux : (MODE == 3 ? 2 : (MODE == 4 ? 3 : (MODE == 5 ? 0 : (MODE == 9 ? 2 : 7)))));
}

__device__ __forceinline__ void peer_tail(KP p, const Job& jb, f32x4 (&acc)[4][4], char* lds, int tid) {
  const int l = tid & 63, w = tid >> 6, wm = w & 1, wn = w >> 1, g = l >> 4, li = l & 15;
#pragma unroll
  for (int j = 0; j < 4; ++j)
#pragma unroll
    for (int i = 0; i < 4; ++i) {
      const int d0 = wn * 64 + j * 16 + g * 4, tok = wm * 64 + i * 16 + li;
      *(uint2*)(lds + (d0 >> 5) * 8192 + swz(tok, (d0 & 31) >> 3) + ((d0 & 7) * 2)) = pack4(acc[j][i]);
    }
  __syncthreads();
  f32x4 sc[4][4];
#pragma unroll
  for (int j = 0; j < 4; ++j)
#pragma unroll
    for (int i = 0; i < 4; ++i) sc[j][i] = f32x4{0.f, 0.f, 0.f, 0.f};
#pragma unroll
  for (int ks = 0; ks < 4; ++ks) {
    s16x8 kf[4], qf[4];
#pragma unroll
    for (int j = 0; j < 4; ++j) kf[j] = *(const s16x8*)(lds + 32768 + ks * 8192 + swz(wn * 64 + j * 16 + li, g));
#pragma unroll
    for (int i = 0; i < 4; ++i) qf[i] = *(const s16x8*)(lds + ks * 8192 + swz(wm * 64 + i * 16 + li, g));
#pragma unroll
    for (int j = 0; j < 4; ++j)
#pragma unroll
      for (int i = 0; i < 4; ++i) sc[j][i] = __builtin_amdgcn_mfma_f32_16x16x32_bf16(kf[j], qf[i], sc[j][i], 0, 0, 0);
    __builtin_amdgcn_sched_barrier(0);
  }
  __syncthreads();
  unsigned* tko = (unsigned*)slot(p, jb.aux ? 5 : 6);
  const int nt = jb.n0 >> 7;
#pragma unroll 1
  for (int hm = 0; hm < 2; ++hm) {
    if (wm == hm) {
#pragma unroll
      for (int j = 0; j < 4; ++j)
#pragma unroll
        for (int i = 0; i < 4; ++i) {
          const int key0 = wn * 64 + j * 16 + g * 4, tokl = i * 16 + li;
          uint4 o;
          o.x = (f2ord(sc[j][i][0]) & ~127u) | (unsigned)(127 - key0);
          o.y = (f2ord(sc[j][i][1]) & ~127u) | (unsigned)(126 - key0);
          o.z = (f2ord(sc[j][i][2]) & ~127u) | (unsigned)(125 - key0);
          o.w = (f2ord(sc[j][i][3]) & ~127u) | (unsigned)(124 - key0);
          *(uint4*)(lds + (tokl * 132 + key0) * 4) = o;
        }
    }
    __syncthreads();
#pragma unroll 1
    for (int pass = 0; pass < 4; ++pass) {
      int tq = tid; asm volatile("" : "+v"(tq));
      const int tokl = pass * 16 + (tq >> 4), sub = tq & 15;
      const uint4 a = *(const uint4*)(lds + (tokl * 132 + sub * 8) * 4), b = *(const uint4*)(lds + (tokl * 132 + sub * 8 + 4) * 4);
      unsigned k0 = a.x, k1 = a.y, k2 = a.z, k3 = a.w, k4 = b.x, k5 = b.y, k6 = b.z, k7 = b.w, mine = 0;
#define CE(x, y) { const unsigned hi_ = umx(x, y), lo_ = x < y ? x : y; x = hi_; y = lo_; }
      CE(k0, k1) CE(k2, k3) CE(k4, k5) CE(k6, k7)
      CE(k0, k2) CE(k1, k3) CE(k4, k6) CE(k5, k7)
      CE(k1, k2) CE(k5, k6) CE(k0, k4) CE(k3, k7)
      CE(k1, k5) CE(k2, k6)
      CE(k1, k4) CE(k3, k6)
      CE(k2, k4) CE(k3, k5)
      CE(k3, k4)
#undef CE
#pragma unroll
      for (int it = 0; it < 16; ++it) {
        const unsigned mx = row_umax(k0);
        if (sub == it) mine = mx;
        const bool wn_ = (k0 == mx);
        k0 = wn_ ? k1 : k0; k1 = wn_ ? k2 : k1; k2 = wn_ ? k3 : k2; k3 = wn_ ? k4 : k3;
        k4 = wn_ ? k5 : k4; k5 = wn_ ? k6 : k5; k6 = wn_ ? k7 : k6; k7 = wn_ ? 0u : k7;
      }
      tko[(size_t)(jb.m0 + hm * 64 + tokl) * 256 + nt * 16 + sub] = mine;
    }
    __syncthreads();
  }
}

template <int PH, int MODE, int NTN>
__device__ __forceinline__ void gemm_range(KP p, int lo, int hi, int vlo, char* lds) {
  const int G = (hi - lo) / (258 * NTN);
  const int nv = G * 264 * NTN;
  int v0 = blockIdx.x;
  if (v0 < vlo) v0 += ((vlo - v0 + (int)gridDim.x - 1) / (int)gridDim.x) * (int)gridDim.x;
  for (int vv = v0; vv < vlo + nv * REP_GEMM; vv += gridDim.x) {
    const int v = REP_GEMM == 1 ? vv - vlo : (vv - vlo) % nv;
    const int gg = v / (264 * NTN), r = v % (264 * NTN);
    const int xcd = r & 7, jx = r >> 3, nt = jx % NTN, mt = (jx / NTN) * 8 + xcd;
    if (mt >= 258) continue;
    const int id = lo + (gg * 258 + mt) * NTN + nt;
    int tid = threadIdx.x;
    asm volatile("" : "+v"(tid));
    const int l = tid & 63, w = tid >> 6, wm = w & 1, wn = w >> 1, g = l >> 4, li = l & 15;
    Job jb; get_job(p, PH, id, jb);
    f32x4 acc[4][4];
#pragma unroll
    for (int j = 0; j < 4; ++j)
#pragma unroll
      for (int i = 0; i < 4; ++i) acc[j][i] = f32x4{0.f, 0.f, 0.f, 0.f};
    const int lrow = tid >> 3, lkq = tid & 7;
    const int so = (lkq >> 2) * 8192 + swz(lrow, lkq & 3);
    const bf16* ga = jb.A + (size_t)(jb.m0 + lrow) * jb.lda + lkq * 8;
    const size_t sa = (size_t)32 * jb.lda;
    const bf16* gb0 = jb.B + (size_t)min(jb.n0 + lrow, jb.nmax - 1) * jb.ldb + lkq * 8;
    const bf16* gb1 = jb.B + (size_t)min(jb.n0 + lrow + 32, jb.nmax - 1) * jb.ldb + lkq * 8;
    const bf16* gb2 = jb.B + (size_t)min(jb.n0 + lrow + 64, jb.nmax - 1) * jb.ldb + lkq * 8;
    const bf16* gb3 = jb.B + (size_t)min(jb.n0 + lrow + 96, jb.nmax - 1) * jb.ldb + lkq * 8;
    uint4 r0a, r0b, r0c, r0d, r0e, r0f, r0g, r0h, r1a, r1b, r1c, r1d, r1e, r1f, r1g, r1h, r2a, r2b, r2c, r2d, r2e, r2f, r2g, r2h;
#define G_LOAD(S, t) { const int ko_ = (t) * 64; r##S##a = *(const uint4*)(ga + ko_); r##S##b = *(const uint4*)(ga + sa + ko_); r##S##c = *(const uint4*)(ga + 2 * sa + ko_); r##S##d = *(const uint4*)(ga + 3 * sa + ko_); \
      r##S##e = *(const uint4*)(gb0 + ko_); r##S##f = *(const uint4*)(gb1 + ko_); r##S##g = *(const uint4*)(gb2 + ko_); r##S##h = *(const uint4*)(gb3 + ko_); }
#define S_WRITE(S, buf) { char* nb_ = lds + (buf) * 32768 + so; *(uint4*)(nb_) = r##S##a; *(uint4*)(nb_ + 2048) = r##S##b; *(uint4*)(nb_ + 4096) = r##S##c; *(uint4*)(nb_ + 6144) = r##S##d; \
      *(uint4*)(nb_ + 16384) = r##S##e; *(uint4*)(nb_ + 18432) = r##S##f; *(uint4*)(nb_ + 20480) = r##S##g; *(uint4*)(nb_ + 22528) = r##S##h; }
#define K_STEP(u, SL, SW, DIST) { const int kt = kb + (u); if (kt < KT) { \
          if (kt + (DIST) < KT) G_LOAD(SL, kt + (DIST)); \
          const char* sb = lds + ((u) & 1) * 32768; \
          _Pragma("unroll") for (int ks = 0; ks < 2; ++ks) { \
            s16x8 xf[4], wf[4]; \
            _Pragma("unroll") for (int i = 0; i < 4; ++i) xf[i] = *(const s16x8*)(sb + ks * 8192 + swz(wm * 64 + i * 16 + li, g)); \
            _Pragma("unroll") for (int j = 0; j < 4; ++j) wf[j] = *(const s16x8*)(sb + 16384 + ks * 8192 + swz(wn * 64 + j * 16 + li, g)); \
            _Pragma("unroll") for (int j = 0; j < 4; ++j) \
              _Pragma("unroll") for (int i = 0; i < 4; ++i) acc[j][i] = __builtin_amdgcn_mfma_f32_16x16x32_bf16(wf[j], xf[i], acc[j][i], 0, 0, 0); \
          } \
          if (kt + 1 < KT) S_WRITE(SW, ((u) + 1) & 1); \
          __syncthreads(); } }
    const int KT = jb.K >> 6;
    if (MODE == 6) {
      G_LOAD(0, 0);
      S_WRITE(0, 0);
      __syncthreads();
      for (int kb = 0; kb < KT; kb += 2) {
        K_STEP(0, 0, 0, 1)
        K_STEP(1, 0, 0, 1)
      }
      const bf16* sk = (const bf16*)(p->ws + O_SK) + (size_t)jb.aux * 32768 + (size_t)((jb.n0 >> 7) & 1) * 16384;
#pragma unroll
      for (int i = 0; i < 8; ++i) {
        const int q = tid + i * 256, key = q >> 4, dc = q & 15;
        *(uint4*)(lds + 32768 + (dc >> 2) * 8192 + swz(key, dc & 3)) = *(const uint4*)(sk + key * 128 + dc * 8);
      }
    } else {
      G_LOAD(0, 0);
      if (KT > 1) G_LOAD(1, 1);
      if (KT > 2) G_LOAD(2, 2);
      S_WRITE(0, 0);
      __syncthreads();
      for (int kb = 0; kb < KT; kb += 6) {
        K_STEP(0, 0, 1, 3)
        K_STEP(1, 1, 2, 3)
        K_STEP(2, 2, 0, 3)
        K_STEP(3, 0, 1, 3)
        K_STEP(4, 1, 2, 3)
        K_STEP(5, 2, 0, 3)
      }
    }
#undef G_LOAD
#undef S_WRITE
#undef K_STEP
    if (MODE == 6) peer_tail(p, jb, acc, lds, tid);
    else if (MODE == 0 || MODE == 3 || MODE == 4 || MODE == 5 || MODE == 8 || MODE == 9) {
#pragma unroll
      for (int j = 0; j < 4; ++j)
#pragma unroll
        for (int i = 0; i < 4; ++i) {
          const int ml = wm * 64 + i * 16 + li, nl = wn * 64 + j * 16 + g * 4;
          const f32x4 val = epi_value<MODE>(p, jb, jb.m0 + ml, jb.n0 + nl, acc[j][i], l);
          *(uint2*)(lds + ml * 272 + nl * 2) = pack4(val);
          if (i & 1) __builtin_amdgcn_sched_barrier(0);
        }
      __syncthreads();
      bf16* dst = epi_dst<MODE>(p, jb) + (size_t)jb.m0 * 1024 + jb.n0;
#pragma unroll 2
      for (int i = 0; i < 8; ++i) {
        const int c = tid + i * 256, row = c >> 4, col = c & 15;
        *(uint4*)(dst + (size_t)row * 1024 + col * 8) = *(const uint4*)(lds + row * 272 + col * 16);
      }
      __syncthreads();
    } else {
#pragma unroll
      for (int j = 0; j < 4; ++j)
#pragma unroll
        for (int i = 0; i < 4; ++i)
        {
          epilogue<MODE>(p, jb, jb.m0 + wm * 64 + i * 16 + li, jb.n0 + wn * 64 + j * 16 + g * 4, acc[j][i], l);
        }
    }
  }
}
template <int ph>
__device__ __forceinline__ void phase_gemm(KP p, char* lds) {
  switch (ph) {
    case 1: gemm_range<1, 0, 8>(p, 0, 6192, 0, lds); gemm_range<1, 1, 1>(p, 6192, 6966, 6336, lds); break;
    case 2: gemm_range<2, 2, 8>(p, 0, 2064, 0, lds); gemm_range<2, 3, 8>(p, 2064, 4128, 2112, lds); gemm_range<2, 4, 8>(p, 4128, 6192, 4224, lds); break;
    case 4: gemm_range<4, 5, 8>(p, 0, 2064, 0, lds); break;
    case 6: gemm_range<6, 6, 16>(p, 0, 4128, 0, lds); break;
    case 8: gemm_range<8, 7, 16>(p, 0, 4128, 0, lds); gemm_range<8, 8, 8>(p, 4128, 6192, 4224, lds); break;
    case 10: gemm_range<10, 9, 8>(p, 0, 2064, 0, lds); break;
    default: gemm_range<12, 6, 16>(p, 0, 4128, 0, lds); break;
  }
}

__device__ __forceinline__ void phase_scan(KP p, char* lds) {
  const int tid = threadIdx.x, l = tid & 63, w = tid >> 6;
  const int row0 = w * 16 + (l >> 3) * 2, col0 = (l & 7) * 8;
  const int lt = tid >> 4, lc = (tid & 15) * 4;
  const bf16* Rb = (const bf16*)slot(p, 6); const bf16* Kb = (const bf16*)slot(p, 7); const bf16* Vb = (const bf16*)slot(p, 8);
  const float* Dc = (const float*)slot(p, 0); const bf16* Ab = (const bf16*)slot(p, 2); const bf16* Gb = (const bf16*)slot(p, 3);
  bf16* YG = (bf16*)slot(p, 4);
  float* ybuf = (float*)(lds + 49152);
  float* cbuf = (float*)(lds + 53248);
  int* s_it = (int*)(lds + 65520);
  int* qL = (int*)(p->ws + O_CNT) + 60; int* qS = qL + 1;
  int role = 0;
  if (threadIdx.x == 0) {
    const unsigned hw = (unsigned)__builtin_amdgcn_s_getreg((7 << 11) | (8 << 6) | 4);
    role = atomicAdd((int*)(p->ws + O_CUT) + ((xb_xcc_id() & 15u) * 256 + (hw & 255u)), 1);
  }
  for (;;) {
    __syncthreads();
    if (tid == 0) {
      int got = -1;
      if (role == 0) { int j = atomicAdd(qL, 1); if (j < 256 * REP_SCAN) got = j & 255; else { j = atomicAdd(qS, 1); if (j < 256) got = 256 + j; } }
      else { int j = atomicAdd(qS, 1); if (j < 256) got = 256 + j; else { j = atomicAdd(qL, 1); if (j < 256 * REP_SCAN) got = j & 255; } }
      *s_it = got;
    }
    __syncthreads();
    const int item = *s_it;
    if (item < 0) break;
    const int seq = item >> 4, h = item & 15;
    const bool samp = seq >= 16; const int b = seq & 15;
    const int nch = samp ? 1 : 128;
    const int tok0 = samp ? NTP + b * 16 : b * 2048;
    f32x2 S2[2][4];
#pragma unroll
    for (int rr = 0; rr < 2; ++rr) {
      if (samp) {
        const float* sp = p->in[2] + ((size_t)(b * 16 + h) * 64 + row0 + rr) * 64 + col0;
        const f32x4 a = ld4(sp), c = ld4(sp + 4);
        S2[rr][0] = f32x2{a[0], a[1]}; S2[rr][1] = f32x2{a[2], a[3]}; S2[rr][2] = f32x2{c[0], c[1]}; S2[rr][3] = f32x2{c[2], c[3]};
      } else {
#pragma unroll
        for (int i = 0; i < 4; ++i) S2[rr][i] = f32x2{0.f, 0.f};
      }
    }
    const int ch0 = h * 64 + lc;
    const f32x4 kk4 = ld4(p->in[16] + ch0), ka4 = ld4(p->in[17] + ch0), rk4 = ld4(p->in[18] + ch0);
    const f32x4 lng = ld4(p->in[19] + ch0), lnb = ld4(p->in[20] + ch0);
    uint2 rr_, rk_, rv_, ra_; f32x4 rd_;
    auto issue = [&](int ch) {
      const size_t off = (size_t)(tok0 + ch * 16 + lt) * 1024 + ch0;
      rr_ = *(const uint2*)(Rb + off); rk_ = *(const uint2*)(Kb + off); rv_ = *(const uint2*)(Vb + off); ra_ = *(const uint2*)(Ab + off);
      rd_ = ld4(Dc + off);
    };
    auto stage = [&](int buf) {
      const f32x4 r4 = unpack4(rr_), k4 = unpack4(rk_), v4 = unpack4(rv_), a4 = unpack4(ra_);
      const f32x4 kkr = k4 * kk4;
      float ss = kkr[0] * kkr[0] + kkr[1] * kkr[1] + kkr[2] * kkr[2] + kkr[3] * kkr[3];
      ss = row_sum(ss);
      const float inv = 1.0f / fmaxf(sqrtf(ss), 1e-12f);
      const f32x4 kkn = kkr * inv;
      const f32x4 kp = k4 * (1.0f + (a4 - 1.0f) * ka4);
      const f32x4 kka = kkn * a4;
      const f32x4 t = r4 * kp * rk4;
      float cb = row_sum(t[0] + t[1] + t[2] + t[3]);
      char* bp = lds + buf * 24576 + lt * 256 + lc * 4;
      st4((float*)(bp), r4); st4((float*)(bp + 4096), rd_); st4((float*)(bp + 8192), kp);
      st4((float*)(bp + 12288), kkn); st4((float*)(bp + 16384), kka); st4((float*)(bp + 20480), v4);
      if ((tid & 15) == 0) cbuf[buf * 16 + lt] = cb;
    };
    __syncthreads();
    issue(0); stage(0);
    __syncthreads();
    for (int ch = 0; ch < nch; ++ch) {
      const int cur = ch & 1;
      const bool more = ch + 1 < nch;
      const size_t goff = (size_t)(tok0 + ch * 16 + lt) * 1024 + ch0;
      const uint2 gq = *(const uint2*)(Gb + goff);
      if (more) issue(ch + 1);
#pragma unroll
      for (int t = 0; t < 16; ++t) {
        const char* bp = lds + cur * 24576 + t * 256 + col0 * 4;
        f32x2 rv[4], dv[4], kv[4], qv[4], av[4];
#pragma unroll
        for (int hh = 0; hh < 2; ++hh) {
          const float4 a0 = *(const float4*)(bp + hh * 16), b0 = *(const float4*)(bp + 4096 + hh * 16), c0 = *(const float4*)(bp + 8192 + hh * 16);
          const float4 d0 = *(const float4*)(bp + 12288 + hh * 16), e0 = *(const float4*)(bp + 16384 + hh * 16);
          rv[2 * hh] = f32x2{a0.x, a0.y}; rv[2 * hh + 1] = f32x2{a0.z, a0.w};
          dv[2 * hh] = f32x2{b0.x, b0.y}; dv[2 * hh + 1] = f32x2{b0.z, b0.w};
          kv[2 * hh] = f32x2{c0.x, c0.y}; kv[2 * hh + 1] = f32x2{c0.z, c0.w};
          qv[2 * hh] = f32x2{d0.x, d0.y}; qv[2 * hh + 1] = f32x2{d0.z, d0.w};
          av[2 * hh] = f32x2{e0.x, e0.y}; av[2 * hh + 1] = f32x2{e0.z, e0.w};
        }
        const float2 vv = *(const float2*)(lds + cur * 24576 + t * 256 + 20480 + row0 * 4);
        float yo[2];
#pragma unroll
        for (int rr = 0; rr < 2; ++rr) {
          f32x2 sa = S2[rr][0] * qv[0];
          sa = S2[rr][1] * qv[1] + sa; sa = S2[rr][2] * qv[2] + sa; sa = S2[rr][3] * qv[3] + sa;
          const float skk = oct_sum(sa.x + sa.y);
          const float vr = rr ? vv.y : vv.x;
          const f32x2 vr2 = {vr, vr}, ns2 = {-skk, -skk};
#pragma unroll
          for (int c = 0; c < 4; ++c) { const f32x2 tt = S2[rr][c] * dv[c] + vr2 * kv[c]; S2[rr][c] = ns2 * av[c] + tt; }
          f32x2 ya = S2[rr][0] * rv[0];
          ya = S2[rr][1] * rv[1] + ya; ya = S2[rr][2] * rv[2] + ya; ya = S2[rr][3] * rv[3] + ya;
          yo[rr] = oct_sum(ya.x + ya.y);
        }
        if ((l & 7) == 0) *(float2*)(ybuf + t * 64 + row0) = make_float2(yo[0], yo[1]);
      }
      __syncthreads();
      {
        const f32x4 y4 = ld4(ybuf + lt * 64 + lc);
        const float mean = row_sum(y4[0] + y4[1] + y4[2] + y4[3]) * (1.0f / 64.0f);
        const f32x4 dy = y4 - mean;
        const float var = row_sum(dy[0] * dy[0] + dy[1] * dy[1] + dy[2] * dy[2] + dy[3] * dy[3]) * (1.0f / 64.0f);
        const float rs = rsqrtf(var + 64e-5f);
        const f32x4 v4 = ld4((const float*)(lds + cur * 24576 + 20480 + lt * 256 + lc * 4));
        const float cb = cbuf[cur * 16 + lt];
        const f32x4 g4 = unpack4(gq);
        const f32x4 o = (dy * rs * lng + lnb + v4 * cb) * g4;
        *(uint2*)(YG + goff) = pack4(o);
      }
      if (more) stage(cur ^ 1);
      __syncthreads();
    }
    float* so = p->out + (samp ? OFF_WKVS : OFF_WKVP) + ((size_t)(b * 16 + h) * 64 + row0) * 64 + col0;
#pragma unroll
    for (int rr = 0; rr < 2; ++rr) {
      st4(so + rr * 64, f32x4{S2[rr][0].x, S2[rr][0].y, S2[rr][1].x, S2[rr][1].y});
      st4(so + rr * 64 + 4, f32x4{S2[rr][2].x, S2[rr][2].y, S2[rr][3].x, S2[rr][3].y});
    }
  }
  int* qQ = (int*)(p->ws + O_CNT) + 62;
  for (;;) {
    __syncthreads();
    if (tid == 0) *s_it = atomicAdd(qQ, 1);
    __syncthreads();
    const int ch = *s_it;
    if (ch >= 1024) break;
    quant_rows(p, ch * 64);
  }
}

__device__ __forceinline__ void phase_ln(KP p, const bf16* src, float* d32, bf16* db, const float* gam, const float* bet) {
  const int tid_ = otid();
  const int l = tid_ & 63, w = tid_ >> 6;
  for (int m = blockIdx.x * 4 + w; m < NT; m += gridDim.x * 4) {
    const bf16* s = src + (size_t)m * 1024;
    f32x4 x[4];
#pragma unroll
    for (int i = 0; i < 4; ++i) x[i] = unpack4(*(const uint2*)(s + i * 256 + l * 4));
    float sm = 0.f;
#pragma unroll
    for (int i = 0; i < 4; ++i) sm += x[i][0] + x[i][1] + x[i][2] + x[i][3];
    const float mean = wave_sum(sm) * (1.0f / 1024.0f);
    float sq = 0.f;
#pragma unroll
    for (int i = 0; i < 4; ++i) { x[i] = x[i] - mean; sq += x[i][0] * x[i][0] + x[i][1] * x[i][1] + x[i][2] * x[i][2] + x[i][3] * x[i][3]; }
    const float rs = rsqrtf(wave_sum(sq) * (1.0f / 1024.0f) + 1e-5f);
#pragma unroll
    for (int i = 0; i < 4; ++i) {
      const int e = i * 256 + l * 4;
      const f32x4 y = x[i] * rs * ld4(gam + e) + ld4(bet + e);
      *(uint2*)(db + (size_t)m * 1024 + e) = pack4(y);
    }
  }
}

__device__ __forceinline__ float dotq4(unsigned u, const float* x, float d) {
  d = fmaf((float)(u & 255u), x[0], d); d = fmaf((float)((u >> 8) & 255u), x[1], d);
  d = fmaf((float)((u >> 16) & 255u), x[2], d); d = fmaf((float)(u >> 24), x[3], d);
  return d;
}
__device__ __forceinline__ float dotq(uint4 u, const float* x) {
  return dotq4(u.x, x, 0.f) + dotq4(u.y, x + 4, 0.f) + dotq4(u.z, x + 8, 0.f) + dotq4(u.w, x + 12, 0.f);
}
__device__ __forceinline__ void axq4(unsigned u, float a, float* o) {
  o[0] = fmaf(a, (float)(u & 255u), o[0]); o[1] = fmaf(a, (float)((u >> 8) & 255u), o[1]);
  o[2] = fmaf(a, (float)((u >> 16) & 255u), o[2]); o[3] = fmaf(a, (float)(u >> 24), o[3]);
}
__device__ __forceinline__ void axq(uint4 u, float a, float* o) { axq4(u.x, a, o); axq4(u.y, a, o + 4); axq4(u.z, a, o + 8); axq4(u.w, a, o + 12); }
__device__ __forceinline__ float reduce8(const float* pp, int l) {
  const bool b0 = l & 1, b1 = l & 2, b2 = l & 4;
  float a[4], bb[2];
#pragma unroll
  for (int i = 0; i < 4; ++i) { const float keep = b0 ? pp[2 * i + 1] : pp[2 * i], send = b0 ? pp[2 * i] : pp[2 * i + 1]; a[i] = keep + dppf<0xB1>(send); }
#pragma unroll
  for (int i = 0; i < 2; ++i) { const float keep = b1 ? a[2 * i + 1] : a[2 * i], send = b1 ? a[2 * i] : a[2 * i + 1]; bb[i] = keep + dppf<0x4E>(send); }
  const float keep = b2 ? bb[1] : bb[0], send = b2 ? bb[0] : bb[1];
  float c = keep + dppf<0x124>(send);
  c += dppf<0x128>(c);
  c += __shfl_xor(c, 16); c += __shfl_xor(c, 32);
  return c;
}

__device__ __forceinline__ void phase_peer_experts(KP p, int layer) {
  const int tid_ = otid();
  const int l = tid_ & 63, w = tid_ >> 6;
  const unsigned* TK = (const unsigned*)slot(p, layer ? 5 : 6);
  const bf16* X = (const bf16*)slot(p, layer ? 4 : 5);
  const unsigned char* PU = (const unsigned char*)(p->ws + O_PU) + (size_t)layer * 8388608;
  const unsigned char* PV = (const unsigned char*)(p->ws + O_PV) + (size_t)layer * 8388608;
  const float* SU = (const float*)(p->ws + O_SU) + layer * 16384;
  const float* SV = (const float*)(p->ws + O_SV) + layer * 16384;
  const float* lg = p->in[29] + layer * 1024; const float* lb = p->in[30] + layer * 1024;
  const int hq = l >> 4, r = l & 15;
  unsigned cd[4];
#pragma unroll
  for (int c = 0; c < 4; ++c) cd[c] = CAND[r * 4 + c];
  for (int mv = blockIdx.x * 4 + w; mv < NT * REP_PE; mv += gridDim.x * 4) {
    const int m = REP_PE == 1 ? mv : mv % NT;
    const unsigned* tk = TK + (size_t)m * 256;
    int eidx[2]; float gate[2];
#pragma unroll
    for (int pass = 0; pass < 2; ++pass) {
      const int h = pass * 4 + hq;
      unsigned k[4];
#pragma unroll
      for (int c = 0; c < 4; ++c) {
        const unsigned ab = cd[c] == 255u ? 0u : cd[c];
        const unsigned k1 = tk[h * 32 + (ab >> 4)], k2 = tk[h * 32 + 16 + (ab & 15)];
        const float s = ord2f(k1 & ~127u) + ord2f(k2 & ~127u);
        k[c] = cd[c] == 255u ? 0u : ((f2ord(s) & ~255u) | (255u - cd[c]));
      }
      unsigned mine = 0;
#pragma unroll
      for (int it = 0; it < 16; ++it) {
        unsigned mx = umx(umx(k[0], k[1]), umx(k[2], k[3]));
        mx = row_umax(mx);
        if (r == it) mine = mx;
#pragma unroll
        for (int c = 0; c < 4; ++c) k[c] = (k[c] == mx) ? 0u : k[c];
      }
      const unsigned pos = 255u - (mine & 255u);
      const unsigned k1 = tk[h * 32 + (pos >> 4)], k2 = tk[h * 32 + 16 + (pos & 15)];
      eidx[pass] = (int)((127u - (k1 & 127u)) * 128u + (127u - (k2 & 127u)));
      const float s = ord2f(mine & ~255u);
      const float mxs = row_max(s);
      const float ex = __expf(s - mxs);
      gate[pass] = ex / row_sum(ex);
    }
    const bf16* xr = X + (size_t)m * 1024;
    float xv[16], out[16];
    {
      const uint4 u0 = *(const uint4*)(xr + l * 16), u1 = *(const uint4*)(xr + l * 16 + 8);
      const f32x4 a = unpack4(make_uint2(u0.x, u0.y)), b = unpack4(make_uint2(u0.z, u0.w)), c = unpack4(make_uint2(u1.x, u1.y)), d = unpack4(make_uint2(u1.z, u1.w));
#pragma unroll
      for (int i = 0; i < 4; ++i) { xv[i] = a[i]; xv[4 + i] = b[i]; xv[8 + i] = c[i]; xv[12 + i] = d[i]; }
    }
    float xam = 0.f;
#pragma unroll
    for (int i = 0; i < 16; ++i) { out[i] = 0.f; xam = fmaxf(xam, fabsf(xv[i])); }
    xam = row_max(xam); xam = fmaxf(xam, __shfl_xor(xam, 16)); xam = fmaxf(xam, __shfl_xor(xam, 32));
    const float xinv = xam > 0.f ? 127.0f / xam : 0.f, xs = xam * (1.0f / 127.0f);
    int xq[16]; int sqi = 0;
#pragma unroll
    for (int i = 0; i < 16; ++i) { xq[i] = (int)rintf(xv[i] * xinv); sqi += xq[i]; }
    int xe0 = (xq[0] & 255) | ((xq[2] & 255) << 8) | ((xq[4] & 255) << 16) | (xq[6] << 24);
    int xo0 = (xq[1] & 255) | ((xq[3] & 255) << 8) | ((xq[5] & 255) << 16) | (xq[7] << 24);
    int xe1 = (xq[8] & 255) | ((xq[10] & 255) << 8) | ((xq[12] & 255) << 16) | (xq[14] << 24);
    int xo1 = (xq[9] & 255) | ((xq[11] & 255) << 8) | ((xq[13] & 255) << 16) | (xq[15] << 24);
    const float sx = wave_sum((float)sqi);
    float csum = 0.f;
    uint2 ua[8], ub[8];
    uint2 va[8], vb[8];
#define LD_U(dst, ps, s0) { _Pragma("unroll") for (int k = 0; k < 8; ++k) dst[k] = *(const uint2*)(PU + (size_t)__builtin_amdgcn_readlane(eidx[ps], (s0) + k) * 512 + l * 8); }
#define LD_V(dst, ps, s0) { _Pragma("unroll") for (int k = 0; k < 8; ++k) dst[k] = *(const uint2*)(PV + (size_t)__builtin_amdgcn_readlane(eidx[ps], (s0) + k) * 512 + l * 8); }
#define DO_U(buf, s0, MD) { float pp[8]; \
        _Pragma("unroll") for (int k = 0; k < 8; ++k) { \
          const unsigned w0 = buf[k].x, w1 = buf[k].y; \
          int a_ = __builtin_amdgcn_sdot4((int)(w0 & 0x0F0F0F0Fu), xe0, 0, false); \
          a_ = __builtin_amdgcn_sdot4((int)((w0 >> 4) & 0x0F0F0F0Fu), xo0, a_, false); \
          a_ = __builtin_amdgcn_sdot4((int)(w1 & 0x0F0F0F0Fu), xe1, a_, false); \
          a_ = __builtin_amdgcn_sdot4((int)((w1 >> 4) & 0x0F0F0F0Fu), xo1, a_, false); \
          pp[k] = (float)a_; } \
        const float c_ = reduce8(pp, l); \
        if ((l >> 3) == ((s0) >> 3)) MD = c_; }
#define TR4(d0, d1, d2, d3, A4, o) { \
          const unsigned pl_ = __builtin_amdgcn_perm(d1, d0, 0x05010400u), ph_ = __builtin_amdgcn_perm(d1, d0, 0x07030602u); \
          const unsigned ql_ = __builtin_amdgcn_perm(d3, d2, 0x05010400u), qh_ = __builtin_amdgcn_perm(d3, d2, 0x07030602u); \
          iacc[(o) + 0] = __builtin_amdgcn_sdot4((int)__builtin_amdgcn_perm(ql_, pl_, 0x05040100u), A4, iacc[(o) + 0], false); \
          iacc[(o) + 2] = __builtin_amdgcn_sdot4((int)__builtin_amdgcn_perm(ql_, pl_, 0x07060302u), A4, iacc[(o) + 2], false); \
          iacc[(o) + 4] = __builtin_amdgcn_sdot4((int)__builtin_amdgcn_perm(qh_, ph_, 0x05040100u), A4, iacc[(o) + 4], false); \
          iacc[(o) + 6] = __builtin_amdgcn_sdot4((int)__builtin_amdgcn_perm(qh_, ph_, 0x07060302u), A4, iacc[(o) + 6], false); }
#define NLO(w) ((w) & 0x0F0F0F0Fu)
#define NHI(w) (((w) >> 4) & 0x0F0F0F0Fu)
#define DO_V(buf, s0, CQ) { _Pragma("unroll") for (int hb = 0; hb < 2; ++hb) { \
          const int c0_ = __builtin_amdgcn_readlane(CQ, (s0) + hb * 4), c1_ = __builtin_amdgcn_readlane(CQ, (s0) + hb * 4 + 1); \
          const int c2_ = __builtin_amdgcn_readlane(CQ, (s0) + hb * 4 + 2), c3_ = __builtin_amdgcn_readlane(CQ, (s0) + hb * 4 + 3); \
          const int a4_ = (c0_ & 255) | ((c1_ & 255) << 8) | ((c2_ & 255) << 16) | ((c3_ & 255) << 24); \
          TR4(NLO(buf[hb * 4].x), NLO(buf[hb * 4 + 1].x), NLO(buf[hb * 4 + 2].x), NLO(buf[hb * 4 + 3].x), a4_, 0) \
          TR4(NHI(buf[hb * 4].x), NHI(buf[hb * 4 + 1].x), NHI(buf[hb * 4 + 2].x), NHI(buf[hb * 4 + 3].x), a4_, 1) \
          TR4(NLO(buf[hb * 4].y), NLO(buf[hb * 4 + 1].y), NLO(buf[hb * 4 + 2].y), NLO(buf[hb * 4 + 3].y), a4_, 8) \
          TR4(NHI(buf[hb * 4].y), NHI(buf[hb * 4 + 1].y), NHI(buf[hb * 4 + 2].y), NHI(buf[hb * 4 + 3].y), a4_, 9) } }
#define CQUANT(WG, CQ, CS) float CS; int CQ; { float cm_ = fabsf(WG); cm_ = row_max(cm_); cm_ = fmaxf(cm_, __shfl_xor(cm_, 16)); cm_ = fmaxf(cm_, __shfl_xor(cm_, 32)); \
          CS = cm_ * (1.0f / 127.0f); CQ = (int)rintf(WG * (cm_ > 0.f ? 127.0f / cm_ : 0.f)); }
#define CSUM(CQ) wave_sum((float)CQ)
#define FLUSH(CS, SUMQ) { const float off_ = 7.5f * (SUMQ); _Pragma("unroll") for (int i = 0; i < 16; ++i) { out[i] = fmaf(CS, (float)iacc[i] - off_, out[i]); iacc[i] = 0; } }
    float md0 = 0.f, md1 = 0.f;
    int iacc[16];
#pragma unroll
    for (int i = 0; i < 16; ++i) iacc[i] = 0;
    LD_U(ua, 0, 0)
#pragma unroll 1
    for (int s = 0; s < 64; s += 16) {
      LD_U(ub, 0, s + 8)
      DO_U(ua, s, md0)
      if (s + 16 < 64) LD_U(ua, 0, s + 16) else { LD_V(va, 0, 0) LD_U(ua, 1, 0) }
      DO_U(ub, s + 8, md0)
    }
    const float su0 = SU[eidx[0]], sv0 = SV[eidx[0]];
    const float hh0 = su0 * xs * (md0 - 7.5f * sx);
    const float wgt0 = gate[0] * 0.5f * hh0 * (1.0f + erff(hh0 * 0.70710678118654752f)) * sv0;
    CQUANT(wgt0, cq0, cs0)
    const float sq0 = CSUM(cq0);
#pragma unroll 1
    for (int s = 0; s < 64; s += 16) {
      LD_V(vb, 0, s + 8) LD_U(ub, 1, s + 8)
      DO_V(va, s, cq0) DO_U(ua, s, md1)
      if (s + 16 < 64) { LD_V(va, 0, s + 16) LD_U(ua, 1, s + 16) } else LD_V(va, 1, 0)
      DO_V(vb, s + 8, cq0) DO_U(ub, s + 8, md1)
    }
    const float su1 = SU[eidx[1]], sv1 = SV[eidx[1]];
    const float hh1 = su1 * xs * (md1 - 7.5f * sx);
    FLUSH(cs0, sq0)
    const float wgt1 = gate[1] * 0.5f * hh1 * (1.0f + erff(hh1 * 0.70710678118654752f)) * sv1;
    CQUANT(wgt1, cq1, cs1)
    const float sq1 = CSUM(cq1);
#pragma unroll 1
    for (int s = 0; s < 64; s += 16) {
      LD_V(vb, 1, s + 8)
      DO_V(va, s, cq1)
      if (s + 16 < 64) LD_V(va, 1, s + 16)
      DO_V(vb, s + 8, cq1)
    }
    FLUSH(cs1, sq1)
#undef LD_U
#undef LD_V
#undef DO_U
#undef DO_V
#undef TR4
#undef NLO
#undef NHI
#undef CSUM
#undef CQUANT
#undef FLUSH
    float sm = 0.f;
#pragma unroll
    for (int i = 0; i < 16; ++i) { out[i] = fmaf(xv[i], 1.4142135623730951f, out[i]); sm += out[i]; }
    const float mean = wave_sum(sm) * (1.0f / 1024.0f);
    float sq = 0.f;
#pragma unroll
    for (int i = 0; i < 16; ++i) { out[i] -= mean; sq = fmaf(out[i], out[i], sq); }
    const float rs = rsqrtf(wave_sum(sq) * (1.0f / 1024.0f) + 1e-5f);
    float* d32 = layer ? ((m < NTP) ? p->out + OFF_YP + (size_t)m * 1024 : p->out + OFF_YS + (size_t)(m - NTP) * 1024)
                       : (float*)slot(p, 0) + (size_t)m * 1024;
#pragma unroll
    for (int hf = 0; hf < 2; ++hf) {
      const int e = l * 16 + hf * 8;
      const f32x4 g0 = ld4(lg + e), g1 = ld4(lg + e + 4), b0 = ld4(lb + e), b1 = ld4(lb + e + 4);
      f32x4 y0, y1;
#pragma unroll
      for (int i = 0; i < 4; ++i) { y0[i] = out[hf * 8 + i] * rs * g0[i] + b0[i]; y1[i] = out[hf * 8 + 4 + i] * rs * g1[i] + b1[i]; }
      if (layer) { st4(d32 + e, y0); st4(d32 + e + 4, y1); }
      else {
        const uint2 pa = pack4(y0), pb = pack4(y1);
        *(uint4*)((bf16*)slot(p, 4) + (size_t)m * 1024 + e) = make_uint4(pa.x, pa.y, pb.x, pb.y);
      }
    }
  }
}

__device__ __forceinline__ void phase_attn(KP p, char* lds) {
  const int tid = threadIdx.x, l = tid & 63, w = tid >> 6, c = w & 1, qh = w >> 1, g = l >> 4, li = l & 15;
  int* s_item = (int*)(lds + 65520);
  int* counter = (int*)(p->ws + O_CNT);
  const float* lp = p->in[24];
  const float s1 = wave_sum(lp[l] * lp[64 + l]), s2 = wave_sum(lp[128 + l] * lp[192 + l]);
  const float lam = __expf(s1) - __expf(s2) + 0.35550906759f;
  const bf16* Kb = (const bf16*)slot(p, 5); const bf16* VT = (const bf16*)slot(p, 6);
  const bf16* Qb = (const bf16*)slot(p, 7); bf16* Ob = (bf16*)slot(p, 8);
  const float* ck = p->in[4]; const float* cv = p->in[5];
  const float* sg = p->in[25];
  const int myq = (int)(xb_xcc_id() & 7u);
  int qoff = 0;
  for (;;) {
    __syncthreads();
    if (tid == 0) {
      int got = -1;
      while (qoff < 8) {
        const int qx = (myq + qoff) & 7;
        const int j = atomicAdd(counter + qx * 8, 1);
        if (j < 640 * REP_ATTN) { got = qx * 1024 + (j % 640); break; }
        ++qoff;
      }
      *s_item = got;
    }
    __syncthreads();
    const int item = *s_item;
    if (item < 0) break;
    bool samp; int b, h, qc, sp;
    {
      const int qx = item >> 10, j = item & 1023;
      h = qx;
      if (j < 128) { samp = true; b = j >> 3; sp = j & 7; qc = 0; }
      else { const int j2 = j - 128; samp = false; sp = 0; b = j2 >> 5; qc = 31 - (j2 & 31); }
    }
    const int nkt = samp ? (sp == 7 ? 17 : 16) : qc + 1;
    const int qtok0 = samp ? NTP + b * 16 : b * 2048 + qc * 64;
    const int nq = samp ? 16 : 64;
    s16x8 qf[2][2];
#pragma unroll
    for (int f = 0; f < 2; ++f)
#pragma unroll
      for (int ks = 0; ks < 2; ++ks) {
        const int qi = min(qh * 32 + f * 16 + li, nq - 1);
        qf[f][ks] = *(const s16x8*)(Qb + (size_t)(qtok0 + qi) * 1024 + h * 128 + c * 64 + ks * 32 + g * 8);
      }
    f32x4 ot[8][2];
#pragma unroll
    for (int ef = 0; ef < 8; ++ef) { ot[ef][0] = f32x4{0.f, 0.f, 0.f, 0.f}; ot[ef][1] = f32x4{0.f, 0.f, 0.f, 0.f}; }
    float mrun[2] = {-INFINITY, -INFINITY}, lsum[2] = {0.f, 0.f};
    uint4 raw[8];
    auto load_tile = [&](int kt, int tid) {
      if (samp && kt < 16) {
#pragma unroll
        for (int i = 0; i < 2; ++i) {
          const int q = tid + i * 256, cc = q >> 8, key = (q >> 3) & 31, dch = q & 7;
          const float* src = ck + ((size_t)(b * 4096 + (sp * 16 + kt) * 32 + key)) * 1024 + h * 128 + cc * 64 + dch * 8;
          raw[2 * i] = ldnt(src); raw[2 * i + 1] = ldnt(src + 4);
        }
        const int key = tid & 31, eq = tid >> 5;
        const float* src = cv + ((size_t)(b * 4096 + (sp * 16 + kt) * 32 + key)) * 1024 + h * 128 + eq * 16;
#pragma unroll
        for (int i = 0; i < 4; ++i) raw[4 + i] = ldnt(src + i * 4);
      } else if (!samp) {
        const bf16* kb_ = Kb + (size_t)(b * 2048 + kt * 64) * 1024 + h * 128;
        const bf16* vb_ = VT + (size_t)((b * 8 + h) * 128) * 2048 + kt * 64;
        const unsigned ko_ = (unsigned)(tid >> 3) * 1024u + (unsigned)(tid & 7) * 8u;
        const unsigned vo_ = (unsigned)(tid >> 3) * 2048u + (unsigned)(tid & 7) * 8u;
        raw[0] = *(const uint4*)(kb_ + ko_);
        raw[1] = *(const uint4*)(kb_ + (ko_ + 32768u));
        raw[2] = *(const uint4*)(kb_ + (ko_ + 64u));
        raw[3] = *(const uint4*)(kb_ + (ko_ + 32768u + 64u));
        raw[4] = *(const uint4*)(vb_ + vo_);
        raw[5] = *(const uint4*)(vb_ + (vo_ + 65536u));
        raw[6] = *(const uint4*)(vb_ + (vo_ + 131072u));
        raw[7] = *(const uint4*)(vb_ + (vo_ + 196608u));
      } else {
        const int ktok0 = NTP + b * 16;
        const size_t vbase = (size_t)33554432 + (size_t)((b * 8 + h) * 128) * 16;
#pragma unroll
        for (int i = 0; i < 4; ++i) {
          const int q = tid + i * 256, cc = q >> 9, key = (q >> 3) & 63, dch = q & 7;
          const uint4 kvv = *(const uint4*)(Kb + (size_t)(ktok0 + (key & 15)) * 1024 + h * 128 + cc * 64 + dch * 8);
          const int e = q >> 3, kch = q & 7;
          const uint4 vvv = *(const uint4*)(VT + vbase + (size_t)e * 16 + (kch & 1) * 8);
          const bool kok = key < 16, vok = kch < 2;
          raw[i] = make_uint4(kok ? kvv.x : 0u, kok ? kvv.y : 0u, kok ? kvv.z : 0u, kok ? kvv.w : 0u);
          raw[4 + i] = make_uint4(vok ? vvv.x : 0u, vok ? vvv.y : 0u, vok ? vvv.z : 0u, vok ? vvv.w : 0u);
        }
      }
    };
    auto store_tile = [&](int kt, int tid) {
      if (samp && kt < 16) {
#pragma unroll
        for (int i = 0; i < 2; ++i) {
          const int q = tid + i * 256, cc = q >> 8, key = (q >> 3) & 31, dch = q & 7;
          const uint4 a = raw[2 * i], bq = raw[2 * i + 1];
          uint4 o;
          o.x = pack2(__uint_as_float(a.x), __uint_as_float(a.y)); o.y = pack2(__uint_as_float(a.z), __uint_as_float(a.w));
          o.z = pack2(__uint_as_float(bq.x), __uint_as_float(bq.y)); o.w = pack2(__uint_as_float(bq.z), __uint_as_float(bq.w));
          *(uint4*)(lds + cc * 8192 + (dch >> 2) * 4096 + swz(key, dch & 3)) = o;
        }
        const int key = tid & 31, eq = tid >> 5;
#pragma unroll
        for (int i = 0; i < 4; ++i) {
          const int e = eq * 16 + i * 4;
          *(bf16*)(lds + 16384 + (e + 0) * 144 + key * 2) = f2b(__uint_as_float(raw[4 + i].x));
          *(bf16*)(lds + 16384 + (e + 1) * 144 + key * 2) = f2b(__uint_as_float(raw[4 + i].y));
          *(bf16*)(lds + 16384 + (e + 2) * 144 + key * 2) = f2b(__uint_as_float(raw[4 + i].z));
          *(bf16*)(lds + 16384 + (e + 3) * 144 + key * 2) = f2b(__uint_as_float(raw[4 + i].w));
        }
      } else {
#pragma unroll
        for (int i = 0; i < 4; ++i) {
          const int dch = tid & 7;
          *(uint4*)(lds + ((dch >> 2) * 4096 + swz(tid >> 3, dch & 3)) + (i & 1) * 2048 + (i >> 1) * 8192) = raw[i];
          *(uint4*)(lds + 16384 + ((tid >> 3) * 144 + dch * 16) + i * 4608) = raw[4 + i];
        }
      }
    };
    load_tile(0, tid);
    for (int kt = 0; kt < nkt; ++kt) {
      int tz = tid;
      asm volatile("" : "+v"(tz));
      const int li = tz & 15, g = (tz & 63) >> 4;
      __syncthreads();
      store_tile(kt, tz);
      __syncthreads();
      if (kt + 1 < nkt) load_tile(kt + 1, tz);
      const int kvalid = samp ? (kt == 16 ? 16 : 32) : 64;
      const bool full = !samp;
      f32x4 st[4][2];
#pragma unroll
      for (int kf = 0; kf < 4; ++kf) { st[kf][0] = f32x4{0.f, 0.f, 0.f, 0.f}; st[kf][1] = f32x4{0.f, 0.f, 0.f, 0.f}; }
      {
        s16x8 kfr[2][4];
#pragma unroll
        for (int ks = 0; ks < 2; ++ks)
#pragma unroll
          for (int kf = 0; kf < 4; ++kf)
            if (kf < 2 || full) kfr[ks][kf] = *(const s16x8*)(lds + c * 8192 + ks * 4096 + swz(kf * 16 + li, g));
#pragma unroll
        for (int ks = 0; ks < 2; ++ks)
#pragma unroll
          for (int kf = 0; kf < 4; ++kf)
            if (kf < 2 || full) {
              st[kf][0] = __builtin_amdgcn_mfma_f32_16x16x32_bf16(kfr[ks][kf], qf[0][ks], st[kf][0], 0, 0, 0);
              st[kf][1] = __builtin_amdgcn_mfma_f32_16x16x32_bf16(kfr[ks][kf], qf[1][ks], st[kf][1], 0, 0, 0);
            }
        __builtin_amdgcn_sched_barrier(0);
      }
      if (kvalid < 64) {
#pragma unroll
        for (int kf = 0; kf < 4; ++kf)
#pragma unroll
          for (int r = 0; r < 4; ++r)
            if (kf * 16 + g * 4 + r >= kvalid) { st[kf][0][r] = -INFINITY; st[kf][1][r] = -INFINITY; }
      }
#pragma unroll
      for (int f = 0; f < 2; ++f) {
        float ml = st[0][f][0];
#pragma unroll
        for (int kf = 0; kf < 4; ++kf)
#pragma unroll
          for (int r = 0; r < 4; ++r) ml = fmaxf(ml, st[kf][f][r]);
        ml = fmaxf(ml, __shfl_xor(ml, 16)); ml = fmaxf(ml, __shfl_xor(ml, 32));
        const bool grow = ml > mrun[f] + 8.0f;
        const float mn = grow ? ml : mrun[f];
        float ps = 0.f;
#pragma unroll
        for (int kf = 0; kf < 4; ++kf)
#pragma unroll
          for (int r = 0; r < 4; ++r) { const float pv = __builtin_amdgcn_exp2f(st[kf][f][r] - mn); st[kf][f][r] = pv; ps += pv; }
        if (__builtin_amdgcn_ballot_w64(grow) != 0ull) {
          const float scl = __builtin_amdgcn_exp2f(mrun[f] - mn);
          lsum[f] *= scl;
#pragma unroll
          for (int ef = 0; ef < 8; ++ef) ot[ef][f] = ot[ef][f] * scl;
        }
        mrun[f] = mn;
        lsum[f] += ps;
      }
      s16x8 pf[2][2];
#pragma unroll
      for (int step = 0; step < 2; ++step)
#pragma unroll
        for (int f = 0; f < 2; ++f) {
          const uint2 a = pack4(st[2 * step][f]), bq = pack4(st[2 * step + 1][f]);
          pf[step][f] = __builtin_bit_cast(s16x8, make_uint4(a.x, a.y, bq.x, bq.y));
        }
      __builtin_amdgcn_sched_barrier(0);
#pragma unroll
      for (int step = 0; step < 2; ++step) {
        if (step == 1 && !full) break;
        s16x8 vf[8];
#pragma unroll
        for (int ef = 0; ef < 8; ++ef) {
          const char* vp = lds + 16384 + (ef * 16 + li) * 144 + (step * 32 + g * 4) * 2;
          const uint2 a = *(const uint2*)vp, bq = *(const uint2*)(vp + 32);
          vf[ef] = __builtin_bit_cast(s16x8, make_uint4(a.x, a.y, bq.x, bq.y));
        }
#pragma unroll
        for (int ef = 0; ef < 8; ++ef) {
          ot[ef][0] = __builtin_amdgcn_mfma_f32_16x16x32_bf16(vf[ef], pf[step][0], ot[ef][0], 0, 0, 0);
          ot[ef][1] = __builtin_amdgcn_mfma_f32_16x16x32_bf16(vf[ef], pf[step][1], ot[ef][1], 0, 0, 0);
        }
        __builtin_amdgcn_sched_barrier(0);
      }
    }
    float inv[2];
#pragma unroll
    for (int f = 0; f < 2; ++f) { float lt = lsum[f]; lt += __shfl_xor(lt, 16); lt += __shfl_xor(lt, 32); inv[f] = 1.0f / lt; }
    if (samp) {
      if (qh == 0) {
        float* pr = (float*)slot(p, 9) + ((size_t)((((b * 8 + h) * 8 + sp) * 2 + c) * 16 + li)) * 132;
#pragma unroll
        for (int ef = 0; ef < 8; ++ef) st4(pr + ef * 16 + g * 4, ot[ef][0]);
        if (g == 0) { pr[128] = mrun[0]; pr[129] = 1.0f / inv[0]; }
      }
      continue;
    }
    __syncthreads();
    float* comb = (float*)lds;
    if (c == 1) {
#pragma unroll
      for (int ef = 0; ef < 8; ++ef)
#pragma unroll
        for (int f = 0; f < 2; ++f)
#pragma unroll
          for (int r = 0; r < 4; ++r) comb[(((qh * 8 + ef) * 2 + f) * 4 + r) * 64 + l] = ot[ef][f][r] * inv[f] * lam;
    }
    __syncthreads();
    if (c == 0) {
#pragma unroll
      for (int f = 0; f < 2; ++f) {
        float ss = 0.f;
#pragma unroll
        for (int ef = 0; ef < 8; ++ef)
#pragma unroll
          for (int r = 0; r < 4; ++r) { const float o = ot[ef][f][r] * inv[f] - comb[(((qh * 8 + ef) * 2 + f) * 4 + r) * 64 + l]; ot[ef][f][r] = o; ss = fmaf(o, o, ss); }
        ss += __shfl_xor(ss, 16); ss += __shfl_xor(ss, 32);
        const float rs = rsqrtf(ss * (1.0f / 128.0f) + 1e-5f) * 0.6444909324090307f;
        const int qi = qh * 32 + f * 16 + li;
        if (qi < nq) {
#pragma unroll
          for (int ef = 0; ef < 8; ++ef) {
            const int e = ef * 16 + g * 4;
            const f32x4 g4 = ld4(sg + e);
            *(uint2*)(Ob + (size_t)(qtok0 + qi) * 1024 + h * 128 + e) = pack4(ot[ef][f] * rs * g4);
          }
        }
      }
    }
  }
}

__device__ __forceinline__ void phase_attn_combine(KP p) {
  const int l = threadIdx.x & 63, w = threadIdx.x >> 6;
  const float* lp = p->in[24];
  const float s1 = wave_sum(lp[l] * lp[64 + l]), s2 = wave_sum(lp[128 + l] * lp[192 + l]);
  const float lam = __expf(s1) - __expf(s2) + 0.35550906759f;
  const float* sg = p->in[25];
  bf16* Ob = (bf16*)slot(p, 8);
  for (int row = blockIdx.x * 4 + w; row < 2048; row += gridDim.x * 4) {
    const int q = row & 15, bh = row >> 4;
    float o2[2][2];
#pragma unroll
    for (int c = 0; c < 2; ++c) {
      float m[8], M = -INFINITY;
#pragma unroll
      for (int sp = 0; sp < 8; ++sp) { m[sp] = ((const float*)slot(p, 9))[((size_t)(((bh * 8 + sp) * 2 + c) * 16 + q)) * 132 + 128]; M = fmaxf(M, m[sp]); }
      float L = 0.f, a0 = 0.f, a1 = 0.f;
#pragma unroll
      for (int sp = 0; sp < 8; ++sp) {
        const float* pr = (const float*)slot(p, 9) + ((size_t)(((bh * 8 + sp) * 2 + c) * 16 + q)) * 132;
        const float wg = __builtin_amdgcn_exp2f(m[sp] - M);
        L = fmaf(wg, pr[129], L);
        const float2 ov = *(const float2*)(pr + l * 2);
        a0 = fmaf(wg, ov.x, a0); a1 = fmaf(wg, ov.y, a1);
      }
      o2[c][0] = a0 / L; o2[c][1] = a1 / L;
    }
    const float x0 = o2[0][0] - lam * o2[1][0], x1 = o2[0][1] - lam * o2[1][1];
    const float ss = wave_sum(x0 * x0 + x1 * x1);
    const float rs = rsqrtf(ss * (1.0f / 128.0f) + 1e-5f) * 0.6444909324090307f;
    const int b = bh >> 3, h = bh & 7;
    *(unsigned*)(Ob + (size_t)(NTP + b * 16 + q) * 1024 + h * 128 + l * 2) = pack2(x0 * rs * sg[l * 2], x1 * rs * sg[l * 2 + 1]);
  }
}

__global__ void __launch_bounds__(256, 2) yoco_mega(Params p) {
  __shared__ __attribute__((aligned(16))) char lds[65536];
  cg::grid_group grid = cg::this_grid();
  KP kp = (KP)__builtin_amdgcn_kernarg_segment_ptr();
#define FRESH() ({ KP q_ = kp; asm volatile("" : "+s"(q_)); q_; })
  phase0(FRESH());
  grid.sync();
  XcdBar xb; xb.bar = (unsigned*)(FRESH()->ws + O_BAR); xb.x = xb_xcc_id(); xb.nloc = 1u; xb.nx = 1u;
  if (threadIdx.x == 0) (void)xb_add(&xb.bar[XB_XCNT(xb.x)], 1u);
  if (threadIdx.x < 64) {
    unsigned nl = 1u, nxx = 1u;
    xcd_census(xb.bar, xb.x, nl, nxx);
    xb.nloc = (unsigned)__builtin_amdgcn_readfirstlane((int)nl); xb.nx = (unsigned)__builtin_amdgcn_readfirstlane((int)nxx);
  }
  phase_gemm<1>(FRESH(), lds); xcd_barrier(xb);
  phase_gemm<2>(FRESH(), lds); xcd_barrier(xb);
  phase_scan(FRESH(), lds); xcd_barrier(xb);
  phase_gemm<4>(FRESH(), lds); xcd_barrier(xb);
  { KP p = FRESH(); phase_ln(p, (const bf16*)slot(p, 0), (float*)slot(p, 2), (bf16*)slot(p, 5), p->in[27], p->in[28]); } xcd_barrier(xb);
  phase_gemm<6>(FRESH(), lds); xcd_barrier(xb);
  phase_peer_experts(FRESH(), 0); xcd_barrier(xb);
  phase_gemm<8>(FRESH(), lds); xcd_barrier(xb);
  phase_attn(FRESH(), lds); xcd_barrier(xb);
  phase_attn_combine(FRESH()); xcd_barrier(xb);
  phase_gemm<10>(FRESH(), lds); xcd_barrier(xb);
  { KP p = FRESH(); phase_ln(p, (const bf16*)slot(p, 2), (float*)slot(p, 0), (bf16*)slot(p, 4), p->in[27] + 1024, p->in[28] + 1024); } xcd_barrier(xb);
  phase_gemm<12>(FRESH(), lds); xcd_barrier(xb);
  phase_peer_experts(FRESH(), 1);
}

extern "C" void kernel_launch(void* const* d_in, const int* in_sizes, int n_in, void* d_out, int out_size,
                              void* d_ws, size_t ws_size, hipStream_t stream) {
  static int grid_blocks = 0;
  if (!grid_blocks) {
    int dev = 0, cus = 0, per_cu = 0;
    hipGetDevice(&dev);
    hipDeviceGetAttribute(&cus, hipDeviceAttributeMultiprocessorCount, dev);
    hipOccupancyMaxActiveBlocksPerMultiprocessor(&per_cu, (const void*)yoco_mega, 256, 0);
    if (per_cu > 2) per_cu = 2;
    if (per_cu < 1) per_cu = 1;
    grid_blocks = cus * per_cu;
  }
  if (ws_size < WS_NEED) { fprintf(stderr, "workspace too small: %zu < %zu\n", ws_size, (size_t)WS_NEED); return; }
  Params p{};
  for (int i = 0; i < 35; ++i) p.in[i] = (const float*)d_in[i];
  p.out = (float*)d_out;
  p.ws = (char*)d_ws;
  void* args[] = {&p};
  hipError_t e = hipLaunchCooperativeKernel((const void*)yoco_mega, dim3(grid_blocks), dim3(256), args, 0, stream);
  if (e != hipSuccess) fprintf(stderr, "cooperative launch failed: %s (grid %d)\n", hipGetErrorString(e), grid_blocks);
}
```
